# Optimizing an MI355X kernel written in HIP

```python
import math
import jax, jax.numpy as jnp
from jax import lax
import numpy as np

D_MODEL = 1024
BATCH = 4
SEQ = 8192
DEPTH = 4

PLE_DIM = 256
CONV_DIM = 512
CONV_WIDTH = 31
RET_HEADS = 8
RET_DK = 64
RET_DV = 128
RET_CHUNK = 128
ROPE_BASE = 10000.0
D_FF_DENSE = 2816
N_EXPERTS = 8
TOP_K = 2
D_FF_EXPERT = 3584
MOE_BLOCK = 256
EPS = 1e-6
N_DENSE = (DEPTH + 1) // 2
N_MOE = DEPTH // 2

SPLIT_SIZES = (2 * CONV_DIM,
               RET_HEADS * RET_DK,
               RET_HEADS * RET_DK,
               RET_HEADS * RET_DV,
               RET_HEADS * RET_DV,
               D_MODEL,
               D_MODEL)
IN_COLS = sum(SPLIT_SIZES)

kernel_name = "hybrid_conv_retention_moe_ple"


def rmsnorm(x, g):
    x32 = x.astype(jnp.float32)
    y = x32 * lax.rsqrt(jnp.mean(x32 * x32, axis=-1, keepdims=True) + EPS)
    return (y * g.astype(jnp.float32)).astype(x.dtype)


def layernorm(x, g, b):
    x32 = x.astype(jnp.float32)
    mu = jnp.mean(x32, axis=-1, keepdims=True)
    var = jnp.mean(jnp.square(x32 - mu), axis=-1, keepdims=True)
    y = (x32 - mu) * lax.rsqrt(var + EPS)
    return (y * g.astype(jnp.float32) + b.astype(jnp.float32)).astype(x.dtype)


def head_norm(y):
    y32 = y.astype(jnp.float32)
    mu = jnp.mean(y32, axis=-1, keepdims=True)
    var = jnp.mean(jnp.square(y32 - mu), axis=-1, keepdims=True)
    return ((y32 - mu) * lax.rsqrt(var + EPS)).astype(y.dtype)


def rotary(t, cos, sin):
    half = t.shape[-1] // 2
    t1, t2 = t[..., :half], t[..., half:]
    return jnp.concatenate([t1 * cos - t2 * sin, t1 * sin + t2 * cos], axis=-1)


def conv_branch(u, conv_w, conv_b, ln_g, ln_b):
    a, gate = jnp.split(u, 2, axis=-1)
    z = a * jax.nn.sigmoid(gate)
    z = lax.conv_general_dilated(
        z, conv_w[:, None, :].astype(z.dtype), window_strides=(1,),
        padding=[(CONV_WIDTH - 1, 0)],
        dimension_numbers=("NWC", "WIO", "NWC"),
        feature_group_count=CONV_DIM) + conv_b
    z = layernorm(z, ln_g, ln_b)
    return jax.nn.silu(z)


def retention(q, k, v):
    B, S, H, DK = q.shape
    DV = v.shape[-1]
    C = RET_CHUNK
    N = S // C
    dt = q.dtype
    log_g = jnp.log(1.0 - jnp.exp2(-5.0 - jnp.arange(H, dtype=jnp.float32)))
    pos = jnp.arange(C, dtype=jnp.float32)
    diff = pos[:, None] - pos[None, :]
    dmat = jnp.where(diff[None] >= 0,
                     jnp.exp(jnp.maximum(diff, 0.0)[None] * log_g[:, None, None]),
                     0.0).astype(dt)
    xi = jnp.exp((pos + 1.0)[None] * log_g[:, None]).astype(dt)
    zeta = jnp.exp((C - 1.0 - pos)[None] * log_g[:, None]).astype(dt)
    g_chunk = jnp.exp(C * log_g).astype(dt)

    def chunks(t):
        return t.reshape(B, N, C, H, t.shape[-1]).transpose(1, 0, 3, 2, 4)

    qc, kc, vc = chunks(q), chunks(k), chunks(v)
    s = jnp.einsum('nbhik,nbhjk->nbhij', qc, kc) * dmat
    intra = jnp.einsum('nbhij,nbhjv->nbhiv', s, vc)
    kz = kc * zeta[None, None, :, :, None]

    def step(state, inp):
        qn, kn, vn = inp
        cross = jnp.einsum('bhik,bhkv->bhiv', qn, state) * xi[None, :, :, None]
        state = g_chunk[None, :, None, None] * state + jnp.einsum('bhjk,bhjv->bhkv', kn, vn)
        return state, cross

    state0 = jnp.zeros((B, H, DK, DV), dt)
    _, cross = lax.scan(step, state0, (qc, kz, vc))
    o = intra + cross
    return o.transpose(1, 0, 3, 2, 4).reshape(B, S, H, DV)


def swiglu(h, w_gate, w_up, w_down):
    return (jax.nn.silu(h @ w_gate) * (h @ w_up)) @ w_down


def moe_ffn(h, w_router, w_gate, w_up, w_down):
    B, S, D = h.shape
    T = B * S
    hf = h.reshape(T, D)
    logits = hf.astype(jnp.float32) @ w_router.astype(jnp.float32)
    top_val, top_idx = lax.top_k(logits, TOP_K)
    gates = jax.nn.softmax(top_val, axis=-1).astype(h.dtype)
    TK = T * TOP_K
    flat_e = top_idx.reshape(TK)
    flat_tok = jnp.repeat(jnp.arange(T, dtype=jnp.int32), TOP_K)
    flat_g = gates.reshape(TK)
    order = jnp.argsort(flat_e)
    e_sorted = flat_e[order]
    counts = jnp.bincount(flat_e, length=N_EXPERTS)
    start = jnp.cumsum(counts) - counts
    padded = ((counts + MOE_BLOCK - 1) // MOE_BLOCK) * MOE_BLOCK
    pad_end = jnp.cumsum(padded)
    pad_start = pad_end - padded
    dest = pad_start[e_sorted] + (jnp.arange(TK) - start[e_sorted])
    n_rows = ((TK + N_EXPERTS * (MOE_BLOCK - 1) + MOE_BLOCK - 1) // MOE_BLOCK) * MOE_BLOCK
    n_blocks = n_rows // MOE_BLOCK
    row_tok = jnp.zeros((n_rows,), jnp.int32).at[dest].set(flat_tok[order])
    row_gate = jnp.zeros((n_rows,), h.dtype).at[dest].set(flat_g[order])
    block_start = jnp.arange(n_blocks) * MOE_BLOCK
    block_e = jnp.minimum(jnp.searchsorted(pad_end, block_start, side='right'), N_EXPERTS - 1)
    xin = hf[row_tok].reshape(n_blocks, MOE_BLOCK, D)

    def run_block(args):
        xb, e = args
        return swiglu(xb, w_gate[e], w_up[e], w_down[e])

    y = lax.map(run_block, (xin, block_e)).reshape(n_rows, D)
    out = jnp.zeros((T, D), h.dtype).at[row_tok].add(y * row_gate[:, None])
    return out.reshape(B, S, D)


def setup_inputs(seed: int = 0) -> dict:
    key = jax.random.key(seed)
    ks = iter(jax.random.split(key, 32))
    f32 = jnp.float32

    def w(shape, fan_in):
        return jax.random.normal(next(ks), shape, f32) * (fan_in ** -0.5)

    def gain(shape):
        return 1.0 + 0.02 * jax.random.normal(next(ks), shape, f32)

    def bias(shape):
        return 0.02 * jax.random.normal(next(ks), shape, f32)

    return {
        "x": jax.random.normal(next(ks), (BATCH, SEQ, D_MODEL), f32),
        "p": jax.random.normal(next(ks), (DEPTH, BATCH, SEQ, PLE_DIM), f32),
        "g_mix": gain((DEPTH, D_MODEL)),
        "w_in": w((DEPTH, D_MODEL, IN_COLS), D_MODEL),
        "conv_w": w((DEPTH, CONV_WIDTH, CONV_DIM), CONV_WIDTH),
        "conv_b": bias((DEPTH, CONV_DIM)),
        "conv_ln_g": gain((DEPTH, CONV_DIM)),
        "conv_ln_b": bias((DEPTH, CONV_DIM)),
        "w_conv_out": w((DEPTH, CONV_DIM, D_MODEL), CONV_DIM),
        "w_ret_out": w((DEPTH, RET_HEADS * RET_DV, D_MODEL), RET_HEADS * RET_DV),
        "w_out": w((DEPTH, D_MODEL, D_MODEL), D_MODEL),
        "g_ffn": gain((DEPTH, D_MODEL)),
        "w_dense_gate": w((N_DENSE, D_MODEL, D_FF_DENSE), D_MODEL),
        "w_dense_up": w((N_DENSE, D_MODEL, D_FF_DENSE), D_MODEL),
        "w_dense_down": w((N_DENSE, D_FF_DENSE, D_MODEL), D_FF_DENSE),
        "w_router": w((N_MOE, D_MODEL, N_EXPERTS), D_MODEL),
        "w_exp_gate": w((N_MOE, N_EXPERTS, D_MODEL, D_FF_EXPERT), D_MODEL),
        "w_exp_up": w((N_MOE, N_EXPERTS, D_MODEL, D_FF_EXPERT), D_MODEL),
        "w_exp_down": w((N_MOE, N_EXPERTS, D_FF_EXPERT, D_MODEL), D_FF_EXPERT),
        "g_ple": gain((DEPTH, D_MODEL)),
        "w_ple_gate": w((DEPTH, D_MODEL, D_MODEL), D_MODEL),
        "w_ple_proj": w((DEPTH, PLE_DIM, D_MODEL), PLE_DIM),
        "g_final": gain((D_MODEL,)),
    }


def reference(x, p, g_mix, w_in, conv_w, conv_b, conv_ln_g, conv_ln_b, w_conv_out,
              w_ret_out, w_out, g_ffn, w_dense_gate, w_dense_up, w_dense_down,
              w_router, w_exp_gate, w_exp_up, w_exp_down, g_ple, w_ple_gate,
              w_ple_proj, g_final):
    B, S, D = x.shape
    dt = x.dtype
    inv_freq = ROPE_BASE ** (-jnp.arange(0, RET_DK, 2, dtype=jnp.float32) / RET_DK)
    ang = jnp.arange(S, dtype=jnp.float32)[:, None] * inv_freq[None, :]
    cos = jnp.cos(ang)[:, None, :].astype(dt)
    sin = jnp.sin(ang)[:, None, :].astype(dt)
    split_idx = list(np.cumsum(SPLIT_SIZES)[:-1])

    for i in range(DEPTH):
        h = rmsnorm(x, g_mix[i])
        u_conv, q, k, v, g_ret, ga, gb = jnp.split(h @ w_in[i], split_idx, axis=-1)
        y_conv = conv_branch(u_conv, conv_w[i], conv_b[i], conv_ln_g[i], conv_ln_b[i]) @ w_conv_out[i]
        q = rotary(q.reshape(B, S, RET_HEADS, RET_DK), cos, sin) * (RET_DK ** -0.5)
        k = rotary(k.reshape(B, S, RET_HEADS, RET_DK), cos, sin)
        v = v.reshape(B, S, RET_HEADS, RET_DV)
        o = head_norm(retention(q, k, v)).reshape(B, S, RET_HEADS * RET_DV)
        y_ret = (jax.nn.silu(g_ret) * o) @ w_ret_out[i]
        merged = jax.nn.sigmoid(ga) * y_conv + jax.nn.sigmoid(gb) * y_ret
        x = x + merged @ w_out[i]

        h2 = rmsnorm(x, g_ffn[i])
        if i % 2 == 0:
            j = i // 2
            x = x + swiglu(h2, w_dense_gate[j], w_dense_up[j], w_dense_down[j])
        else:
            j = i // 2
            x = x + moe_ffn(h2, w_router[j], w_exp_gate[j], w_exp_up[j], w_exp_down[j])

        gate = jax.nn.sigmoid(rmsnorm(x, g_ple[i]) @ w_ple_gate[i])
        x = x + gate * (p[i] @ w_ple_proj[i])

    return rmsnorm(x, g_final)
```

```cpp
#include <hip/hip_runtime.h>
#include <cstdio>
#include <cstdint>
#ifndef MK_FUSED
#define MK_FUSED 0
#endif
namespace pg8 {
#define PG8_LAS __attribute__((address_space(3)))
typedef unsigned short bf16_t;
typedef short bf16x8 __attribute__((ext_vector_type(8)));
typedef float f32x4 __attribute__((ext_vector_type(4)));
typedef unsigned u32x4 __attribute__((ext_vector_type(4)));
constexpr int BM = 256, BK = 64, HALF = 128, HTB = HALF * BK * 2  , STAGE_BYTES = 8 * HTB, NXCD = 8, WGM = 8;

__host__ __device__ __forceinline__ int lds_byte(int r, int c) { const int st = (r >> 4) * 2 + (c >> 5), rr = r & 15, cc = c & 31, ob = rr * 64 + cc * 2; return st * 1024 + (ob ^ (((ob >> 9) & 1) << 5)); }
__host__ __device__ __forceinline__ void stage_rc(int b, int& R, int& C) { const int st = b / 1024, sb = b % 1024, swz = sb ^ (((sb >> 9) & 1) << 5); R = (st >> 1) * 16 + swz / 64; C = (st & 1) * 32 + (swz % 64) / 2; }
__host__ __device__ __forceinline__ int perm32(int rho) { const int n = rho >> 4, i = rho & 15; return 8 * (i >> 2) + 4 * n + (i & 3); }

struct Unit { int pm, pn, pb; };
struct Gemm { const bf16_t* A; const bf16_t* Bt; int M, N, K; };

struct StaticOrder {
    int nM, nN, nwg, G, c;
    __host__ __device__ void init(int M, int N, int G_, int c_) { nM = M / BM; nN = N / BM; nwg = nM * nN; G = G_; c = c_; }
    __host__ __device__ bool next(int i, Unit& u) const {
        const long L = (long)i * G + c; if (L >= nwg) return false;
        int wgid = (int)L; { const int q = nwg / NXCD, r = nwg % NXCD, xcd = wgid % NXCD, off = wgid / NXCD; wgid = (xcd < r ? xcd * (q + 1) : r * (q + 1) + (xcd - r) * q) + off; }
        const int nig = WGM * nN, gid = wgid / nig, fm = gid * WGM, gsz = (nM - fm) < WGM ? (nM - fm) : WGM;
        u.pm = fm + ((wgid % nig) % gsz); u.pn = (wgid % nig) / gsz; u.pb = u.pn; return true;
    }
    __device__ __forceinline__ void a_ready(const Unit&) const {}
    __device__ __forceinline__ void done(const Unit&) const {}
};

__device__ __forceinline__ unsigned cvt_pk_bf16(float lo, float hi) { unsigned r; asm volatile("v_cvt_pk_bf16_f32 %0, %1, %2" : "=v"(r) : "v"(lo), "v"(hi)); return r; }
typedef float f32x2 __attribute__((ext_vector_type(2)));


template <class Epi, class Sched, bool ALIGN_EPI = false, bool SP2 = false>
__device__ __forceinline__ void gemm_phase(PG8_LAS unsigned char* lds, const Gemm g, const Sched& S, const Epi& E) {
    int tid_ = threadIdx.x; asm volatile("" : "+v"(tid_));
    const int tid = tid_, wid = __builtin_amdgcn_readfirstlane(tid >> 6), lane = tid & 63, wr = wid >> 2, wc = wid & 3, fr = lane & 15, fq = lane >> 4;
    int K_ = g.K; asm volatile("" : "+s"(K_)); const int K = K_, nt = K / BK;
    unsigned voffA[2], voffB[2];
#pragma unroll
    for (int i = 0; i < 2; ++i) { int R, C; stage_rc(tid * 16 + i * 8192, R, C); const int Rb = Epi::PERM ? ((R & ~31) + perm32(R & 31)) : R;
        voffA[i] = (unsigned)(R * K + C) * 2u; voffB[i] = (unsigned)(Rb * K + C) * 2u; }
    const size_t kstep = (size_t)(BK * 2);
    const size_t hstep = (size_t)HALF * K * 2;
    const size_t tstep = 2 * hstep;
    const unsigned ldsw = (unsigned)wid * 1024u;
    const int aoff = lds_byte(wr * 64 + fr, fq * 8), boff = lds_byte(wc * 32 + fr, fq * 8);
#define PG8_SA(b, h) (((b) * 2 + (h)) * HTB)
#define PG8_SB(b, h) ((4 + (b) * 2 + (h)) * HTB)
#define PG8_STAGE(bufoff, gbase, voff) do { _Pragma("unroll") for (int _i = 0; _i < 2; ++_i) \
        __builtin_amdgcn_global_load_lds((const unsigned*)((const char*)(gbase) + (voff)[_i]), (PG8_LAS unsigned*)(lds + (bufoff) + ldsw + _i * 8192), 16, 0, 0); } while (0)
#define PG8_LDA(dst, b, h) do { _Pragma("unroll") for (int m = 0; m < 4; ++m) _Pragma("unroll") for (int k = 0; k < 2; ++k) dst[m][k] = *(const PG8_LAS bf16x8*)(lds + PG8_SA(b, h) + aoff + m * 2048 + k * 1024); } while (0)
#define PG8_LDB(dst, b, h) do { _Pragma("unroll") for (int n = 0; n < 2; ++n) _Pragma("unroll") for (int k = 0; k < 2; ++k) dst[n][k] = *(const PG8_LAS bf16x8*)(lds + PG8_SB(b, h) + boff + n * 2048 + k * 1024); } while (0)
#define PG8_MMA(ai, bj, At, Bt) do { __builtin_amdgcn_s_setprio(1); _Pragma("unroll") for (int m = 0; m < 4; ++m) _Pragma("unroll") for (int n = 0; n < 2; ++n) _Pragma("unroll") for (int k = 0; k < 2; ++k) \
        acc[ai][bj][m][n] = __builtin_amdgcn_mfma_f32_16x16x32_bf16(Bt[n][k], At[m][k], acc[ai][bj][m][n], 0, 0, 0); __builtin_amdgcn_s_setprio(0); } while (0)
#define PG8_WAIT_V(n) asm volatile("s_waitcnt vmcnt(" #n ")" ::: "memory")
#define PG8_WAIT_L(n) asm volatile("s_waitcnt lgkmcnt(" #n ")" ::: "memory")
#define PG8_BAR __builtin_amdgcn_s_barrier()
#define PG8_SCHED __builtin_amdgcn_sched_barrier(0)
    Unit cur, nxt; int ui = 0;
    if (!S.next(0, cur)) return;
    f32x4 acc[2][2][4][2];
#pragma unroll
    for (int a = 0; a < 2; ++a)
#pragma unroll
        for (int b = 0; b < 2; ++b)
#pragma unroll
            for (int m = 0; m < 4; ++m)
#pragma unroll
                for (int n = 0; n < 2; ++n) acc[a][b][m][n] = (f32x4){0.f, 0.f, 0.f, 0.f};
    bf16x8 At[4][2], B0[2][2], B1[2][2];
    const char* cA = (const char*)g.A + (size_t)cur.pm * tstep; const char* cB = (const char*)g.Bt + (size_t)cur.pb * tstep;
    S.a_ready(cur);
    if constexpr (SP2) {
        PG8_STAGE(PG8_SB(0, 0), cB, voffB); PG8_STAGE(PG8_SB(0, 1), cB + hstep, voffB); PG8_STAGE(PG8_SA(0, 0), cA, voffA); PG8_STAGE(PG8_SA(0, 1), cA + hstep, voffA);
        if (wr == 1) PG8_BAR;
        PG8_WAIT_V(2); PG8_BAR;
        PG8_STAGE(PG8_SB(1, 0), cB + kstep, voffB); PG8_STAGE(PG8_SA(1, 0), cA + kstep, voffA); PG8_STAGE(PG8_SB(1, 1), cB + hstep + kstep, voffB);
        PG8_WAIT_V(6); PG8_BAR;
    } else {
        PG8_STAGE(PG8_SB(0, 0), cB, voffB); PG8_STAGE(PG8_SA(0, 0), cA, voffA); PG8_STAGE(PG8_SB(0, 1), cB + hstep, voffB); PG8_STAGE(PG8_SA(0, 1), cA + hstep, voffA);
        if (wr == 1) PG8_BAR;
        PG8_WAIT_V(4); PG8_BAR;
        PG8_STAGE(PG8_SB(1, 0), cB + kstep, voffB); PG8_STAGE(PG8_SA(1, 0), cA + kstep, voffA); PG8_STAGE(PG8_SB(1, 1), cB + hstep + kstep, voffB);
        PG8_WAIT_V(6); PG8_BAR;
    }
    for (;;) {
        const bool has_next = S.next(ui + 1, nxt);
        const char* nA = has_next ? (const char*)g.A + (size_t)nxt.pm * tstep : cA; const char* nB = has_next ? (const char*)g.Bt + (size_t)nxt.pb * tstep : cB;
        for (int t = 0; t < nt; t += 2) {
            const bool last = (t == nt - 2);
            const char* a1 = cA + (size_t)(t + 1) * kstep;
            const char* a2 = last ? nA : cA + (size_t)(t + 2) * kstep; const char* b2 = last ? nB : cB + (size_t)(t + 2) * kstep;
            const char* a3 = a2 + kstep; const char* b3 = b2 + kstep;
            if (last && has_next) S.a_ready(nxt);
            if constexpr (SP2) {
            PG8_LDB(B0, 0, 0); PG8_LDB(B1, 0, 1); PG8_SCHED; PG8_LDA(At, 0, 0); PG8_STAGE(PG8_SA(1, 1), a1 + hstep, voffA);
            PG8_WAIT_V(8); PG8_WAIT_L(0); PG8_BAR; PG8_MMA(0, 0, At, B0); PG8_MMA(0, 1, At, B1); PG8_BAR; PG8_SCHED;
            PG8_LDA(At, 0, 1); PG8_STAGE(PG8_SB(0, 0), b2, voffB); PG8_STAGE(PG8_SB(0, 1), b2 + hstep, voffB); PG8_STAGE(PG8_SA(0, 0), a2, voffA);
            PG8_WAIT_V(8); PG8_WAIT_L(0); PG8_BAR; PG8_MMA(1, 0, At, B0); PG8_MMA(1, 1, At, B1); PG8_BAR; PG8_SCHED;
            PG8_LDB(B0, 1, 0); PG8_LDB(B1, 1, 1); PG8_SCHED; PG8_LDA(At, 1, 0); PG8_STAGE(PG8_SA(0, 1), a2 + hstep, voffA);
            PG8_WAIT_V(8); PG8_WAIT_L(0); PG8_BAR; PG8_MMA(0, 0, At, B0); PG8_MMA(0, 1, At, B1); PG8_BAR; PG8_SCHED;
            PG8_LDA(At, 1, 1); PG8_STAGE(PG8_SB(1, 0), b3, voffB); PG8_STAGE(PG8_SB(1, 1), b3 + hstep, voffB); PG8_STAGE(PG8_SA(1, 0), a3, voffA);
            PG8_WAIT_V(8); PG8_WAIT_L(0); PG8_BAR; PG8_MMA(1, 0, At, B0); PG8_MMA(1, 1, At, B1); PG8_BAR; PG8_SCHED;
            } else {
            PG8_LDB(B0, 0, 0); PG8_SCHED; PG8_LDA(At, 0, 0); PG8_STAGE(PG8_SA(1, 1), a1 + hstep, voffA);
            PG8_WAIT_L(8); PG8_BAR; PG8_WAIT_L(0); PG8_MMA(0, 0, At, B0); PG8_BAR; PG8_SCHED;
            PG8_LDB(B1, 0, 1); PG8_STAGE(PG8_SB(0, 0), b2, voffB);
            PG8_BAR; PG8_WAIT_L(0); PG8_MMA(0, 1, At, B1); PG8_BAR;
            PG8_LDA(At, 0, 1); PG8_STAGE(PG8_SA(0, 0), a2, voffA);
            PG8_BAR; PG8_WAIT_L(0); PG8_MMA(1, 0, At, B0); PG8_BAR; PG8_SCHED;
            PG8_STAGE(PG8_SB(0, 1), b2 + hstep, voffB);
            PG8_WAIT_V(6); PG8_BAR; PG8_MMA(1, 1, At, B1); PG8_BAR;
            PG8_LDB(B0, 1, 0); PG8_SCHED; PG8_LDA(At, 1, 0); PG8_STAGE(PG8_SA(0, 1), a2 + hstep, voffA);
            PG8_WAIT_L(8); PG8_BAR; PG8_WAIT_L(0); PG8_MMA(0, 0, At, B0); PG8_BAR; PG8_SCHED;
            PG8_LDB(B1, 1, 1); PG8_STAGE(PG8_SB(1, 0), b3, voffB);
            PG8_BAR; PG8_WAIT_L(0); PG8_MMA(0, 1, At, B1); PG8_BAR;
            PG8_LDA(At, 1, 1); PG8_STAGE(PG8_SA(1, 0), a3, voffA);
            PG8_BAR; PG8_WAIT_L(0); PG8_MMA(1, 0, At, B0); PG8_BAR; PG8_SCHED;
            PG8_STAGE(PG8_SB(1, 1), b3 + hstep, voffB);
            PG8_WAIT_V(6); PG8_BAR; PG8_MMA(1, 1, At, B1); PG8_BAR;
            }
        }
        if constexpr (ALIGN_EPI) { if (wr == 0) PG8_BAR; }
        if constexpr (!Epi::AFTER_DRAIN) { E(acc, cur, wr, wc, fr, fq); S.done(cur); }
        if (!has_next) break;
#pragma unroll
        for (int a = 0; a < 2; ++a)
#pragma unroll
            for (int b = 0; b < 2; ++b)
#pragma unroll
                for (int m = 0; m < 4; ++m)
#pragma unroll
                    for (int n = 0; n < 2; ++n) acc[a][b][m][n] = (f32x4){0.f, 0.f, 0.f, 0.f};
        cur = nxt; cA = nA; cB = nB; ++ui;
        if constexpr (ALIGN_EPI) { if (wr == 1) PG8_BAR; }
    }
    PG8_WAIT_V(0);
    if constexpr (!ALIGN_EPI) { if (wr == 0) PG8_BAR; }
    PG8_BAR;
    if constexpr (Epi::AFTER_DRAIN) { E.fused(acc, cur, wr, wc, fr, fq, lds, wid, lane); S.done(cur); }
#undef PG8_SA
#undef PG8_SB
#undef PG8_STAGE
#undef PG8_LDA
#undef PG8_LDB
#undef PG8_MMA
#undef PG8_WAIT_V
#undef PG8_WAIT_L
#undef PG8_BAR
#undef PG8_SCHED
}
}

namespace pg8 {
constexpr int TT = 32768;
constexpr float kLog2e = 1.4426950408889634f;
__device__ __forceinline__ float sigm(float v) { return __builtin_amdgcn_rcpf(1.0f + __builtin_amdgcn_exp2f(-v * kLog2e)); }
__device__ __forceinline__ f32x4 sigm4(f32x4 v) { f32x4 r; r.x = sigm(v.x); r.y = sigm(v.y); r.z = sigm(v.z); r.w = sigm(v.w); return r; }
__device__ __forceinline__ u32x4 pack8(f32x4 a, f32x4 b) { u32x4 w; w.x = cvt_pk_bf16(a.x, a.y); w.y = cvt_pk_bf16(a.z, a.w); w.z = cvt_pk_bf16(b.x, b.y); w.w = cvt_pk_bf16(b.z, b.w); return w; }
__device__ __forceinline__ f32x4 bf_lo4(unsigned a, unsigned b) { f32x4 r; r.x = __uint_as_float(a << 16); r.y = __uint_as_float(a & 0xffff0000u); r.z = __uint_as_float(b << 16); r.w = __uint_as_float(b & 0xffff0000u); return r; }
__device__ __forceinline__ float row_rs(const float* part, int row) {
    const f32x4* p = (const f32x4*)(part + (size_t)row * 16);
    const f32x4 a = p[0], b = p[1], c = p[2], d = p[3];
    const float s = (((a.x + a.y) + (a.z + a.w)) + ((b.x + b.y) + (b.z + b.w))) + (((c.x + c.y) + (c.z + c.w)) + ((d.x + d.y) + (d.z + d.w)));
    return __builtin_amdgcn_rsqf(s * (1.0f / 1024.0f) + 1e-6f);
}
__device__ __forceinline__ float row_rs4(const float* part, int row, int fq) {
    const f32x4 a = *(const f32x4*)(part + (size_t)row * 16 + fq * 4);
    float s = (a.x + a.y) + (a.z + a.w); s += __shfl_xor(s, 16); s += __shfl_xor(s, 32);
    return __builtin_amdgcn_rsqf(s * (1.0f / 1024.0f) + 1e-6f);
}
__device__ __forceinline__ void rows_rs8(const float* part, int row0, int fq, float (&rs)[2][4]) {
    f32x4 a[2][4];
#pragma unroll
    for (int ai = 0; ai < 2; ++ai)
#pragma unroll
        for (int m = 0; m < 4; ++m) a[ai][m] = *(const f32x4*)(part + (size_t)(row0 + ai * HALF + m * 16) * 16 + fq * 4);
#pragma unroll
    for (int ai = 0; ai < 2; ++ai)
#pragma unroll
        for (int m = 0; m < 4; ++m) { float s = (a[ai][m].x + a[ai][m].y) + (a[ai][m].z + a[ai][m].w); s += __shfl_xor(s, 16); s += __shfl_xor(s, 32); rs[ai][m] = __builtin_amdgcn_rsqf(s * (1.0f / 1024.0f) + 1e-6f); }
    asm volatile("" ::: "memory");
}
__device__ __forceinline__ float log2g(int h) {
    const float x = __builtin_amdgcn_exp2f((float)(-5 - h));
    const float ln = -x * (1.0f + x * (0.5f + x * (0.33333334f + x * (0.25f + x * (0.2f + x * 0.16666667f)))));
    return ln * kLog2e;
}

struct EpiIn {
    static constexpr bool PERM = true, AFTER_DRAIN = false;
    const float* part; const float* ctab; const float* stab;
    bf16_t *Z, *Q, *SG;
    static constexpr size_t QK_STRIDE = 16777216, G_STRIDE = 33554432;
    __device__ __forceinline__ void operator()(const f32x4 (&acc)[2][2][4][2], const Unit& u, int wr, int wc, int fr, int fq) const {
        asm volatile("" : "+v"(fr));
        const int row0 = u.pm * BM + wr * 64 + fr, pn = u.pn;
        float rsa[2][4]; rows_rs8(part, row0, fq, rsa);
        if (pn < 4) {
#pragma unroll
            for (int ai = 0; ai < 2; ++ai)
#pragma unroll
                for (int m = 0; m < 4; ++m) { const int row = row0 + ai * HALF + m * 16; const float rs = rsa[ai][m];
                    const f32x4 a0 = acc[ai][0][m][0] * rs, a1 = acc[ai][0][m][1] * rs, g0 = acc[ai][1][m][0] * rs, g1 = acc[ai][1][m][1] * rs;
                    *(u32x4*)(Z + (size_t)row * 512 + pn * 128 + wc * 32 + fq * 8) = pack8(a0 * sigm4(g0), a1 * sigm4(g1)); }
        } else if (pn < 8) {
            const bool isk = pn >= 6; const int head = 4 * ((pn - 4) & 1) + wc; const float scale = isk ? 1.0f : 0.125f; bf16_t* dst = Q + (isk ? QK_STRIDE : (size_t)0);
#pragma unroll
            for (int ai = 0; ai < 2; ++ai)
#pragma unroll
                for (int m = 0; m < 4; ++m) { const int row = row0 + ai * HALF + m * 16; const float rs = rsa[ai][m] * scale; const int pos = row & 8191;
                    const f32x4 c0 = *(const f32x4*)(ctab + pos * 32 + fq * 8), c1 = *(const f32x4*)(ctab + pos * 32 + fq * 8 + 4);
                    const f32x4 s0 = *(const f32x4*)(stab + pos * 32 + fq * 8), s1 = *(const f32x4*)(stab + pos * 32 + fq * 8 + 4);
                    const f32x4 t10 = acc[ai][0][m][0] * rs, t11 = acc[ai][0][m][1] * rs, t20 = acc[ai][1][m][0] * rs, t21 = acc[ai][1][m][1] * rs;
                    bf16_t* p = dst + (size_t)row * 512 + head * 64 + fq * 8;
                    *(u32x4*)(p) = pack8(t10 * c0 - t20 * s0, t11 * c1 - t21 * s1);
                    *(u32x4*)(p + 32) = pack8(t10 * s0 + t20 * c0, t11 * s1 + t21 * c1); asm volatile("" ::: "memory"); }
        } else {
            const int sel = (pn - 8) >> 2, colb = ((pn - 8) & 3) * 256 + wc * 32 + fq * 8; bf16_t* dst = SG + (size_t)sel * G_STRIDE; const bool silu = sel == 0;
#pragma unroll
            for (int ai = 0; ai < 2; ++ai)
#pragma unroll
                for (int m = 0; m < 4; ++m) { const int row = row0 + ai * HALF + m * 16; const float rs = rsa[ai][m];
#pragma unroll
                    for (int bj = 0; bj < 2; ++bj) { const f32x4 v0 = acc[ai][bj][m][0] * rs, v1 = acc[ai][bj][m][1] * rs; f32x4 o0 = sigm4(v0), o1 = sigm4(v1);
                        if (silu) { o0 = o0 * v0; o1 = o1 * v1; }
                        *(u32x4*)(dst + (size_t)row * 1024 + colb + bj * HALF) = pack8(o0, o1); } }
        }
    }
};
struct EpiKvT {
    static constexpr bool PERM = true, AFTER_DRAIN = false;
    const float* part; const float* ctT; const float* stT;
    bf16_t *KZT, *VT;
    __device__ __forceinline__ void operator()(const f32x4 (&acc)[2][2][4][2], const Unit& u, int wr, int wc, int fr, int fq) const {
        asm volatile("" : "+v"(fr));
        const int col0 = u.pn * BM + wc * 32 + fq * 8;
        f32x4 rsv[2][2];
        { const int lane = fq * 16 + fr; const float mine = row_rs(part, u.pn * BM + (lane >> 5) * HALF + wc * 32 + (lane & 31));
          asm volatile("" ::: "memory");
#pragma unroll
          for (int bj = 0; bj < 2; ++bj)
#pragma unroll
            for (int n = 0; n < 2; ++n) { const int sl = bj * 32 + fq * 8 + n * 4; rsv[bj][n].x = __shfl(mine, sl); rsv[bj][n].y = __shfl(mine, sl + 1); rsv[bj][n].z = __shfl(mine, sl + 2); rsv[bj][n].w = __shfl(mine, sl + 3); } }
        if (u.pm < 2) {
            const int pos0 = col0 & 8191;
#pragma unroll
            for (int m = 0; m < 4; ++m) { const int head = 4 * u.pm + 2 * wr + (m >> 1), d = 16 * (m & 1) + fr; const float lg = log2g(head);
#pragma unroll
                for (int bj = 0; bj < 2; ++bj) { f32x4 o1[2], o2[2];
#pragma unroll
                    for (int n = 0; n < 2; ++n) { const int pos = pos0 + bj * HALF + n * 4; const f32x4 c4 = *(const f32x4*)(ctT + d * 8192 + pos), s4 = *(const f32x4*)(stT + d * 8192 + pos);
                        const float jf = (float)(127 - (pos & 127)); f32x4 z;
                        z.x = __builtin_amdgcn_exp2f(jf * lg); z.y = __builtin_amdgcn_exp2f((jf - 1.0f) * lg); z.z = __builtin_amdgcn_exp2f((jf - 2.0f) * lg); z.w = __builtin_amdgcn_exp2f((jf - 3.0f) * lg);
                        const f32x4 t1 = acc[0][bj][m][n] * rsv[bj][n], t2 = acc[1][bj][m][n] * rsv[bj][n];
                        o1[n] = (t1 * c4 - t2 * s4) * z; o2[n] = (t1 * s4 + t2 * c4) * z; }
                    *(u32x4*)(KZT + (size_t)(head * 64 + d) * TT + col0 + bj * HALF) = pack8(o1[0], o1[1]);
                    *(u32x4*)(KZT + (size_t)(head * 64 + 32 + d) * TT + col0 + bj * HALF) = pack8(o2[0], o2[1]); } }
        } else {
#pragma unroll
            for (int ai = 0; ai < 2; ++ai)
#pragma unroll
                for (int m = 0; m < 4; ++m) { const int r = (u.pm - 2) * BM + ai * HALF + wr * 64 + m * 16 + fr;
#pragma unroll
                    for (int bj = 0; bj < 2; ++bj) *(u32x4*)(VT + (size_t)r * TT + col0 + bj * HALF) = pack8(acc[ai][bj][m][0] * rsv[bj][0], acc[ai][bj][m][1] * rsv[bj][1]); }
        }
    }
};
struct EpiStore {
    static constexpr bool PERM = true, AFTER_DRAIN = false;
    bf16_t* O; int ld;
    __device__ __forceinline__ void operator()(const f32x4 (&acc)[2][2][4][2], const Unit& u, int wr, int wc, int fr, int fq) const {
        asm volatile("" : "+v"(fr));
        const int row0 = u.pm * BM + wr * 64 + fr, col0 = u.pn * BM + wc * 32 + fq * 8;
#pragma unroll
        for (int ai = 0; ai < 2; ++ai)
#pragma unroll
            for (int m = 0; m < 4; ++m) { bf16_t* rowp = O + (size_t)(row0 + ai * HALF + m * 16) * ld + col0;
#pragma unroll
                for (int bj = 0; bj < 2; ++bj) *(u32x4*)(rowp + bj * HALF) = pack8(acc[ai][bj][m][0], acc[ai][bj][m][1]); }
    }
};
template <bool ADD> struct EpiGate {
    static constexpr bool PERM = true, AFTER_DRAIN = false;
    const bf16_t* G; bf16_t* O;
    __device__ __forceinline__ void operator()(const f32x4 (&acc)[2][2][4][2], const Unit& u, int wr, int wc, int fr, int fq) const {
        asm volatile("" : "+v"(fr));
        const int row0 = u.pm * BM + wr * 64 + fr, col0 = u.pn * BM + wc * 32 + fq * 8;
#pragma unroll
        for (int ai = 0; ai < 2; ++ai)
#pragma unroll
            for (int m = 0; m < 4; ++m) { const size_t off = (size_t)(row0 + ai * HALF + m * 16) * 1024 + col0;
#pragma unroll
                for (int bj = 0; bj < 2; ++bj) { const u32x4 g = *(const u32x4*)(G + off + bj * HALF);
                    f32x4 o0 = acc[ai][bj][m][0] * bf_lo4(g.x, g.y), o1 = acc[ai][bj][m][1] * bf_lo4(g.z, g.w);
                    if (ADD) { const u32x4 p = *(const u32x4*)(O + off + bj * HALF); o0 = o0 + bf_lo4(p.x, p.y); o1 = o1 + bf_lo4(p.z, p.w); }
                    *(u32x4*)(O + off + bj * HALF) = pack8(o0, o1); } }
    }
};
template <bool PLE> struct EpiRes {
    static constexpr bool PERM = true, AFTER_DRAIN = false;
    float* X; bf16_t* XB; float* part_out; const float* part_in; const bf16_t* PP;
    __device__ __forceinline__ void operator()(const f32x4 (&acc)[2][2][4][2], const Unit& u, int wr, int wc, int fr, int fq) const {
        asm volatile("" : "+v"(fr));
        const int row0 = u.pm * BM + wr * 64 + fr, col0 = u.pn * BM + wc * 32 + fq * 8;
#pragma unroll
        for (int ai = 0; ai < 2; ++ai)
#pragma unroll
            for (int m = 0; m < 4; ++m) { const int row = row0 + ai * HALF + m * 16; const size_t off = (size_t)row * 1024 + col0; float ss = 0.f;
                float rs = 1.0f; if (PLE) rs = row_rs4(part_in, row, fq);
#pragma unroll
                for (int bj = 0; bj < 2; ++bj) { float* xp = X + off + bj * HALF; f32x4 x0 = *(const f32x4*)xp, x1 = *(const f32x4*)(xp + 4);
                    if (PLE) { const u32x4 p = *(const u32x4*)(PP + off + bj * HALF);
                        x0 = x0 + sigm4(acc[ai][bj][m][0] * rs) * bf_lo4(p.x, p.y); x1 = x1 + sigm4(acc[ai][bj][m][1] * rs) * bf_lo4(p.z, p.w); }
                    else { x0 = x0 + acc[ai][bj][m][0]; x1 = x1 + acc[ai][bj][m][1]; }
                    *(f32x4*)xp = x0; *(f32x4*)(xp + 4) = x1; *(u32x4*)(XB + off + bj * HALF) = pack8(x0, x1);
                    ss += ((x0.x * x0.x + x0.y * x0.y) + (x0.z * x0.z + x0.w * x0.w)) + ((x1.x * x1.x + x1.y * x1.y) + (x1.z * x1.z + x1.w * x1.w)); }
                ss += __shfl_xor(ss, 16); ss += __shfl_xor(ss, 32);
                if (fq == 0) part_out[(size_t)row * 16 + u.pn * 4 + wc] = ss; asm volatile("" ::: "memory"); }
    }
};
template <bool SLOT> struct EpiSwi {
    static constexpr bool PERM = true, AFTER_DRAIN = false;
    const float* part; const float* rsx; bf16_t* O; int ld;
    __device__ __forceinline__ void operator()(const f32x4 (&acc)[2][2][4][2], const Unit& u, int wr, int wc, int fr, int fq) const {
        asm volatile("" : "+v"(fr));
        const int row0 = u.pm * BM + wr * 64 + fr;
#pragma unroll
        for (int ai = 0; ai < 2; ++ai)
#pragma unroll
            for (int m = 0; m < 4; ++m) { const int row = row0 + ai * HALF + m * 16; const float rs = SLOT ? rsx[row] : row_rs4(part, row, fq);
                const f32x4 g0 = acc[ai][0][m][0] * rs, g1 = acc[ai][0][m][1] * rs, u0 = acc[ai][1][m][0] * rs, u1 = acc[ai][1][m][1] * rs;
                *(u32x4*)(O + (size_t)row * ld + u.pn * 128 + wc * 32 + fq * 8) = pack8(g0 * sigm4(g0) * u0, g1 * sigm4(g1) * u1); }
    }
};
struct MoeOrder : StaticOrder {
    const int* blk_e; int ntile;
    __device__ bool next(int i, Unit& u) const { if (!StaticOrder::next(i, u)) return false; u.pb = blk_e[u.pm] * ntile + u.pn; return true; }
};
}

#define GAS __attribute__((address_space(1)))
#define LAS __attribute__((address_space(3)))
typedef unsigned short bf16;
typedef unsigned v4u __attribute__((ext_vector_type(4)));
typedef float f32x4 __attribute__((ext_vector_type(4)));
typedef short bf16x8 __attribute__((ext_vector_type(8)));
typedef GAS unsigned gu32;
typedef GAS unsigned long long gu64;
#define RLX_AGENT __ATOMIC_RELAXED, __HIP_MEMORY_SCOPE_AGENT
#define LDS_WAIT() asm volatile("s_waitcnt lgkmcnt(0)" ::: "memory")
#define VM_WAIT() asm volatile("s_waitcnt vmcnt(0)" ::: "memory")
__device__ __forceinline__ unsigned long long rt() { return __builtin_amdgcn_s_memrealtime(); }
__device__ __forceinline__ unsigned f2bf(float f) { unsigned u = __builtin_bit_cast(unsigned, f); return (u + 0x7fffu + ((u >> 16) & 1u)) >> 16; }
__device__ __forceinline__ unsigned pk2(float lo, float hi) { return f2bf(lo) | (f2bf(hi) << 16); }

#define XB_TMO      128
#define XB_XCNT(j)  (256  + 64 * (j))
#define XB_XSUB(j)  (1280 + 64 * (j))
#define XB_XGEN(j)  (2304 + 64 * (j))
#define XB_TOP      3328
#define XB_TOPGEN   3392
#define XCD_BAR_WORDS 3456
#define XB_SPIN_CAP (1u << 18)

__device__ __forceinline__ unsigned xb_ld(unsigned* p)              { return __hip_atomic_load(p, __ATOMIC_RELAXED, __HIP_MEMORY_SCOPE_AGENT); }
__device__ __forceinline__ unsigned xb_add(unsigned* p, unsigned v) { return __hip_atomic_fetch_add(p, v, __ATOMIC_RELAXED, __HIP_MEMORY_SCOPE_AGENT); }
__device__ __forceinline__ unsigned xb_xcc_id() { return (unsigned)__builtin_amdgcn_s_getreg((3 << 11) | 20) & 0xFu; }
#define XB_SPIN(cond, bar) do { unsigned _sp = 0; while (cond) { __builtin_amdgcn_s_sleep(1); \
    if ((++_sp & 255u) == 0u) { if (xb_ld(&(bar)[XB_TMO])) break; if (_sp > XB_SPIN_CAP) { atomicAdd(&(bar)[XB_TMO], 1u); break; } } } } while (0)

struct XcdBarrier {
    unsigned* bar; unsigned x;
    volatile LAS unsigned* st;
};

__device__ __forceinline__ XcdBarrier xcd_barrier_post(unsigned* bar, volatile LAS unsigned* st) {
    XcdBarrier b; b.bar = bar; b.x = xb_xcc_id(); b.st = st;
    if (threadIdx.x == 0) (void)xb_add(&bar[XB_XCNT(b.x)], 1u);
    return b;
}
__device__ __forceinline__ void xcd_barrier_complete(unsigned* bar, unsigned x, unsigned& nloc, unsigned& nx) {
    const unsigned G = gridDim.x * gridDim.y * gridDim.z;
    unsigned sum, cnt, mine, sp = 0u;
    for (;;) {
        sum = 0u; cnt = 0u; mine = 0u;
#pragma unroll 1
        for (unsigned j = 0; j < 16; ++j) { const unsigned c = xb_ld(&bar[XB_XCNT(j)]); sum += c; cnt += (c > 0u) ? 1u : 0u; mine = (j == x) ? c : mine; }
        if (sum == G) break;
        __builtin_amdgcn_s_sleep(1);
        if ((++sp & 255u) == 0u) { if (xb_ld(&bar[XB_TMO])) break; if (sp > XB_SPIN_CAP) { atomicAdd(&bar[XB_TMO], 1u); break; } }
    }
    nloc = mine > 0u ? mine : 1u; nx = cnt > 0u ? cnt : 1u;
}

__device__ __forceinline__ void xcd_barrier(const XcdBarrier& b) {
    asm volatile("s_waitcnt vmcnt(0)" ::: "memory");
    __syncthreads();
    if (threadIdx.x == 0) {
        unsigned* bar = b.bar;
        __builtin_amdgcn_s_waitcnt(0);
        unsigned nloc = b.st[0], nx = b.st[1];
        if (nloc == 0u) { xcd_barrier_complete(bar, b.x, nloc, nx); b.st[0] = nloc; b.st[1] = nx; }
        const unsigned old = xb_add(&bar[XB_XSUB(b.x)], 1u);
        const unsigned gen = old / nloc;
        if (old + 1u == (gen + 1u) * nloc) {
            __builtin_amdgcn_fence(__ATOMIC_RELEASE, "agent");
            asm volatile("s_waitcnt vmcnt(0)" ::: "memory");
            const unsigned og = xb_add(&bar[XB_TOP], 1u);
            const unsigned tg = og / nx;
            if (og + 1u == (tg + 1u) * nx) xb_add(&bar[XB_TOPGEN], 1u);
            else XB_SPIN(xb_ld(&bar[XB_TOPGEN]) == tg, bar);
            __builtin_amdgcn_fence(__ATOMIC_ACQUIRE, "agent");
            xb_add(&bar[XB_XGEN(b.x)], 1u);
            asm volatile("s_waitcnt vmcnt(0)" ::: "memory");
        } else {
            XB_SPIN(xb_ld(&bar[XB_XGEN(b.x)]) == gen, bar);
            __builtin_amdgcn_fence(__ATOMIC_ACQUIRE, "agent");
            asm volatile("s_waitcnt vmcnt(0)" ::: "memory");
        }
    }
    __syncthreads();
}


constexpr int NWAVES = 8;
constexpr int T = 32768, D = 1024, SEQ = 8192, DEPTH = 4, PLE_DIM = 256, CONV_DIM = 512, CONV_W = 31, RH = 8, RDK = 64, RDV = 128, RC = 128;
constexpr int DFF = 2816, NEXP = 8, EFF = 3584, IN_COLS = 6144;
constexpr int NCH = SEQ / RC;
constexpr int NUNIT = (T / RC) * RH;
constexpr int MOE_ROWS = 67584;
constexpr float EPS = 1e-6f;

constexpr size_t MiB = 1u << 20;
constexpr size_t WS_CTL = 0, CTL_ZERO_BYTES = 1 * MiB;
constexpr size_t WS_COS = 1 * MiB, WS_SIN = 2 * MiB, WS_COST = 3 * MiB, WS_SINT = 4 * MiB;
constexpr size_t WS_PART = 5 * MiB, WS_PARTN = 9 * MiB;
constexpr size_t WS_MOE = 7 * MiB;
constexpr size_t MO_TOKE = 0, MO_TOKG = 256 * 1024, MO_TOKRS = 512 * 1024, MO_SLOT = 640 * 1024, MO_RSX = 896 * 1024, MO_CNT = 1280 * 1024, MO_BLK = 1296 * 1024;
constexpr size_t WS_WIN = 16 * MiB, WS_WKVT = 56 * MiB, WS_WCO = 68 * MiB, WS_WRO = 72 * MiB, WS_WO = 80 * MiB, WS_WDGU = 88 * MiB, WS_WDD = 110 * MiB, WS_WPG = 121 * MiB, WS_WPP = 129 * MiB;
constexpr size_t WS_WEGU = 131 * MiB, WS_WED = 243 * MiB;
constexpr size_t WS_XB = 299 * MiB, WS_PB = 363 * MiB, WS_ACT = 427 * MiB;
constexpr size_t WS_Z = WS_ACT, WS_Q = WS_ACT + 32 * MiB, WS_K = WS_ACT + 64 * MiB, WS_KZT = WS_ACT + 96 * MiB, WS_VT = WS_ACT + 128 * MiB, WS_SG = WS_ACT + 192 * MiB, WS_SGA = WS_ACT + 256 * MiB,
                 WS_SGB = WS_ACT + 320 * MiB, WS_C = WS_ACT + 384 * MiB, WS_KVT = WS_ACT + 416 * MiB, WS_ST = WS_ACT + 480 * MiB, WS_MG = WS_ACT + 512 * MiB;
constexpr size_t WS_FA = WS_ACT;
constexpr size_t WS_XG = WS_ACT, WS_EA = WS_ACT + 132 * MiB;
constexpr size_t WS_PP = WS_ACT;
constexpr size_t WS_XBN = WS_MG;
constexpr size_t WS_END = WS_EA + 462 * MiB;
static_assert(WS_MG + 64 * MiB <= WS_END && WS_END == 1021 * MiB, "ws map");
constexpr int CW_TMO = 0, CW_BAR = 4096;

constexpr int RING_OFF = 0, RING_BYTES = 131072;
constexpr int LDSCTL_OFF = RING_BYTES, MISC_OFF = LDSCTL_OFF + 320, PTAB_OFF = LDSCTL_OFF + 512, JOB_OFF = LDSCTL_OFF + 1024;
constexpr int LDS_BYTES = 147456;

__device__ __forceinline__ float wave_sum(float v) {
#pragma unroll
    for (int o = 1; o < 64; o <<= 1) v += __shfl_xor(v, o);
    return v;
}
using pg8::sigm; using pg8::log2g; using pg8::kLog2e;

__device__ __forceinline__ void job_map(int map, int b, int& col, bool& second) {
    const int t = b >> 3, jb = b & 7; second = false;
    if (map == 0) { col = 32 * b; }
    else if (map == 1) {
        if (t < 4) col = (jb < 4 ? 0 : 512) + 128 * t + 32 * (jb & 3);
        else if (t < 8) { const int base = 1024 + 512 * ((t - 4) >> 1), head = 4 * ((t - 4) & 1) + (jb & 3); col = base + head * 64 + (jb < 4 ? 0 : 32); }
        else col = 3072 + 256 * (t - 8) + 32 * jb;
    } else if (map == 2) {
        if (t < 2) { const int head = 4 * t + (jb & 3); col = 1536 + head * 64 + (jb < 4 ? 0 : 32); }
        else col = 2048 + 256 * (t - 2) + 32 * jb;
    } else { second = jb >= 4; col = 128 * t + 32 * (jb & 3); }
}
__device__ __forceinline__ void conv_item(const float* src, const float* src2, const float* gain, bf16* WT, int ldw, int K, int NB, int map, int r, LAS float* scr, int lane) {
    const int kb = r / NB, b = r % NB, k0 = 64 * kb; int col; bool second; job_map(map, b, col, second);
    const float* W = second ? src2 : src;
#pragma unroll 8
    for (int i = 0; i < 32; ++i) { const int kk = 2 * i + (lane >> 5); float v = W[(size_t)(k0 + kk) * ldw + col + (lane & 31)]; if (gain) v *= gain[k0 + kk]; scr[kk * 33 + (lane & 31)] = v; }
    LDS_WAIT(); asm volatile("" ::: "memory");
    const int c = lane & 7;
#pragma unroll
    for (int q = 0; q < 4; ++q) { const int n = (lane >> 3) + 8 * q; const LAS float* sp = scr + (8 * c) * 33 + n;
        v4u o; o.x = pk2(sp[0 * 33], sp[1 * 33]); o.y = pk2(sp[2 * 33], sp[3 * 33]); o.z = pk2(sp[4 * 33], sp[5 * 33]); o.w = pk2(sp[6 * 33], sp[7 * 33]);
        *(GAS v4u*)(WT + (size_t)(b * 32 + n) * K + k0 + 8 * c) = o; }
    LDS_WAIT(); asm volatile("" ::: "memory");
}

struct Args { const float* in[23]; float* out; unsigned char* ws; int l_lo, l_hi, ph_lo, ph_hi, fused, pad; };
enum { PH_A = 0, PH_B, PH_C, PH_D, PH_E, PH_F, PH_G, PH_H, PH_G1, PH_G2, PH_CMB, PH_I, PH_N };

__device__ __forceinline__ bool ph_in(int lo, int hi, int k) { asm volatile("" : "+s"(lo), "+s"(hi)); return lo <= k && k < hi; }
__device__ __forceinline__ const float* inp_ptr(LAS unsigned char* lds, int k) {
    const volatile LAS unsigned* pt = (const volatile LAS unsigned*)(lds + PTAB_OFF) + 2 * k;
    const unsigned lo = __builtin_amdgcn_readfirstlane(pt[0]), hi = __builtin_amdgcn_readfirstlane(pt[1]);
    return (const float*)(((unsigned long long)hi << 32) | lo);
}
__global__ void __launch_bounds__(NWAVES * 64, 2) hybrid_fwd(Args args) {
    extern __shared__ __attribute__((aligned(16))) unsigned char lds_raw[];
    LAS unsigned char* lds = (LAS unsigned char*)lds_raw;
    volatile LAS unsigned* MISC = (volatile LAS unsigned*)(lds + MISC_OFF);
    const int tid0 = threadIdx.x;
    unsigned char* const ws0 = args.ws; float* const X0 = args.out;
    gu32* ctl = (gu32*)(ws0 + WS_CTL);
#define PHASE_VIEW() unsigned char* ws = ws0; float* X = X0; int tid = threadIdx.x, G = gridDim.x, bx = blockIdx.x; asm volatile("" : "+s"(ws), "+s"(X), "+v"(tid), "+s"(G), "+s"(bx)); \
    const int lane = tid & 63, wave = __builtin_amdgcn_readfirstlane(tid >> 6), gw = bx * NWAVES + wave, NGW = G * NWAVES; (void)lane; (void)wave; (void)gw; (void)NGW; \
    bf16* XB = (bf16*)(ws + WS_XB); bf16* XBN = (bf16*)(ws + WS_XBN); float* PART = (float*)(ws + WS_PART); float* PARTN = (float*)(ws + WS_PARTN); \
    (void)XB; (void)XBN; (void)PART; (void)PARTN; (void)X

    for (int u = tid0; u < (LDS_BYTES - LDSCTL_OFF) / 4; u += NWAVES * 64) ((LAS unsigned*)(lds + LDSCTL_OFF))[u] = 0u;
    __syncthreads();
    if (tid0 == 0) { LAS unsigned long long* pt = (LAS unsigned long long*)(lds + PTAB_OFF);
#pragma unroll
        for (int k = 0; k < 23; ++k) pt[k] = (unsigned long long)args.in[k]; }
    __syncthreads();
#define INP(k) inp_ptr(lds, (k))
    XcdBarrier bar; bar.bar = (unsigned*)(ctl + CW_BAR); bar.x = 0; bar.st = nullptr;
    if (args.fused) bar = xcd_barrier_post((unsigned*)(ctl + CW_BAR), MISC + 8);
#define GRID_BAR() do { if (args.fused) xcd_barrier(bar); } while (0)
    const int l_lo = args.l_lo, l_hi = args.l_hi, ph_lo = args.ph_lo, ph_hi = args.ph_hi;
#define IN(k) ph_in(ph_lo, ph_hi, (k))

    if (l_lo < 0) { PHASE_VIEW();
        {   LAS float* scr = (LAS float*)(lds + RING_OFF + wave * 16384);
            constexpr int I_IN = 16 * 160, I_KV = 16 * 48, I_CO = 8 * 32, I_SQ = 16 * 32, I_PP = 4 * 32, I_DG = 16 * 176, I_DD = 44 * 32;
            constexpr int I_LAYER = I_IN + I_KV + I_CO + 3 * I_SQ + I_PP + I_DG + I_DD;
            for (int it = gw; it < DEPTH * I_LAYER; it += NGW) {
                const int L = it / I_LAYER; int r = it % I_LAYER; const int j = L >> 1;
                if (r < I_IN) { conv_item(INP(3) + (size_t)L * D * IN_COLS, nullptr, INP(2) + L * D, (bf16*)(ws + WS_WIN) + (size_t)L * 5120 * D, IN_COLS, D, 160, 1, r, scr, lane); continue; } r -= I_IN;
                if (r < I_KV) { conv_item(INP(3) + (size_t)L * D * IN_COLS, nullptr, INP(2) + L * D, (bf16*)(ws + WS_WKVT) + (size_t)L * 1536 * D, IN_COLS, D, 48, 2, r, scr, lane); continue; } r -= I_KV;
                if (r < I_CO) { conv_item(INP(8) + (size_t)L * CONV_DIM * D, nullptr, nullptr, (bf16*)(ws + WS_WCO) + (size_t)L * D * CONV_DIM, D, CONV_DIM, 32, 0, r, scr, lane); continue; } r -= I_CO;
                if (r < I_SQ) { conv_item(INP(9) + (size_t)L * D * D, nullptr, nullptr, (bf16*)(ws + WS_WRO) + (size_t)L * D * D, D, D, 32, 0, r, scr, lane); continue; } r -= I_SQ;
                if (r < I_SQ) { conv_item(INP(10) + (size_t)L * D * D, nullptr, nullptr, (bf16*)(ws + WS_WO) + (size_t)L * D * D, D, D, 32, 0, r, scr, lane); continue; } r -= I_SQ;
                if (r < I_SQ) { conv_item(INP(20) + (size_t)L * D * D, nullptr, INP(19) + L * D, (bf16*)(ws + WS_WPG) + (size_t)L * D * D, D, D, 32, 0, r, scr, lane); continue; } r -= I_SQ;
                if (r < I_PP) { conv_item(INP(21) + (size_t)L * PLE_DIM * D, nullptr, nullptr, (bf16*)(ws + WS_WPP) + (size_t)L * D * PLE_DIM, D, PLE_DIM, 32, 0, r, scr, lane); continue; } r -= I_PP;
                if (L & 1) continue;
                if (r < I_DG) { conv_item(INP(12) + (size_t)j * D * DFF, INP(13) + (size_t)j * D * DFF, INP(11) + L * D, (bf16*)(ws + WS_WDGU) + (size_t)j * 2 * DFF * D, DFF, D, 176, 3, r, scr, lane); continue; } r -= I_DG;
                conv_item(INP(14) + (size_t)j * DFF * D, nullptr, nullptr, (bf16*)(ws + WS_WDD) + (size_t)j * D * DFF, D, DFF, 32, 0, r, scr, lane);
            }
        }
        for (int m = gw; m < T; m += NGW) {
            const GAS f32x4* xr = (const GAS f32x4*)(INP(0) + (size_t)m * D) + lane; GAS f32x4* xo = (GAS f32x4*)(X + (size_t)m * D) + lane;
            GAS unsigned long long* o8 = (GAS unsigned long long*)(XBN + (size_t)m * D) + lane; float s = 0.f;
#pragma unroll
            for (int j = 0; j < 4; ++j) { const f32x4 v = xr[64 * j]; xo[64 * j] = v; s += (v.x * v.x + v.y * v.y) + (v.z * v.z + v.w * v.w);
                o8[64 * j] = (unsigned long long)pk2(v.x, v.y) | ((unsigned long long)pk2(v.z, v.w) << 32); }
            s = wave_sum(s);
            if (lane < 16) PARTN[(size_t)m * 16 + lane] = lane == 0 ? s : 0.f;
        }
        { const size_t n4 = (size_t)DEPTH * T * PLE_DIM / 4; const GAS f32x4* ps = (const GAS f32x4*)INP(1); GAS unsigned long long* pd = (GAS unsigned long long*)(ws + WS_PB);
          for (size_t i = (size_t)bx * 512 + tid; i < n4; i += (size_t)G * 512) { const f32x4 v = ps[i]; pd[i] = (unsigned long long)pk2(v.x, v.y) | ((unsigned long long)pk2(v.z, v.w) << 32); } }
        for (int i = bx * 512 + tid; i < SEQ * 32; i += G * 512) { const int pos = i >> 5, d = i & 31;
            const float inv = exp2f(-(float)d * 0.41524101186092029f);
            const float ang = (float)pos * inv; const double rev = (double)ang * 0.15915494309189535; const float fr = (float)(rev - rint(rev));
            const float sn = __builtin_amdgcn_sinf(fr), cs = __builtin_amdgcn_cosf(fr);
            ((float*)(ws + WS_COS))[i] = cs; ((float*)(ws + WS_SIN))[i] = sn; ((float*)(ws + WS_COST))[d * SEQ + pos] = cs; ((float*)(ws + WS_SINT))[d * SEQ + pos] = sn; }
        GRID_BAR();
    }

    if (0 >= l_lo && 0 < l_hi) { constexpr int L = 0;
        const bool moe = (L & 1) != 0; const int jl = L >> 1;
#define MOE_VIEW() int* tok_e = (int*)(ws + WS_MOE + MO_TOKE); float* tok_g = (float*)(ws + WS_MOE + MO_TOKG); float* tok_rs = (float*)(ws + WS_MOE + MO_TOKRS); \
            int* tok_slot = (int*)(ws + WS_MOE + MO_SLOT); float* rsx = (float*)(ws + WS_MOE + MO_RSX); int* cnts = (int*)(ws + WS_MOE + MO_CNT); int* blk = (int*)(ws + WS_MOE + MO_BLK); \
            bf16* XG = (bf16*)(ws + WS_XG); bf16* EA = (bf16*)(ws + WS_EA); \
            (void)tok_e; (void)tok_g; (void)tok_rs; (void)tok_slot; (void)rsx; (void)cnts; (void)blk; (void)XG; (void)EA
#define MIX_VIEW() bf16* Zb = (bf16*)(ws + WS_Z); bf16* Qb = (bf16*)(ws + WS_Q); bf16* Kb = (bf16*)(ws + WS_K); bf16* KZT = (bf16*)(ws + WS_KZT); bf16* VT = (bf16*)(ws + WS_VT); \
        bf16* SG = (bf16*)(ws + WS_SG); bf16* SGA = (bf16*)(ws + WS_SGA); bf16* SGB = (bf16*)(ws + WS_SGB); bf16* Cb = (bf16*)(ws + WS_C); \
        float* KVT = (float*)(ws + WS_KVT); bf16* ST = (bf16*)(ws + WS_ST); bf16* MG = (bf16*)(ws + WS_MG); \
        (void)Zb; (void)Qb; (void)Kb; (void)KZT; (void)VT; (void)SG; (void)SGA; (void)SGB; (void)Cb; (void)KVT; (void)ST; (void)MG

        if (IN(PH_A)) { PHASE_VIEW(); MIX_VIEW();
            { pg8::Gemm g{XBN, (const bf16*)(ws + WS_WIN) + (size_t)L * 5120 * D, T, 5120, D}; pg8::StaticOrder S; S.init(T, 5120, G, bx);
              pg8::EpiIn E{PARTN, (const float*)(ws + WS_COS), (const float*)(ws + WS_SIN), Zb, Qb, SG};
              static_assert(WS_K - WS_Q == 2 * pg8::EpiIn::QK_STRIDE && WS_SGA - WS_SG == 2 * pg8::EpiIn::G_STRIDE && WS_SGB - WS_SGA == 2 * pg8::EpiIn::G_STRIDE, "EpiIn strides");
              pg8::gemm_phase<pg8::EpiIn, pg8::StaticOrder, true, true>(lds + RING_OFF, g, S, E); }
            { pg8::Gemm g{(const bf16*)(ws + WS_WKVT) + (size_t)L * 1536 * D, XBN, 1536, T, D}; pg8::StaticOrder S; S.init(1536, T, G, bx);
              pg8::EpiKvT E{PARTN, (const float*)(ws + WS_COST), (const float*)(ws + WS_SINT), KZT, VT};
              pg8::gemm_phase<pg8::EpiKvT, pg8::StaticOrder, true, true>(lds + RING_OFF, g, S, E); }
            GRID_BAR();
        }

        if (IN(PH_B)) { PHASE_VIEW(); MIX_VIEW();
            {
                const float* cw = INP(4) + (size_t)L * CONV_W * CONV_DIM; const float* cb = INP(5) + L * CONV_DIM;
                const float* lg = INP(6) + L * CONV_DIM; const float* lb = INP(7) + L * CONV_DIM;
                LAS unsigned* zt = (LAS unsigned*)(lds + RING_OFF);
                LAS float* ot = (LAS float*)(lds + RING_OFF + 65536);
                const int cp = tid & 255, half = tid >> 8;
                float w0[CONV_W], w1[CONV_W];
#pragma unroll
                for (int w = 0; w < CONV_W; ++w) { w0[w] = cw[w * CONV_DIM + 2 * cp]; w1[w] = cw[w * CONV_DIM + 2 * cp + 1]; }
                const float b0 = cb[2 * cp], b1 = cb[2 * cp + 1];
                f32x4 lg0 = *(const f32x4*)(lg + 8 * lane), lg1 = *(const f32x4*)(lg + 8 * lane + 4), lb0 = *(const f32x4*)(lb + 8 * lane), lb1 = *(const f32x4*)(lb + 8 * lane + 4);
                for (int u = bx; u < T / 32; u += G) {
                    const int tok0 = u * 32, pos0 = tok0 & (SEQ - 1);
                    for (int idx = tid; idx < 62 * 64; idx += 512) { const int r = idx >> 6, ch = idx & 63; const int pos = pos0 - 30 + r;
                        v4u v = {0u, 0u, 0u, 0u}; if (pos >= 0) v = *(const GAS v4u*)(Zb + (size_t)(tok0 - 30 + r) * CONV_DIM + ch * 8);
                        *(LAS v4u*)(zt + r * 256 + ch * 4) = v; }
                    __syncthreads();
#pragma unroll 1
                    for (int tg = 0; tg < 2; ++tg) { const int tb = 16 * half + 8 * tg;
                        float a0[8], a1[8];
#pragma unroll
                        for (int q = 0; q < 8; ++q) { a0[q] = b0; a1[q] = b1; }
#pragma unroll
                        for (int r = 0; r < 38; ++r) { const unsigned pv = zt[(tb + r) * 256 + cp]; const float f0 = __uint_as_float(pv << 16), f1 = __uint_as_float(pv & 0xffff0000u);
#pragma unroll
                            for (int q = 0; q < 8; ++q) { const int w = r - q; if (w >= 0 && w < CONV_W) { a0[q] = fmaf(w0[w], f0, a0[q]); a1[q] = fmaf(w1[w], f1, a1[q]); } } }
#pragma unroll
                        for (int q = 0; q < 8; ++q) { typedef float f2 __attribute__((ext_vector_type(2))); *(LAS f2*)(ot + (tb + q) * 512 + 2 * cp) = (f2){a0[q], a1[q]}; } }
                    __syncthreads();
#pragma unroll 1
                    for (int q = 0; q < 4; ++q) { const int tk = 4 * wave + q; const LAS f32x4* op = (const LAS f32x4*)(ot + tk * 512 + 8 * lane); f32x4 v0 = op[0], v1 = op[1];
                        const float mean = wave_sum((v0.x + v0.y) + (v0.z + v0.w) + (v1.x + v1.y) + (v1.z + v1.w)) * (1.0f / 512.0f);
                        v0 = v0 - mean; v1 = v1 - mean;
                        const float var = wave_sum((v0.x * v0.x + v0.y * v0.y) + (v0.z * v0.z + v0.w * v0.w) + (v1.x * v1.x + v1.y * v1.y) + (v1.z * v1.z + v1.w * v1.w)) * (1.0f / 512.0f);
                        const float rstd = __builtin_amdgcn_rsqf(var + EPS);
                        v0 = v0 * rstd * lg0 + lb0; v1 = v1 * rstd * lg1 + lb1;
                        v0 = v0 * pg8::sigm4(v0); v1 = v1 * pg8::sigm4(v1);
                        *(GAS v4u*)(Cb + (size_t)(tok0 + tk) * CONV_DIM + 8 * lane) = pg8::pack8(v0, v1); }
                    __syncthreads();
                }
            }
            {
                const int fr = lane & 15, g4 = lane >> 4;
                for (int u = bx; u < NUNIT; u += G) {
                    const int n = u & 63, bh = u >> 6, h = bh & 7, b = bh >> 3; const size_t tok0 = (size_t)b * SEQ + n * RC;
                    bf16x8 Bv[4];
#pragma unroll
                    for (int ks = 0; ks < 4; ++ks) Bv[ks] = *(const GAS bf16x8*)(VT + (size_t)(h * RDV + 16 * wave + fr) * T + tok0 + 32 * ks + 8 * g4);
#pragma unroll
                    for (int dkt = 0; dkt < 4; ++dkt) { f32x4 acc = {0.f, 0.f, 0.f, 0.f};
#pragma unroll
                        for (int ks = 0; ks < 4; ++ks) { const bf16x8 Ak = *(const GAS bf16x8*)(KZT + (size_t)(h * RDK + 16 * dkt + fr) * T + tok0 + 32 * ks + 8 * g4);
                            acc = __builtin_amdgcn_mfma_f32_16x16x32_bf16(Ak, Bv[ks], acc, 0, 0, 0); }
                        *(GAS f32x4*)(KVT + (size_t)u * (RDV * RDK) + (16 * wave + fr) * RDK + 16 * dkt + 4 * g4) = acc; }
                }
            }
            if (moe) {
                __syncthreads();
                LAS float* scr = (LAS float*)(lds + RING_OFF + wave * 16384);
                constexpr int I_GU = 16 * 224, I_DN = 56 * 32, I_EXP = I_GU + I_DN;
                for (int it = gw; it < NEXP * I_EXP; it += NGW) { const int e = it / I_EXP, r = it % I_EXP; const size_t o = ((size_t)jl * NEXP + e) * D * EFF;
                    if (r < I_GU) conv_item(INP(16) + o, INP(17) + o, INP(11) + L * D, (bf16*)(ws + WS_WEGU) + (size_t)e * 2 * EFF * D, EFF, D, 224, 3, r, scr, lane);
                    else conv_item(INP(18) + o, nullptr, nullptr, (bf16*)(ws + WS_WED) + (size_t)e * D * EFF, D, EFF, 32, 0, r - I_GU, scr, lane); }
            }
            GRID_BAR();
        }

        if (IN(PH_C)) { PHASE_VIEW(); MIX_VIEW();
            {   const int gt = bx * 512 + tid;
                if (gt < 32 * 4096) { const int bh = gt >> 12, e2 = gt & 4095, h = bh & 7; const float gc = __builtin_amdgcn_exp2f(128.0f * log2g(h));
                    float s0 = 0.f, s1 = 0.f; typedef float f2 __attribute__((ext_vector_type(2)));
                    const GAS f2* kv = (const GAS f2*)(KVT + (size_t)bh * NCH * (RDV * RDK)) + e2; GAS unsigned* st = (GAS unsigned*)(ST + (size_t)bh * NCH * (RDV * RDK)) + e2;
#pragma unroll 8
                    for (int n = 0; n < NCH; ++n) { const f2 v = kv[(size_t)n * 4096]; st[(size_t)n * 4096] = pk2(s0, s1); s0 = fmaf(gc, s0, v.x); s1 = fmaf(gc, s1, v.y); } }
            }
            { pg8::Gemm g{Cb, (const bf16*)(ws + WS_WCO) + (size_t)L * D * CONV_DIM, T, D, CONV_DIM}; pg8::StaticOrder S; S.init(T, D, G, bx);
              pg8::EpiGate<false> E{SGA, MG};
              pg8::gemm_phase<pg8::EpiGate<false>, pg8::StaticOrder, true, true>(lds + RING_OFF, g, S, E); }
            GRID_BAR();
        }

        if (IN(PH_D)) { PHASE_VIEW(); MIX_VIEW();
            const int fr = lane & 15, g4 = lane >> 4;
            for (int u = bx; u < NUNIT; u += G) {
                const int n = u & 63, bh = u >> 6, h = bh & 7, b = bh >> 3; const size_t tok0 = (size_t)b * SEQ + n * RC; const float lg = log2g(h);
                const size_t tok = tok0 + 16 * wave + fr;
                bf16x8 Bq[2];
#pragma unroll
                for (int ks = 0; ks < 2; ++ks) Bq[ks] = *(const GAS bf16x8*)(Qb + tok * 512 + h * RDK + 32 * ks + 8 * g4);
                unsigned P[8][2];
#pragma unroll
                for (int jt2 = 0; jt2 < 8; ++jt2) {
                    if (jt2 <= wave) { f32x4 s = {0.f, 0.f, 0.f, 0.f};
#pragma unroll
                        for (int ks = 0; ks < 2; ++ks) { const bf16x8 Ak = *(const GAS bf16x8*)(Kb + (tok0 + 16 * jt2 + fr) * 512 + h * RDK + 32 * ks + 8 * g4);
                            s = __builtin_amdgcn_mfma_f32_16x16x32_bf16(Ak, Bq[ks], s, 0, 0, 0); }
                        const int dd = (16 * wave + fr) - (16 * jt2 + 4 * g4);
                        const float d0 = dd >= 0 ? s.x * __builtin_amdgcn_exp2f((float)dd * lg) : 0.f, d1 = dd >= 1 ? s.y * __builtin_amdgcn_exp2f((float)(dd - 1) * lg) : 0.f;
                        const float d2 = dd >= 2 ? s.z * __builtin_amdgcn_exp2f((float)(dd - 2) * lg) : 0.f, d3 = dd >= 3 ? s.w * __builtin_amdgcn_exp2f((float)(dd - 3) * lg) : 0.f;
                        P[jt2][0] = pg8::cvt_pk_bf16(d0, d1); P[jt2][1] = pg8::cvt_pk_bf16(d2, d3);
                    } else { P[jt2][0] = 0u; P[jt2][1] = 0u; }
                }
                f32x4 oT[8], cT[8];
#pragma unroll
                for (int dvt = 0; dvt < 8; ++dvt) { oT[dvt] = (f32x4){0.f, 0.f, 0.f, 0.f}; cT[dvt] = (f32x4){0.f, 0.f, 0.f, 0.f}; }
#pragma unroll
                for (int t2 = 0; t2 < 4; ++t2) {
                    if (2 * t2 <= wave) {
                        typedef unsigned u2 __attribute__((ext_vector_type(2)));
                        v4u bp; bp.x = P[2 * t2][0]; bp.y = P[2 * t2][1]; bp.z = P[2 * t2 + 1][0]; bp.w = P[2 * t2 + 1][1];
                        const bf16x8 Bp = __builtin_bit_cast(bf16x8, bp);
#pragma unroll
                        for (int dvt = 0; dvt < 8; ++dvt) { const GAS bf16* vp = (const GAS bf16*)VT + (size_t)(h * RDV + 16 * dvt + fr) * T + tok0 + 32 * t2 + 4 * g4;
                            const u2 lo = *(const GAS u2*)vp, hi = *(const GAS u2*)(vp + 16); v4u av; av.x = lo.x; av.y = lo.y; av.z = hi.x; av.w = hi.y;
                            oT[dvt] = __builtin_amdgcn_mfma_f32_16x16x32_bf16(__builtin_bit_cast(bf16x8, av), Bp, oT[dvt], 0, 0, 0); }
                    }
                }
#pragma unroll
                for (int dvt = 0; dvt < 8; ++dvt)
#pragma unroll
                    for (int ks = 0; ks < 2; ++ks) { const bf16x8 As = *(const GAS bf16x8*)(ST + (size_t)u * (RDV * RDK) + (16 * dvt + fr) * RDK + 32 * ks + 8 * g4);
                        cT[dvt] = __builtin_amdgcn_mfma_f32_16x16x32_bf16(As, Bq[ks], cT[dvt], 0, 0, 0); }
                const float xi = __builtin_amdgcn_exp2f((float)(16 * wave + fr + 1) * lg);
                float sm = 0.f;
#pragma unroll
                for (int dvt = 0; dvt < 8; ++dvt) { oT[dvt] = oT[dvt] + cT[dvt] * xi; sm += (oT[dvt].x + oT[dvt].y) + (oT[dvt].z + oT[dvt].w); }
                sm += __shfl_xor(sm, 16); sm += __shfl_xor(sm, 32);
                const float mean = sm * (1.0f / 128.0f); float sq = 0.f;
#pragma unroll
                for (int dvt = 0; dvt < 8; ++dvt) { oT[dvt] = oT[dvt] - mean; sq += (oT[dvt].x * oT[dvt].x + oT[dvt].y * oT[dvt].y) + (oT[dvt].z * oT[dvt].z + oT[dvt].w * oT[dvt].w); }
                sq += __shfl_xor(sq, 16); sq += __shfl_xor(sq, 32);
                const float rstd = __builtin_amdgcn_rsqf(sq * (1.0f / 128.0f) + EPS);
#pragma unroll
                for (int dvt = 0; dvt < 8; ++dvt) { typedef unsigned u2 __attribute__((ext_vector_type(2)));
                    GAS u2* gp = (GAS u2*)(SG + tok * 1024 + h * RDV + 16 * dvt + 4 * g4); const u2 gv = *gp; const f32x4 gf = pg8::bf_lo4(gv.x, gv.y);
                    const f32x4 r = oT[dvt] * rstd * gf; u2 o; o.x = pg8::cvt_pk_bf16(r.x, r.y); o.y = pg8::cvt_pk_bf16(r.z, r.w); *gp = o; }
            }
            GRID_BAR();
        }

        if (IN(PH_E)) { PHASE_VIEW(); MIX_VIEW();
            pg8::Gemm g{SG, (const bf16*)(ws + WS_WRO) + (size_t)L * D * D, T, D, D}; pg8::StaticOrder S; S.init(T, D, G, bx);
            pg8::EpiGate<true> E{SGB, MG};
            pg8::gemm_phase<pg8::EpiGate<true>, pg8::StaticOrder, true, true>(lds + RING_OFF, g, S, E);
            GRID_BAR();
        }

        if (IN(PH_F)) { PHASE_VIEW(); MIX_VIEW();
            pg8::Gemm g{MG, (const bf16*)(ws + WS_WO) + (size_t)L * D * D, T, D, D}; pg8::StaticOrder S; S.init(T, D, G, bx);
            pg8::EpiRes<false> E{X, XB, PART, nullptr, nullptr};
            pg8::gemm_phase<pg8::EpiRes<false>, pg8::StaticOrder, true, true>(lds + RING_OFF, g, S, E);
            GRID_BAR();
        }

        if (!moe) {
            if (IN(PH_G)) { PHASE_VIEW(); MOE_VIEW();
                pg8::Gemm g{XB, (const bf16*)(ws + WS_WDGU) + (size_t)jl * 2 * DFF * D, T, 2 * DFF, D}; pg8::StaticOrder S; S.init(T, 2 * DFF, G, bx);
                pg8::EpiSwi<false> E{PART, nullptr, (bf16*)(ws + WS_FA), DFF};
                pg8::gemm_phase<pg8::EpiSwi<false>, pg8::StaticOrder, true, true>(lds + RING_OFF, g, S, E);
                GRID_BAR();
            }
            if (IN(PH_H)) { PHASE_VIEW(); MOE_VIEW();
                pg8::Gemm g{(const bf16*)(ws + WS_FA), (const bf16*)(ws + WS_WDD) + (size_t)jl * D * DFF, T, D, DFF}; pg8::StaticOrder S; S.init(T, D, G, bx);
                pg8::EpiRes<false> E{X, XB, PART, nullptr, nullptr};
                pg8::gemm_phase<pg8::EpiRes<false>, pg8::StaticOrder, true, true>(lds + RING_OFF, g, S, E);
                GRID_BAR();
            }
        } else {
            if (IN(PH_G)) { PHASE_VIEW(); MOE_VIEW();
                LAS float* wrT = (LAS float*)(lds + RING_OFF);
                LAS int* lcnt = (LAS int*)(lds + RING_OFF + 32768);
                const float* wr = INP(15) + (size_t)jl * D * NEXP; const float* gf = INP(11) + L * D;
                for (int i = tid; i < D * NEXP; i += 512) { const int k = i >> 3, e = i & 7; wrT[e * 1024 + k] = wr[i] * gf[k]; }
                if (tid < 8) lcnt[tid] = 0;
                __syncthreads();
                for (int q = 0; q < 16; ++q) { const int t = bx * 128 + wave * 16 + q;
                    const GAS f32x4* xr = (const GAS f32x4*)(X + (size_t)t * D) + lane; f32x4 xv[4]; float ss = 0.f;
#pragma unroll
                    for (int j = 0; j < 4; ++j) { xv[j] = xr[64 * j]; ss += (xv[j].x * xv[j].x + xv[j].y * xv[j].y) + (xv[j].z * xv[j].z + xv[j].w * xv[j].w); }
                    float lgt[8];
#pragma unroll
                    for (int e = 0; e < 8; ++e) { float a = 0.f;
#pragma unroll
                        for (int j = 0; j < 4; ++j) { const f32x4 w = *(const LAS f32x4*)(wrT + e * 1024 + 256 * j + 4 * lane); a += (xv[j].x * w.x + xv[j].y * w.y) + (xv[j].z * w.z + xv[j].w * w.w); }
                        lgt[e] = wave_sum(a); }
                    ss = wave_sum(ss); const float rs = __builtin_amdgcn_rsqf(ss * (1.0f / 1024.0f) + EPS);
                    int e1 = 0; float v1 = lgt[0];
#pragma unroll
                    for (int e = 1; e < 8; ++e) if (lgt[e] > v1) { v1 = lgt[e]; e1 = e; }
                    int e2 = -1; float v2 = 0.f;
#pragma unroll
                    for (int e = 0; e < 8; ++e) if (e != e1 && (e2 < 0 || lgt[e] > v2)) { v2 = lgt[e]; e2 = e; }
                    const float ex = __builtin_amdgcn_exp2f((v2 - v1) * rs * kLog2e), g1 = 1.0f / (1.0f + ex), g2 = ex * g1;
                    if (lane == 0) { tok_e[2 * t] = e1; tok_e[2 * t + 1] = e2; tok_g[2 * t] = g1; tok_g[2 * t + 1] = g2; tok_rs[t] = rs; atomicAdd((int*)&lcnt[e1], 1); atomicAdd((int*)&lcnt[e2], 1); }
                }
                __syncthreads();
                if (tid < 8) cnts[bx * 8 + tid] = lcnt[tid];
                __syncthreads();
                GRID_BAR();
            }
            if (IN(PH_H)) { PHASE_VIEW(); MOE_VIEW();
                LAS int* lc = (LAS int*)(lds + RING_OFF);
                LAS int* base = lc + 2048;
                LAS int* lslot = base + 16;
                LAS int* le = lslot + 256;
                for (int i = tid; i < 2048; i += 512) lc[i] = cnts[i];
                if (tid < 256) le[tid] = tok_e[bx * 256 + tid];
                __syncthreads();
                {
                    int tot = 0, pre = 0;
#pragma unroll
                    for (int k = 0; k < 4; ++k) { const int wg = lane + 64 * k; const int c = lc[wg * 8 + wave]; tot += c; pre += (wg < bx) ? c : 0; }
#pragma unroll
                    for (int o = 1; o < 64; o <<= 1) { tot += __shfl_xor(tot, o); pre += __shfl_xor(pre, o); }
                    if (lane == 0) { base[wave] = pre; base[8 + wave] = tot; }
                }
                __syncthreads();
                if (tid == 0) { int ps = 0; for (int e = 0; e < 8; ++e) { const int tot = base[8 + e]; base[e] += ps; const int nb = (tot + 255) >> 8;
                        if (bx == 0) { for (int q = 0; q < nb; ++q) blk[1 + (ps >> 8) + q] = e; }
                        ps += nb << 8; }
                    if (bx == 0) blk[0] = ps >> 8; }
                __syncthreads();
                {
                    int run = base[wave];
#pragma unroll
                    for (int k = 0; k < 2; ++k) { const int i = lane + 64 * k; const int a = le[2 * i], b2 = le[2 * i + 1]; const bool f = (a == wave) || (b2 == wave);
                        const unsigned long long m = __ballot(f); const int rank = __popcll(m & ((1ull << lane) - 1ull));
                        if (f) lslot[2 * i + (a == wave ? 0 : 1)] = run + rank;
                        run += __popcll(m); }
                }
                __syncthreads();
                if (tid < 256) { const int t = bx * 128 + (tid >> 1); const int s = lslot[tid]; tok_slot[bx * 256 + tid] = s; rsx[s] = tok_rs[t]; }
                for (int p = wave; p < 256; p += 8) { const int t = bx * 128 + (p >> 1), s = lslot[p];
                    const GAS v4u* src = (const GAS v4u*)(XB + (size_t)t * D) + lane; GAS v4u* dst = (GAS v4u*)(XG + (size_t)s * D) + lane; dst[0] = src[0]; dst[64] = src[64]; }
                __syncthreads();
                GRID_BAR();
            }
            if (IN(PH_G1)) { PHASE_VIEW(); MOE_VIEW();
                const int nblk = blk[0];
                pg8::Gemm g{XG, (const bf16*)(ws + WS_WEGU), nblk * 256, 2 * EFF, D}; pg8::MoeOrder S; S.init(nblk * 256, 2 * EFF, G, bx); S.blk_e = blk + 1; S.ntile = 2 * EFF / 256;
                pg8::EpiSwi<true> E{nullptr, rsx, EA, EFF};
                pg8::gemm_phase<pg8::EpiSwi<true>, pg8::MoeOrder, true, true>(lds + RING_OFF, g, S, E);
                GRID_BAR();
            }
            if (IN(PH_G2)) { PHASE_VIEW(); MOE_VIEW();
                const int nblk = blk[0];
                pg8::Gemm g{EA, (const bf16*)(ws + WS_WED), nblk * 256, D, EFF}; pg8::MoeOrder S; S.init(nblk * 256, D, G, bx); S.blk_e = blk + 1; S.ntile = D / 256;
                pg8::EpiStore E{XG, D};
                pg8::gemm_phase<pg8::EpiStore, pg8::MoeOrder, true, true>(lds + RING_OFF, g, S, E);
                GRID_BAR();
            }
            if (IN(PH_CMB)) { PHASE_VIEW(); MOE_VIEW();
                for (int t = gw; t < T; t += NGW) {
                    const int s1 = tok_slot[2 * t], s2 = tok_slot[2 * t + 1]; const float g1 = tok_g[2 * t], g2 = tok_g[2 * t + 1];
                    GAS f32x4* xr = (GAS f32x4*)(X + (size_t)t * D) + lane; typedef unsigned u2 __attribute__((ext_vector_type(2)));
                    const GAS u2* y1 = (const GAS u2*)(XG + (size_t)s1 * D) + lane; const GAS u2* y2 = (const GAS u2*)(XG + (size_t)s2 * D) + lane;
                    GAS unsigned long long* o8 = (GAS unsigned long long*)(XB + (size_t)t * D) + lane; float s = 0.f;
#pragma unroll
                    for (int j = 0; j < 4; ++j) { f32x4 v = xr[64 * j]; const u2 a = y1[64 * j], b2 = y2[64 * j];
                        v = v + (pg8::bf_lo4(a.x, a.y) * g1 + pg8::bf_lo4(b2.x, b2.y) * g2); xr[64 * j] = v; s += (v.x * v.x + v.y * v.y) + (v.z * v.z + v.w * v.w);
                        o8[64 * j] = (unsigned long long)pk2(v.x, v.y) | ((unsigned long long)pk2(v.z, v.w) << 32); }
                    s = wave_sum(s);
                    if (lane < 16) PART[(size_t)t * 16 + lane] = lane == 0 ? s : 0.f;
                }
                GRID_BAR();
            }
        }

        if (IN(PH_I)) { PHASE_VIEW(); MIX_VIEW();
            bf16* PP = (bf16*)(ws + WS_PP);
            { pg8::Gemm g{(const bf16*)(ws + WS_PB) + (size_t)L * T * PLE_DIM, (const bf16*)(ws + WS_WPP) + (size_t)L * D * PLE_DIM, T, D, PLE_DIM}; pg8::StaticOrder S; S.init(T, D, G, bx);
              pg8::EpiStore E{PP, D};
              pg8::gemm_phase<pg8::EpiStore, pg8::StaticOrder, true, true>(lds + RING_OFF, g, S, E); }
            { pg8::Gemm g{XB, (const bf16*)(ws + WS_WPG) + (size_t)L * D * D, T, D, D}; pg8::StaticOrder S; S.init(T, D, G, bx);
              pg8::EpiRes<true> E{X, XBN, PARTN, PART, PP};
              pg8::gemm_phase<pg8::EpiRes<true>, pg8::StaticOrder, true, true>(lds + RING_OFF, g, S, E); }
            GRID_BAR();
        }
    }
    if (1 >= l_lo && 1 < l_hi) { constexpr int L = 1;
        const bool moe = (L & 1) != 0; const int jl = L >> 1;
#define MOE_VIEW() int* tok_e = (int*)(ws + WS_MOE + MO_TOKE); float* tok_g = (float*)(ws + WS_MOE + MO_TOKG); float* tok_rs = (float*)(ws + WS_MOE + MO_TOKRS); \
            int* tok_slot = (int*)(ws + WS_MOE + MO_SLOT); float* rsx = (float*)(ws + WS_MOE + MO_RSX); int* cnts = (int*)(ws + WS_MOE + MO_CNT); int* blk = (int*)(ws + WS_MOE + MO_BLK); \
            bf16* XG = (bf16*)(ws + WS_XG); bf16* EA = (bf16*)(ws + WS_EA); \
            (void)tok_e; (void)tok_g; (void)tok_rs; (void)tok_slot; (void)rsx; (void)cnts; (void)blk; (void)XG; (void)EA
#define MIX_VIEW() bf16* Zb = (bf16*)(ws + WS_Z); bf16* Qb = (bf16*)(ws + WS_Q); bf16* Kb = (bf16*)(ws + WS_K); bf16* KZT = (bf16*)(ws + WS_KZT); bf16* VT = (bf16*)(ws + WS_VT); \
        bf16* SG = (bf16*)(ws + WS_SG); bf16* SGA = (bf16*)(ws + WS_SGA); bf16* SGB = (bf16*)(ws + WS_SGB); bf16* Cb = (bf16*)(ws + WS_C); \
        float* KVT = (float*)(ws + WS_KVT); bf16* ST = (bf16*)(ws + WS_ST); bf16* MG = (bf16*)(ws + WS_MG); \
        (void)Zb; (void)Qb; (void)Kb; (void)KZT; (void)VT; (void)SG; (void)SGA; (void)SGB; (void)Cb; (void)KVT; (void)ST; (void)MG

        if (IN(PH_A)) { PHASE_VIEW(); MIX_VIEW();
            { pg8::Gemm g{XBN, (const bf16*)(ws + WS_WIN) + (size_t)L * 5120 * D, T, 5120, D}; pg8::StaticOrder S; S.init(T, 5120, G, bx);
              pg8::EpiIn E{PARTN, (const float*)(ws + WS_COS), (const float*)(ws + WS_SIN), Zb, Qb, SG};
              static_assert(WS_K - WS_Q == 2 * pg8::EpiIn::QK_STRIDE && WS_SGA - WS_SG == 2 * pg8::EpiIn::G_STRIDE && WS_SGB - WS_SGA == 2 * pg8::EpiIn::G_STRIDE, "EpiIn strides");
              pg8::gemm_phase<pg8::EpiIn, pg8::StaticOrder, true, true>(lds + RING_OFF, g, S, E); }
            { pg8::Gemm g{(const bf16*)(ws + WS_WKVT) + (size_t)L * 1536 * D, XBN, 1536, T, D}; pg8::StaticOrder S; S.init(1536, T, G, bx);
              pg8::EpiKvT E{PARTN, (const float*)(ws + WS_COST), (const float*)(ws + WS_SINT), KZT, VT};
              pg8::gemm_phase<pg8::EpiKvT, pg8::StaticOrder, true, true>(lds + RING_OFF, g, S, E); }
            GRID_BAR();
        }

        if (IN(PH_B)) { PHASE_VIEW(); MIX_VIEW();
            {
                const float* cw = INP(4) + (size_t)L * CONV_W * CONV_DIM; const float* cb = INP(5) + L * CONV_DIM;
                const float* lg = INP(6) + L * CONV_DIM; const float* lb = INP(7) + L * CONV_DIM;
                LAS unsigned* zt = (LAS unsigned*)(lds + RING_OFF);
                LAS float* ot = (LAS float*)(lds + RING_OFF + 65536);
                const int cp = tid & 255, half = tid >> 8;
                float w0[CONV_W], w1[CONV_W];
#pragma unroll
                for (int w = 0; w < CONV_W; ++w) { w0[w] = cw[w * CONV_DIM + 2 * cp]; w1[w] = cw[w * CONV_DIM + 2 * cp + 1]; }
                const float b0 = cb[2 * cp], b1 = cb[2 * cp + 1];
                f32x4 lg0 = *(const f32x4*)(lg + 8 * lane), lg1 = *(const f32x4*)(lg + 8 * lane + 4), lb0 = *(const f32x4*)(lb + 8 * lane), lb1 = *(const f32x4*)(lb + 8 * lane + 4);
                for (int u = bx; u < T / 32; u += G) {
                    const int tok0 = u * 32, pos0 = tok0 & (SEQ - 1);
                    for (int idx = tid; idx < 62 * 64; idx += 512) { const int r = idx >> 6, ch = idx & 63; const int pos = pos0 - 30 + r;
                        v4u v = {0u, 0u, 0u, 0u}; if (pos >= 0) v = *(const GAS v4u*)(Zb + (size_t)(tok0 - 30 + r) * CONV_DIM + ch * 8);
                        *(LAS v4u*)(zt + r * 256 + ch * 4) = v; }
                    __syncthreads();
#pragma unroll 1
                    for (int tg = 0; tg < 2; ++tg) { const int tb = 16 * half + 8 * tg;
                        float a0[8], a1[8];
#pragma unroll
                        for (int q = 0; q < 8; ++q) { a0[q] = b0; a1[q] = b1; }
#pragma unroll
                        for (int r = 0; r < 38; ++r) { const unsigned pv = zt[(tb + r) * 256 + cp]; const float f0 = __uint_as_float(pv << 16), f1 = __uint_as_float(pv & 0xffff0000u);
#pragma unroll
                            for (int q = 0; q < 8; ++q) { const int w = r - q; if (w >= 0 && w < CONV_W) { a0[q] = fmaf(w0[w], f0, a0[q]); a1[q] = fmaf(w1[w], f1, a1[q]); } } }
#pragma unroll
                        for (int q = 0; q < 8; ++q) { typedef float f2 __attribute__((ext_vector_type(2))); *(LAS f2*)(ot + (tb + q) * 512 + 2 * cp) = (f2){a0[q], a1[q]}; } }
                    __syncthreads();
#pragma unroll 1
                    for (int q = 0; q < 4; ++q) { const int tk = 4 * wave + q; const LAS f32x4* op = (const LAS f32x4*)(ot + tk * 512 + 8 * lane); f32x4 v0 = op[0], v1 = op[1];
                        const float mean = wave_sum((v0.x + v0.y) + (v0.z + v0.w) + (v1.x + v1.y) + (v1.z + v1.w)) * (1.0f / 512.0f);
                        v0 = v0 - mean; v1 = v1 - mean;
                        const float var = wave_sum((v0.x * v0.x + v0.y * v0.y) + (v0.z * v0.z + v0.w * v0.w) + (v1.x * v1.x + v1.y * v1.y) + (v1.z * v1.z + v1.w * v1.w)) * (1.0f / 512.0f);
                        const float rstd = __builtin_amdgcn_rsqf(var + EPS);
                        v0 = v0 * rstd * lg0 + lb0; v1 = v1 * rstd * lg1 + lb1;
                        v0 = v0 * pg8::sigm4(v0); v1 = v1 * pg8::sigm4(v1);
                        *(GAS v4u*)(Cb + (size_t)(tok0 + tk) * CONV_DIM + 8 * lane) = pg8::pack8(v0, v1); }
                    __syncthreads();
                }
            }
            {
                const int fr = lane & 15, g4 = lane >> 4;
                for (int u = bx; u < NUNIT; u += G) {
                    const int n = u & 63, bh = u >> 6, h = bh & 7, b = bh >> 3; const size_t tok0 = (size_t)b * SEQ + n * RC;
                    bf16x8 Bv[4];
#pragma unroll
                    for (int ks = 0; ks < 4; ++ks) Bv[ks] = *(const GAS bf16x8*)(VT + (size_t)(h * RDV + 16 * wave + fr) * T + tok0 + 32 * ks + 8 * g4);
#pragma unroll
                    for (int dkt = 0; dkt < 4; ++dkt) { f32x4 acc = {0.f, 0.f, 0.f, 0.f};
#pragma unroll
                        for (int ks = 0; ks < 4; ++ks) { const bf16x8 Ak = *(const GAS bf16x8*)(KZT + (size_t)(h * RDK + 16 * dkt + fr) * T + tok0 + 32 * ks + 8 * g4);
                            acc = __builtin_amdgcn_mfma_f32_16x16x32_bf16(Ak, Bv[ks], acc, 0, 0, 0); }
                        *(GAS f32x4*)(KVT + (size_t)u * (RDV * RDK) + (16 * wave + fr) * RDK + 16 * dkt + 4 * g4) = acc; }
                }
            }
            if (moe) {
                __syncthreads();
                LAS float* scr = (LAS float*)(lds + RING_OFF + wave * 16384);
                constexpr int I_GU = 16 * 224, I_DN = 56 * 32, I_EXP = I_GU + I_DN;
                for (int it = gw; it < NEXP * I_EXP; it += NGW) { const int e = it / I_EXP, r = it % I_EXP; const size_t o = ((size_t)jl * NEXP + e) * D * EFF;
                    if (r < I_GU) conv_item(INP(16) + o, INP(17) + o, INP(11) + L * D, (bf16*)(ws + WS_WEGU) + (size_t)e * 2 * EFF * D, EFF, D, 224, 3, r, scr, lane);
                    else conv_item(INP(18) + o, nullptr, nullptr, (bf16*)(ws + WS_WED) + (size_t)e * D * EFF, D, EFF, 32, 0, r - I_GU, scr, lane); }
            }
            GRID_BAR();
        }

        if (IN(PH_C)) { PHASE_VIEW(); MIX_VIEW();
            {   const int gt = bx * 512 + tid;
                if (gt < 32 * 4096) { const int bh = gt >> 12, e2 = gt & 4095, h = bh & 7; const float gc = __builtin_amdgcn_exp2f(128.0f * log2g(h));
                    float s0 = 0.f, s1 = 0.f; typedef float f2 __attribute__((ext_vector_type(2)));
                    const GAS f2* kv = (const GAS f2*)(KVT + (size_t)bh * NCH * (RDV * RDK)) + e2; GAS unsigned* st = (GAS unsigned*)(ST + (size_t)bh * NCH * (RDV * RDK)) + e2;
#pragma unroll 8
                    for (int n = 0; n < NCH; ++n) { const f2 v = kv[(size_t)n * 4096]; st[(size_t)n * 4096] = pk2(s0, s1); s0 = fmaf(gc, s0, v.x); s1 = fmaf(gc, s1, v.y); } }
            }
            { pg8::Gemm g{Cb, (const bf16*)(ws + WS_WCO) + (size_t)L * D * CONV_DIM, T, D, CONV_DIM}; pg8::StaticOrder S; S.init(T, D, G, bx);
              pg8::EpiGate<false> E{SGA, MG};
              pg8::gemm_phase<pg8::EpiGate<false>, pg8::StaticOrder, true, true>(lds + RING_OFF, g, S, E); }
            GRID_BAR();
        }

        if (IN(PH_D)) { PHASE_VIEW(); MIX_VIEW();
            const int fr = lane & 15, g4 = lane >> 4;
            for (int u = bx; u < NUNIT; u += G) {
                const int n = u & 63, bh = u >> 6, h = bh & 7, b = bh >> 3; const size_t tok0 = (size_t)b * SEQ + n * RC; const float lg = log2g(h);
                const size_t tok = tok0 + 16 * wave + fr;
                bf16x8 Bq[2];
#pragma unroll
                for (int ks = 0; ks < 2; ++ks) Bq[ks] = *(const GAS bf16x8*)(Qb + tok * 512 + h * RDK + 32 * ks + 8 * g4);
                unsigned P[8][2];
#pragma unroll
                for (int jt2 = 0; jt2 < 8; ++jt2) {
                    if (jt2 <= wave) { f32x4 s = {0.f, 0.f, 0.f, 0.f};
#pragma unroll
                        for (int ks = 0; ks < 2; ++ks) { const bf16x8 Ak = *(const GAS bf16x8*)(Kb + (tok0 + 16 * jt2 + fr) * 512 + h * RDK + 32 * ks + 8 * g4);
                            s = __builtin_amdgcn_mfma_f32_16x16x32_bf16(Ak, Bq[ks], s, 0, 0, 0); }
                        const int dd = (16 * wave + fr) - (16 * jt2 + 4 * g4);
                        const float d0 = dd >= 0 ? s.x * __builtin_amdgcn_exp2f((float)dd * lg) : 0.f, d1 = dd >= 1 ? s.y * __builtin_amdgcn_exp2f((float)(dd - 1) * lg) : 0.f;
                        const float d2 = dd >= 2 ? s.z * __builtin_amdgcn_exp2f((float)(dd - 2) * lg) : 0.f, d3 = dd >= 3 ? s.w * __builtin_amdgcn_exp2f((float)(dd - 3) * lg) : 0.f;
                        P[jt2][0] = pg8::cvt_pk_bf16(d0, d1); P[jt2][1] = pg8::cvt_pk_bf16(d2, d3);
                    } else { P[jt2][0] = 0u; P[jt2][1] = 0u; }
                }
                f32x4 oT[8], cT[8];
#pragma unroll
                for (int dvt = 0; dvt < 8; ++dvt) { oT[dvt] = (f32x4){0.f, 0.f, 0.f, 0.f}; cT[dvt] = (f32x4){0.f, 0.f, 0.f, 0.f}; }
#pragma unroll
                for (int t2 = 0; t2 < 4; ++t2) {
                    if (2 * t2 <= wave) {
                        typedef unsigned u2 __attribute__((ext_vector_type(2)));
                        v4u bp; bp.x = P[2 * t2][0]; bp.y = P[2 * t2][1]; bp.z = P[2 * t2 + 1][0]; bp.w = P[2 * t2 + 1][1];
                        const bf16x8 Bp = __builtin_bit_cast(bf16x8, bp);
#pragma unroll
                        for (int dvt = 0; dvt < 8; ++dvt) { const GAS bf16* vp = (const GAS bf16*)VT + (size_t)(h * RDV + 16 * dvt + fr) * T + tok0 + 32 * t2 + 4 * g4;
                            const u2 lo = *(const GAS u2*)vp, hi = *(const GAS u2*)(vp + 16); v4u av; av.x = lo.x; av.y = lo.y; av.z = hi.x; av.w = hi.y;
                            oT[dvt] = __builtin_amdgcn_mfma_f32_16x16x32_bf16(__builtin_bit_cast(bf16x8, av), Bp, oT[dvt], 0, 0, 0); }
                    }
                }
#pragma unroll
                for (int dvt = 0; dvt < 8; ++dvt)
#pragma unroll
                    for (int ks = 0; ks < 2; ++ks) { const bf16x8 As = *(const GAS bf16x8*)(ST + (size_t)u * (RDV * RDK) + (16 * dvt + fr) * RDK + 32 * ks + 8 * g4);
                        cT[dvt] = __builtin_amdgcn_mfma_f32_16x16x32_bf16(As, Bq[ks], cT[dvt], 0, 0, 0); }
                const float xi = __builtin_amdgcn_exp2f((float)(16 * wave + fr + 1) * lg);
                float sm = 0.f;
#pragma unroll
                for (int dvt = 0; dvt < 8; ++dvt) { oT[dvt] = oT[dvt] + cT[dvt] * xi; sm += (oT[dvt].x + oT[dvt].y) + (oT[dvt].z + oT[dvt].w); }
                sm += __shfl_xor(sm, 16); sm += __shfl_xor(sm, 32);
                const float mean = sm * (1.0f / 128.0f); float sq = 0.f;
#pragma unroll
                for (int dvt = 0; dvt < 8; ++dvt) { oT[dvt] = oT[dvt] - mean; sq += (oT[dvt].x * oT[dvt].x + oT[dvt].y * oT[dvt].y) + (oT[dvt].z * oT[dvt].z + oT[dvt].w * oT[dvt].w); }
                sq += __shfl_xor(sq, 16); sq += __shfl_xor(sq, 32);
                const float rstd = __builtin_amdgcn_rsqf(sq * (1.0f / 128.0f) + EPS);
#pragma unroll
                for (int dvt = 0; dvt < 8; ++dvt) { typedef unsigned u2 __attribute__((ext_vector_type(2)));
                    GAS u2* gp = (GAS u2*)(SG + tok * 1024 + h * RDV + 16 * dvt + 4 * g4); const u2 gv = *gp; const f32x4 gf = pg8::bf_lo4(gv.x, gv.y);
                    const f32x4 r = oT[dvt] * rstd * gf; u2 o; o.x = pg8::cvt_pk_bf16(r.x, r.y); o.y = pg8::cvt_pk_bf16(r.z, r.w); *gp = o; }
            }
            GRID_BAR();
        }

        if (IN(PH_E)) { PHASE_VIEW(); MIX_VIEW();
            pg8::Gemm g{SG, (const bf16*)(ws + WS_WRO) + (size_t)L * D * D, T, D, D}; pg8::StaticOrder S; S.init(T, D, G, bx);
            pg8::EpiGate<true> E{SGB, MG};
            pg8::gemm_phase<pg8::EpiGate<true>, pg8::StaticOrder, true, true>(lds + RING_OFF, g, S, E);
            GRID_BAR();
        }

        if (IN(PH_F)) { PHASE_VIEW(); MIX_VIEW();
            pg8::Gemm g{MG, (const bf16*)(ws + WS_WO) + (size_t)L * D * D, T, D, D}; pg8::StaticOrder S; S.init(T, D, G, bx);
            pg8::EpiRes<false> E{X, XB, PART, nullptr, nullptr};
            pg8::gemm_phase<pg8::EpiRes<false>, pg8::StaticOrder, true, true>(lds + RING_OFF, g, S, E);
            GRID_BAR();
        }

        if (!moe) {
            if (IN(PH_G)) { PHASE_VIEW(); MOE_VIEW();
                pg8::Gemm g{XB, (const bf16*)(ws + WS_WDGU) + (size_t)jl * 2 * DFF * D, T, 2 * DFF, D}; pg8::StaticOrder S; S.init(T, 2 * DFF, G, bx);
                pg8::EpiSwi<false> E{PART, nullptr, (bf16*)(ws + WS_FA), DFF};
                pg8::gemm_phase<pg8::EpiSwi<false>, pg8::StaticOrder, true, true>(lds + RING_OFF, g, S, E);
                GRID_BAR();
            }
            if (IN(PH_H)) { PHASE_VIEW(); MOE_VIEW();
                pg8::Gemm g{(const bf16*)(ws + WS_FA), (const bf16*)(ws + WS_WDD) + (size_t)jl * D * DFF, T, D, DFF}; pg8::StaticOrder S; S.init(T, D, G, bx);
                pg8::EpiRes<false> E{X, XB, PART, nullptr, nullptr};
                pg8::gemm_phase<pg8::EpiRes<false>, pg8::StaticOrder, true, true>(lds + RING_OFF, g, S, E);
                GRID_BAR();
            }
        } else {
            if (IN(PH_G)) { PHASE_VIEW(); MOE_VIEW();
                LAS float* wrT = (LAS float*)(lds + RING_OFF);
                LAS int* lcnt = (LAS int*)(lds + RING_OFF + 32768);
                const float* wr = INP(15) + (size_t)jl * D * NEXP; const float* gf = INP(11) + L * D;
                for (int i = tid; i < D * NEXP; i += 512) { const int k = i >> 3, e = i & 7; wrT[e * 1024 + k] = wr[i] * gf[k]; }
                if (tid < 8) lcnt[tid] = 0;
                __syncthreads();
                for (int q = 0; q < 16; ++q) { const int t = bx * 128 + wave * 16 + q;
                    const GAS f32x4* xr = (const GAS f32x4*)(X + (size_t)t * D) + lane; f32x4 xv[4]; float ss = 0.f;
#pragma unroll
                    for (int j = 0; j < 4; ++j) { xv[j] = xr[64 * j]; ss += (xv[j].x * xv[j].x + xv[j].y * xv[j].y) + (xv[j].z * xv[j].z + xv[j].w * xv[j].w); }
                    float lgt[8];
#pragma unroll
                    for (int e = 0; e < 8; ++e) { float a = 0.f;
#pragma unroll
                        for (int j = 0; j < 4; ++j) { const f32x4 w = *(const LAS f32x4*)(wrT + e * 1024 + 256 * j + 4 * lane); a += (xv[j].x * w.x + xv[j].y * w.y) + (xv[j].z * w.z + xv[j].w * w.w); }
                        lgt[e] = wave_sum(a); }
                    ss = wave_sum(ss); const float rs = __builtin_amdgcn_rsqf(ss * (1.0f / 1024.0f) + EPS);
                    int e1 = 0; float v1 = lgt[0];
#pragma unroll
                    for (int e = 1; e < 8; ++e) if (lgt[e] > v1) { v1 = lgt[e]; e1 = e; }
                    int e2 = -1; float v2 = 0.f;
#pragma unroll
                    for (int e = 0; e < 8; ++e) if (e != e1 && (e2 < 0 || lgt[e] > v2)) { v2 = lgt[e]; e2 = e; }
                    const float ex = __builtin_amdgcn_exp2f((v2 - v1) * rs * kLog2e), g1 = 1.0f / (1.0f + ex), g2 = ex * g1;
                    if (lane == 0) { tok_e[2 * t] = e1; tok_e[2 * t + 1] = e2; tok_g[2 * t] = g1; tok_g[2 * t + 1] = g2; tok_rs[t] = rs; atomicAdd((int*)&lcnt[e1], 1); atomicAdd((int*)&lcnt[e2], 1); }
                }
                __syncthreads();
                if (tid < 8) cnts[bx * 8 + tid] = lcnt[tid];
                __syncthreads();
                GRID_BAR();
            }
            if (IN(PH_H)) { PHASE_VIEW(); MOE_VIEW();
                LAS int* lc = (LAS int*)(lds + RING_OFF);
                LAS int* base = lc + 2048;
                LAS int* lslot = base + 16;
                LAS int* le = lslot + 256;
                for (int i = tid; i < 2048; i += 512) lc[i] = cnts[i];
                if (tid < 256) le[tid] = tok_e[bx * 256 + tid];
                __syncthreads();
                {
                    int tot = 0, pre = 0;
#pragma unroll
                    for (int k = 0; k < 4; ++k) { const int wg = lane + 64 * k; const int c = lc[wg * 8 + wave]; tot += c; pre += (wg < bx) ? c : 0; }
#pragma unroll
                    for (int o = 1; o < 64; o <<= 1) { tot += __shfl_xor(tot, o); pre += __shfl_xor(pre, o); }
                    if (lane == 0) { base[wave] = pre; base[8 + wave] = tot; }
                }
                __syncthreads();
                if (tid == 0) { int ps = 0; for (int e = 0; e < 8; ++e) { const int tot = base[8 + e]; base[e] += ps; const int nb = (tot + 255) >> 8;
                        if (bx == 0) { for (int q = 0; q < nb; ++q) blk[1 + (ps >> 8) + q] = e; }
                        ps += nb << 8; }
                    if (bx == 0) blk[0] = ps >> 8; }
                __syncthreads();
                {
                    int run = base[wave];
#pragma unroll
                    for (int k = 0; k < 2; ++k) { const int i = lane + 64 * k; const int a = le[2 * i], b2 = le[2 * i + 1]; const bool f = (a == wave) || (b2 == wave);
                        const unsigned long long m = __ballot(f); const int rank = __popcll(m & ((1ull << lane) - 1ull));
                        if (f) lslot[2 * i + (a == wave ? 0 : 1)] = run + rank;
                        run += __popcll(m); }
                }
                __syncthreads();
                if (tid < 256) { const int t = bx * 128 + (tid >> 1); const int s = lslot[tid]; tok_slot[bx * 256 + tid] = s; rsx[s] = tok_rs[t]; }
                for (int p = wave; p < 256; p += 8) { const int t = bx * 128 + (p >> 1), s = lslot[p];
                    const GAS v4u* src = (const GAS v4u*)(XB + (size_t)t * D) + lane; GAS v4u* dst = (GAS v4u*)(XG + (size_t)s * D) + lane; dst[0] = src[0]; dst[64] = src[64]; }
                __syncthreads();
                GRID_BAR();
            }
            if (IN(PH_G1)) { PHASE_VIEW(); MOE_VIEW();
                const int nblk = blk[0];
                pg8::Gemm g{XG, (const bf16*)(ws + WS_WEGU), nblk * 256, 2 * EFF, D}; pg8::MoeOrder S; S.init(nblk * 256, 2 * EFF, G, bx); S.blk_e = blk + 1; S.ntile = 2 * EFF / 256;
                pg8::EpiSwi<true> E{nullptr, rsx, EA, EFF};
                pg8::gemm_phase<pg8::EpiSwi<true>, pg8::MoeOrder, true, true>(lds + RING_OFF, g, S, E);
                GRID_BAR();
            }
            if (IN(PH_G2)) { PHASE_VIEW(); MOE_VIEW();
                const int nblk = blk[0];
                pg8::Gemm g{EA, (const bf16*)(ws + WS_WED), nblk * 256, D, EFF}; pg8::MoeOrder S; S.init(nblk * 256, D, G, bx); S.blk_e = blk + 1; S.ntile = D / 256;
                pg8::EpiStore E{XG, D};
                pg8::gemm_phase<pg8::EpiStore, pg8::MoeOrder, true, true>(lds + RING_OFF, g, S, E);
                GRID_BAR();
            }
            if (IN(PH_CMB)) { PHASE_VIEW(); MOE_VIEW();
                for (int t = gw; t < T; t += NGW) {
                    const int s1 = tok_slot[2 * t], s2 = tok_slot[2 * t + 1]; const float g1 = tok_g[2 * t], g2 = tok_g[2 * t + 1];
                    GAS f32x4* xr = (GAS f32x4*)(X + (size_t)t * D) + lane; typedef unsigned u2 __attribute__((ext_vector_type(2)));
                    const GAS u2* y1 = (const GAS u2*)(XG + (size_t)s1 * D) + lane; const GAS u2* y2 = (const GAS u2*)(XG + (size_t)s2 * D) + lane;
                    GAS unsigned long long* o8 = (GAS unsigned long long*)(XB + (size_t)t * D) + lane; float s = 0.f;
#pragma unroll
                    for (int j = 0; j < 4; ++j) { f32x4 v = xr[64 * j]; const u2 a = y1[64 * j], b2 = y2[64 * j];
                        v = v + (pg8::bf_lo4(a.x, a.y) * g1 + pg8::bf_lo4(b2.x, b2.y) * g2); xr[64 * j] = v; s += (v.x * v.x + v.y * v.y) + (v.z * v.z + v.w * v.w);
                        o8[64 * j] = (unsigned long long)pk2(v.x, v.y) | ((unsigned long long)pk2(v.z, v.w) << 32); }
                    s = wave_sum(s);
                    if (lane < 16) PART[(size_t)t * 16 + lane] = lane == 0 ? s : 0.f;
                }
                GRID_BAR();
            }
        }

        if (IN(PH_I)) { PHASE_VIEW(); MIX_VIEW();
            bf16* PP = (bf16*)(ws + WS_PP);
            { pg8::Gemm g{(const bf16*)(ws + WS_PB) + (size_t)L * T * PLE_DIM, (const bf16*)(ws + WS_WPP) + (size_t)L * D * PLE_DIM, T, D, PLE_DIM}; pg8::StaticOrder S; S.init(T, D, G, bx);
              pg8::EpiStore E{PP, D};
              pg8::gemm_phase<pg8::EpiStore, pg8::StaticOrder, true, true>(lds + RING_OFF, g, S, E); }
            { pg8::Gemm g{XB, (const bf16*)(ws + WS_WPG) + (size_t)L * D * D, T, D, D}; pg8::StaticOrder S; S.init(T, D, G, bx);
              pg8::EpiRes<true> E{X, XBN, PARTN, PART, PP};
              pg8::gemm_phase<pg8::EpiRes<true>, pg8::StaticOrder, true, true>(lds + RING_OFF, g, S, E); }
            GRID_BAR();
        }
    }
    if (2 >= l_lo && 2 < l_hi) { constexpr int L = 2;
        const bool moe = (L & 1) != 0; const int jl = L >> 1;
#define MOE_VIEW() int* tok_e = (int*)(ws + WS_MOE + MO_TOKE); float* tok_g = (float*)(ws + WS_MOE + MO_TOKG); float* tok_rs = (float*)(ws + WS_MOE + MO_TOKRS); \
            int* tok_slot = (int*)(ws + WS_MOE + MO_SLOT); float* rsx = (float*)(ws + WS_MOE + MO_RSX); int* cnts = (int*)(ws + WS_MOE + MO_CNT); int* blk = (int*)(ws + WS_MOE + MO_BLK); \
            bf16* XG = (bf16*)(ws + WS_XG); bf16* EA = (bf16*)(ws + WS_EA); \
            (void)tok_e; (void)tok_g; (void)tok_rs; (void)tok_slot; (void)rsx; (void)cnts; (void)blk; (void)XG; (void)EA
#define MIX_VIEW() bf16* Zb = (bf16*)(ws + WS_Z); bf16* Qb = (bf16*)(ws + WS_Q); bf16* Kb = (bf16*)(ws + WS_K); bf16* KZT = (bf16*)(ws + WS_KZT); bf16* VT = (bf16*)(ws + WS_VT); \
        bf16* SG = (bf16*)(ws + WS_SG); bf16* SGA = (bf16*)(ws + WS_SGA); bf16* SGB = (bf16*)(ws + WS_SGB); bf16* Cb = (bf16*)(ws + WS_C); \
        float* KVT = (float*)(ws + WS_KVT); bf16* ST = (bf16*)(ws + WS_ST); bf16* MG = (bf16*)(ws + WS_MG); \
        (void)Zb; (void)Qb; (void)Kb; (void)KZT; (void)VT; (void)SG; (void)SGA; (void)SGB; (void)Cb; (void)KVT; (void)ST; (void)MG

        if (IN(PH_A)) { PHASE_VIEW(); MIX_VIEW();
            { pg8::Gemm g{XBN, (const bf16*)(ws + WS_WIN) + (size_t)L * 5120 * D, T, 5120, D}; pg8::StaticOrder S; S.init(T, 5120, G, bx);
              pg8::EpiIn E{PARTN, (const float*)(ws + WS_COS), (const float*)(ws + WS_SIN), Zb, Qb, SG};
              static_assert(WS_K - WS_Q == 2 * pg8::EpiIn::QK_STRIDE && WS_SGA - WS_SG == 2 * pg8::EpiIn::G_STRIDE && WS_SGB - WS_SGA == 2 * pg8::EpiIn::G_STRIDE, "EpiIn strides");
              pg8::gemm_phase<pg8::EpiIn, pg8::StaticOrder, true, true>(lds + RING_OFF, g, S, E); }
            { pg8::Gemm g{(const bf16*)(ws + WS_WKVT) + (size_t)L * 1536 * D, XBN, 1536, T, D}; pg8::StaticOrder S; S.init(1536, T, G, bx);
              pg8::EpiKvT E{PARTN, (const float*)(ws + WS_COST), (const float*)(ws + WS_SINT), KZT, VT};
              pg8::gemm_phase<pg8::EpiKvT, pg8::StaticOrder, true, true>(lds + RING_OFF, g, S, E); }
            GRID_BAR();
        }

        if (IN(PH_B)) { PHASE_VIEW(); MIX_VIEW();
            {
                const float* cw = INP(4) + (size_t)L * CONV_W * CONV_DIM; const float* cb = INP(5) + L * CONV_DIM;
                const float* lg = INP(6) + L * CONV_DIM; const float* lb = INP(7) + L * CONV_DIM;
                LAS unsigned* zt = (LAS unsigned*)(lds + RING_OFF);
                LAS float* ot = (LAS float*)(lds + RING_OFF + 65536);
                const int cp = tid & 255, half = tid >> 8;
                float w0[CONV_W], w1[CONV_W];
#pragma unroll
                for (int w = 0; w < CONV_W; ++w) { w0[w] = cw[w * CONV_DIM + 2 * cp]; w1[w] = cw[w * CONV_DIM + 2 * cp + 1]; }
                const float b0 = cb[2 * cp], b1 = cb[2 * cp + 1];
                f32x4 lg0 = *(const f32x4*)(lg + 8 * lane), lg1 = *(const f32x4*)(lg + 8 * lane + 4), lb0 = *(const f32x4*)(lb + 8 * lane), lb1 = *(const f32x4*)(lb + 8 * lane + 4);
                for (int u = bx; u < T / 32; u += G) {
                    const int tok0 = u * 32, pos0 = tok0 & (SEQ - 1);
                    for (int idx = tid; idx < 62 * 64; idx += 512) { const int r = idx >> 6, ch = idx & 63; const int pos = pos0 - 30 + r;
                        v4u v = {0u, 0u, 0u, 0u}; if (pos >= 0) v = *(const GAS v4u*)(Zb + (size_t)(tok0 - 30 + r) * CONV_DIM + ch * 8);
                        *(LAS v4u*)(zt + r * 256 + ch * 4) = v; }
                    __syncthreads();
#pragma unroll 1
                    for (int tg = 0; tg < 2; ++tg) { const int tb = 16 * half + 8 * tg;
                        float a0[8], a1[8];
#pragma unroll
                        for (int q = 0; q < 8; ++q) { a0[q] = b0; a1[q] = b1; }
#pragma unroll
                        for (int r = 0; r < 38; ++r) { const unsigned pv = zt[(tb + r) * 256 + cp]; const float f0 = __uint_as_float(pv << 16), f1 = __uint_as_float(pv & 0xffff0000u);
#pragma unroll
                            for (int q = 0; q < 8; ++q) { const int w = r - q; if (w >= 0 && w < CONV_W) { a0[q] = fmaf(w0[w], f0, a0[q]); a1[q] = fmaf(w1[w], f1, a1[q]); } } }
#pragma unroll
                        for (int q = 0; q < 8; ++q) { typedef float f2 __attribute__((ext_vector_type(2))); *(LAS f2*)(ot + (tb + q) * 512 + 2 * cp) = (f2){a0[q], a1[q]}; } }
                    __syncthreads();
#pragma unroll 1
                    for (int q = 0; q < 4; ++q) { const int tk = 4 * wave + q; const LAS f32x4* op = (const LAS f32x4*)(ot + tk * 512 + 8 * lane); f32x4 v0 = op[0], v1 = op[1];
                        const float mean = wave_sum((v0.x + v0.y) + (v0.z + v0.w) + (v1.x + v1.y) + (v1.z + v1.w)) * (1.0f / 512.0f);
                        v0 = v0 - mean; v1 = v1 - mean;
                        const float var = wave_sum((v0.x * v0.x + v0.y * v0.y) + (v0.z * v0.z + v0.w * v0.w) + (v1.x * v1.x + v1.y * v1.y) + (v1.z * v1.z + v1.w * v1.w)) * (1.0f / 512.0f);
                        const float rstd = __builtin_amdgcn_rsqf(var + EPS);
                        v0 = v0 * rstd * lg0 + lb0; v1 = v1 * rstd * lg1 + lb1;
                        v0 = v0 * pg8::sigm4(v0); v1 = v1 * pg8::sigm4(v1);
                        *(GAS v4u*)(Cb + (size_t)(tok0 + tk) * CONV_DIM + 8 * lane) = pg8::pack8(v0, v1); }
                    __syncthreads();
                }
            }
            {
                const int fr = lane & 15, g4 = lane >> 4;
                for (int u = bx; u < NUNIT; u += G) {
                    const int n = u & 63, bh = u >> 6, h = bh & 7, b = bh >> 3; const size_t tok0 = (size_t)b * SEQ + n * RC;
                    bf16x8 Bv[4];
#pragma unroll
                    for (int ks = 0; ks < 4; ++ks) Bv[ks] = *(const GAS bf16x8*)(VT + (size_t)(h * RDV + 16 * wave + fr) * T + tok0 + 32 * ks + 8 * g4);
#pragma unroll
                    for (int dkt = 0; dkt < 4; ++dkt) { f32x4 acc = {0.f, 0.f, 0.f, 0.f};
#pragma unroll
                        for (int ks = 0; ks < 4; ++ks) { const bf16x8 Ak = *(const GAS bf16x8*)(KZT + (size_t)(h * RDK + 16 * dkt + fr) * T + tok0 + 32 * ks + 8 * g4);
                            acc = __builtin_amdgcn_mfma_f32_16x16x32_bf16(Ak, Bv[ks], acc, 0, 0, 0); }
                        *(GAS f32x4*)(KVT + (size_t)u * (RDV * RDK) + (16 * wave + fr) * RDK + 16 * dkt + 4 * g4) = acc; }
                }
            }
            if (moe) {
                __syncthreads();
                LAS float* scr = (LAS float*)(lds + RING_OFF + wave * 16384);
                constexpr int I_GU = 16 * 224, I_DN = 56 * 32, I_EXP = I_GU + I_DN;
                for (int it = gw; it < NEXP * I_EXP; it += NGW) { const int e = it / I_EXP, r = it % I_EXP; const size_t o = ((size_t)jl * NEXP + e) * D * EFF;
                    if (r < I_GU) conv_item(INP(16) + o, INP(17) + o, INP(11) + L * D, (bf16*)(ws + WS_WEGU) + (size_t)e * 2 * EFF * D, EFF, D, 224, 3, r, scr, lane);
                    else conv_item(INP(18) + o, nullptr, nullptr, (bf16*)(ws + WS_WED) + (size_t)e * D * EFF, D, EFF, 32, 0, r - I_GU, scr, lane); }
            }
            GRID_BAR();
        }

        if (IN(PH_C)) { PHASE_VIEW(); MIX_VIEW();
            {   const int gt = bx * 512 + tid;
                if (gt < 32 * 4096) { const int bh = gt >> 12, e2 = gt & 4095, h = bh & 7; const float gc = __builtin_amdgcn_exp2f(128.0f * log2g(h));
                    float s0 = 0.f, s1 = 0.f; typedef float f2 __attribute__((ext_vector_type(2)));
                    const GAS f2* kv = (const GAS f2*)(KVT + (size_t)bh * NCH * (RDV * RDK)) + e2; GAS unsigned* st = (GAS unsigned*)(ST + (size_t)bh * NCH * (RDV * RDK)) + e2;
#pragma unroll 8
                    for (int n = 0; n < NCH; ++n) { const f2 v = kv[(size_t)n * 4096]; st[(size_t)n * 4096] = pk2(s0, s1); s0 = fmaf(gc, s0, v.x); s1 = fmaf(gc, s1, v.y); } }
            }
            { pg8::Gemm g{Cb, (const bf16*)(ws + WS_WCO) + (size_t)L * D * CONV_DIM, T, D, CONV_DIM}; pg8::StaticOrder S; S.init(T, D, G, bx);
              pg8::EpiGate<false> E{SGA, MG};
              pg8::gemm_phase<pg8::EpiGate<false>, pg8::StaticOrder, true, true>(lds + RING_OFF, g, S, E); }
            GRID_BAR();
        }

        if (IN(PH_D)) { PHASE_VIEW(); MIX_VIEW();
            const int fr = lane & 15, g4 = lane >> 4;
            for (int u = bx; u < NUNIT; u += G) {
                const int n = u & 63, bh = u >> 6, h = bh & 7, b = bh >> 3; const size_t tok0 = (size_t)b * SEQ + n * RC; const float lg = log2g(h);
                const size_t tok = tok0 + 16 * wave + fr;
                bf16x8 Bq[2];
#pragma unroll
                for (int ks = 0; ks < 2; ++ks) Bq[ks] = *(const GAS bf16x8*)(Qb + tok * 512 + h * RDK + 32 * ks + 8 * g4);
                unsigned P[8][2];
#pragma unroll
                for (int jt2 = 0; jt2 < 8; ++jt2) {
                    if (jt2 <= wave) { f32x4 s = {0.f, 0.f, 0.f, 0.f};
#pragma unroll
                        for (int ks = 0; ks < 2; ++ks) { const bf16x8 Ak = *(const GAS bf16x8*)(Kb + (tok0 + 16 * jt2 + fr) * 512 + h * RDK + 32 * ks + 8 * g4);
                            s = __builtin_amdgcn_mfma_f32_16x16x32_bf16(Ak, Bq[ks], s, 0, 0, 0); }
                        const int dd = (16 * wave + fr) - (16 * jt2 + 4 * g4);
                        const float d0 = dd >= 0 ? s.x * __builtin_amdgcn_exp2f((float)dd * lg) : 0.f, d1 = dd >= 1 ? s.y * __builtin_amdgcn_exp2f((float)(dd - 1) * lg) : 0.f;
                        const float d2 = dd >= 2 ? s.z * __builtin_amdgcn_exp2f((float)(dd - 2) * lg) : 0.f, d3 = dd >= 3 ? s.w * __builtin_amdgcn_exp2f((float)(dd - 3) * lg) : 0.f;
                        P[jt2][0] = pg8::cvt_pk_bf16(d0, d1); P[jt2][1] = pg8::cvt_pk_bf16(d2, d3);
                    } else { P[jt2][0] = 0u; P[jt2][1] = 0u; }
                }
                f32x4 oT[8], cT[8];
#pragma unroll
                for (int dvt = 0; dvt < 8; ++dvt) { oT[dvt] = (f32x4){0.f, 0.f, 0.f, 0.f}; cT[dvt] = (f32x4){0.f, 0.f, 0.f, 0.f}; }
#pragma unroll
                for (int t2 = 0; t2 < 4; ++t2) {
                    if (2 * t2 <= wave) {
                        typedef unsigned u2 __attribute__((ext_vector_type(2)));
                        v4u bp; bp.x = P[2 * t2][0]; bp.y = P[2 * t2][1]; bp.z = P[2 * t2 + 1][0]; bp.w = P[2 * t2 + 1][1];
                        const bf16x8 Bp = __builtin_bit_cast(bf16x8, bp);
#pragma unroll
                        for (int dvt = 0; dvt < 8; ++dvt) { const GAS bf16* vp = (const GAS bf16*)VT + (size_t)(h * RDV + 16 * dvt + fr) * T + tok0 + 32 * t2 + 4 * g4;
                            const u2 lo = *(const GAS u2*)vp, hi = *(const GAS u2*)(vp + 16); v4u av; av.x = lo.x; av.y = lo.y; av.z = hi.x; av.w = hi.y;
                            oT[dvt] = __builtin_amdgcn_mfma_f32_16x16x32_bf16(__builtin_bit_cast(bf16x8, av), Bp, oT[dvt], 0, 0, 0); }
                    }
                }
#pragma unroll
                for (int dvt = 0; dvt < 8; ++dvt)
#pragma unroll
                    for (int ks = 0; ks < 2; ++ks) { const bf16x8 As = *(const GAS bf16x8*)(ST + (size_t)u * (RDV * RDK) + (16 * dvt + fr) * RDK + 32 * ks + 8 * g4);
                        cT[dvt] = __builtin_amdgcn_mfma_f32_16x16x32_bf16(As, Bq[ks], cT[dvt], 0, 0, 0); }
                const float xi = __builtin_amdgcn_exp2f((float)(16 * wave + fr + 1) * lg);
                float sm = 0.f;
#pragma unroll
                for (int dvt = 0; dvt < 8; ++dvt) { oT[dvt] = oT[dvt] + cT[dvt] * xi; sm += (oT[dvt].x + oT[dvt].y) + (oT[dvt].z + oT[dvt].w); }
                sm += __shfl_xor(sm, 16); sm += __shfl_xor(sm, 32);
                const float mean = sm * (1.0f / 128.0f); float sq = 0.f;
#pragma unroll
                for (int dvt = 0; dvt < 8; ++dvt) { oT[dvt] = oT[dvt] - mean; sq += (oT[dvt].x * oT[dvt].x + oT[dvt].y * oT[dvt].y) + (oT[dvt].z * oT[dvt].z + oT[dvt].w * oT[dvt].w); }
                sq += __shfl_xor(sq, 16); sq += __shfl_xor(sq, 32);
                const float rstd = __builtin_amdgcn_rsqf(sq * (1.0f / 128.0f) + EPS);
#pragma unroll
                for (int dvt = 0; dvt < 8; ++dvt) { typedef unsigned u2 __attribute__((ext_vector_type(2)));
                    GAS u2* gp = (GAS u2*)(SG + tok * 1024 + h * RDV + 16 * dvt + 4 * g4); const u2 gv = *gp; const f32x4 gf = pg8::bf_lo4(gv.x, gv.y);
                    const f32x4 r = oT[dvt] * rstd * gf; u2 o; o.x = pg8::cvt_pk_bf16(r.x, r.y); o.y = pg8::cvt_pk_bf16(r.z, r.w); *gp = o; }
            }
            GRID_BAR();
        }

        if (IN(PH_E)) { PHASE_VIEW(); MIX_VIEW();
            pg8::Gemm g{SG, (const bf16*)(ws + WS_WRO) + (size_t)L * D * D, T, D, D}; pg8::StaticOrder S; S.init(T, D, G, bx);
            pg8::EpiGate<true> E{SGB, MG};
            pg8::gemm_phase<pg8::EpiGate<true>, pg8::StaticOrder, true, true>(lds + RING_OFF, g, S, E);
            GRID_BAR();
        }

        if (IN(PH_F)) { PHASE_VIEW(); MIX_VIEW();
            pg8::Gemm g{MG, (const bf16*)(ws + WS_WO) + (size_t)L * D * D, T, D, D}; pg8::StaticOrder S; S.init(T, D, G, bx);
            pg8::EpiRes<false> E{X, XB, PART, nullptr, nullptr};
            pg8::gemm_phase<pg8::EpiRes<false>, pg8::StaticOrder, true, true>(lds + RING_OFF, g, S, E);
            GRID_BAR();
        }

        if (!moe) {
            if (IN(PH_G)) { PHASE_VIEW(); MOE_VIEW();
                pg8::Gemm g{XB, (const bf16*)(ws + WS_WDGU) + (size_t)jl * 2 * DFF * D, T, 2 * DFF, D}; pg8::StaticOrder S; S.init(T, 2 * DFF, G, bx);
                pg8::EpiSwi<false> E{PART, nullptr, (bf16*)(ws + WS_FA), DFF};
                pg8::gemm_phase<pg8::EpiSwi<false>, pg8::StaticOrder, true, true>(lds + RING_OFF, g, S, E);
                GRID_BAR();
            }
            if (IN(PH_H)) { PHASE_VIEW(); MOE_VIEW();
                pg8::Gemm g{(const bf16*)(ws + WS_FA), (const bf16*)(ws + WS_WDD) + (size_t)jl * D * DFF, T, D, DFF}; pg8::StaticOrder S; S.init(T, D, G, bx);
                pg8::EpiRes<false> E{X, XB, PART, nullptr, nullptr};
                pg8::gemm_phase<pg8::EpiRes<false>, pg8::StaticOrder, true, true>(lds + RING_OFF, g, S, E);
                GRID_BAR();
            }
        } else {
            if (IN(PH_G)) { PHASE_VIEW(); MOE_VIEW();
                LAS float* wrT = (LAS float*)(lds + RING_OFF);
                LAS int* lcnt = (LAS int*)(lds + RING_OFF + 32768);
                const float* wr = INP(15) + (size_t)jl * D * NEXP; const float* gf = INP(11) + L * D;
                for (int i = tid; i < D * NEXP; i += 512) { const int k = i >> 3, e = i & 7; wrT[e * 1024 + k] = wr[i] * gf[k]; }
                if (tid < 8) lcnt[tid] = 0;
                __syncthreads();
                for (int q = 0; q < 16; ++q) { const int t = bx * 128 + wave * 16 + q;
                    const GAS f32x4* xr = (const GAS f32x4*)(X + (size_t)t * D) + lane; f32x4 xv[4]; float ss = 0.f;
#pragma unroll
                    for (int j = 0; j < 4; ++j) { xv[j] = xr[64 * j]; ss += (xv[j].x * xv[j].x + xv[j].y * xv[j].y) + (xv[j].z * xv[j].z + xv[j].w * xv[j].w); }
                    float lgt[8];
#pragma unroll
                    for (int e = 0; e < 8; ++e) { float a = 0.f;
#pragma unroll
                        for (int j = 0; j < 4; ++j) { const f32x4 w = *(const LAS f32x4*)(wrT + e * 1024 + 256 * j + 4 * lane); a += (xv[j].x * w.x + xv[j].y * w.y) + (xv[j].z * w.z + xv[j].w * w.w); }
                        lgt[e] = wave_sum(a); }
                    ss = wave_sum(ss); const float rs = __builtin_amdgcn_rsqf(ss * (1.0f / 1024.0f) + EPS);
                    int e1 = 0; float v1 = lgt[0];
#pragma unroll
                    for (int e = 1; e < 8; ++e) if (lgt[e] > v1) { v1 = lgt[e]; e1 = e; }
                    int e2 = -1; float v2 = 0.f;
#pragma unroll
                    for (int e = 0; e < 8; ++e) if (e != e1 && (e2 < 0 || lgt[e] > v2)) { v2 = lgt[e]; e2 = e; }
                    const float ex = __builtin_amdgcn_exp2f((v2 - v1) * rs * kLog2e), g1 = 1.0f / (1.0f + ex), g2 = ex * g1;
                    if (lane == 0) { tok_e[2 * t] = e1; tok_e[2 * t + 1] = e2; tok_g[2 * t] = g1; tok_g[2 * t + 1] = g2; tok_rs[t] = rs; atomicAdd((int*)&lcnt[e1], 1); atomicAdd((int*)&lcnt[e2], 1); }
                }
                __syncthreads();
                if (tid < 8) cnts[bx * 8 + tid] = lcnt[tid];
                __syncthreads();
                GRID_BAR();
            }
            if (IN(PH_H)) { PHASE_VIEW(); MOE_VIEW();
                LAS int* lc = (LAS int*)(lds + RING_OFF);
                LAS int* base = lc + 2048;
                LAS int* lslot = base + 16;
                LAS int* le = lslot + 256;
                for (int i = tid; i < 2048; i += 512) lc[i] = cnts[i];
                if (tid < 256) le[tid] = tok_e[bx * 256 + tid];
                __syncthreads();
                {
                    int tot = 0, pre = 0;
#pragma unroll
                    for (int k = 0; k < 4; ++k) { const int wg = lane + 64 * k; const int c = lc[wg * 8 + wave]; tot += c; pre += (wg < bx) ? c : 0; }
#pragma unroll
                    for (int o = 1; o < 64; o <<= 1) { tot += __shfl_xor(tot, o); pre += __shfl_xor(pre, o); }
                    if (lane == 0) { base[wave] = pre; base[8 + wave] = tot; }
                }
                __syncthreads();
                if (tid == 0) { int ps = 0; for (int e = 0; e < 8; ++e) { const int tot = base[8 + e]; base[e] += ps; const int nb = (tot + 255) >> 8;
                        if (bx == 0) { for (int q = 0; q < nb; ++q) blk[1 + (ps >> 8) + q] = e; }
                        ps += nb << 8; }
                    if (bx == 0) blk[0] = ps >> 8; }
                __syncthreads();
                {
                    int run = base[wave];
#pragma unroll
                    for (int k = 0; k < 2; ++k) { const int i = lane + 64 * k; const int a = le[2 * i], b2 = le[2 * i + 1]; const bool f = (a == wave) || (b2 == wave);
                        const unsigned long long m = __ballot(f); const int rank = __popcll(m & ((1ull << lane) - 1ull));
                        if (f) lslot[2 * i + (a == wave ? 0 : 1)] = run + rank;
                        run += __popcll(m); }
                }
                __syncthreads();
                if (tid < 256) { const int t = bx * 128 + (tid >> 1); const int s = lslot[tid]; tok_slot[bx * 256 + tid] = s; rsx[s] = tok_rs[t]; }
                for (int p = wave; p < 256; p += 8) { const int t = bx * 128 + (p >> 1), s = lslot[p];
                    const GAS v4u* src = (const GAS v4u*)(XB + (size_t)t * D) + lane; GAS v4u* dst = (GAS v4u*)(XG + (size_t)s * D) + lane; dst[0] = src[0]; dst[64] = src[64]; }
                __syncthreads();
                GRID_BAR();
            }
            if (IN(PH_G1)) { PHASE_VIEW(); MOE_VIEW();
                const int nblk = blk[0];
                pg8::Gemm g{XG, (const bf16*)(ws + WS_WEGU), nblk * 256, 2 * EFF, D}; pg8::MoeOrder S; S.init(nblk * 256, 2 * EFF, G, bx); S.blk_e = blk + 1; S.ntile = 2 * EFF / 256;
                pg8::EpiSwi<true> E{nullptr, rsx, EA, EFF};
                pg8::gemm_phase<pg8::EpiSwi<true>, pg8::MoeOrder, true, true>(lds + RING_OFF, g, S, E);
                GRID_BAR();
            }
            if (IN(PH_G2)) { PHASE_VIEW(); MOE_VIEW();
                const int nblk = blk[0];
                pg8::Gemm g{EA, (const bf16*)(ws + WS_WED), nblk * 256, D, EFF}; pg8::MoeOrder S; S.init(nblk * 256, D, G, bx); S.blk_e = blk + 1; S.ntile = D / 256;
                pg8::EpiStore E{XG, D};
                pg8::gemm_phase<pg8::EpiStore, pg8::MoeOrder, true, true>(lds + RING_OFF, g, S, E);
                GRID_BAR();
            }
            if (IN(PH_CMB)) { PHASE_VIEW(); MOE_VIEW();
                for (int t = gw; t < T; t += NGW) {
                    const int s1 = tok_slot[2 * t], s2 = tok_slot[2 * t + 1]; const float g1 = tok_g[2 * t], g2 = tok_g[2 * t + 1];
                    GAS f32x4* xr = (GAS f32x4*)(X + (size_t)t * D) + lane; typedef unsigned u2 __attribute__((ext_vector_type(2)));
                    const GAS u2* y1 = (const GAS u2*)(XG + (size_t)s1 * D) + lane; const GAS u2* y2 = (const GAS u2*)(XG + (size_t)s2 * D) + lane;
                    GAS unsigned long long* o8 = (GAS unsigned long long*)(XB + (size_t)t * D) + lane; float s = 0.f;
#pragma unroll
                    for (int j = 0; j < 4; ++j) { f32x4 v = xr[64 * j]; const u2 a = y1[64 * j], b2 = y2[64 * j];
                        v = v + (pg8::bf_lo4(a.x, a.y) * g1 + pg8::bf_lo4(b2.x, b2.y) * g2); xr[64 * j] = v; s += (v.x * v.x + v.y * v.y) + (v.z * v.z + v.w * v.w);
                        o8[64 * j] = (unsigned long long)pk2(v.x, v.y) | ((unsigned long long)pk2(v.z, v.w) << 32); }
                    s = wave_sum(s);
                    if (lane < 16) PART[(size_t)t * 16 + lane] = lane == 0 ? s : 0.f;
                }
                GRID_BAR();
            }
        }

        if (IN(PH_I)) { PHASE_VIEW(); MIX_VIEW();
            bf16* PP = (bf16*)(ws + WS_PP);
            { pg8::Gemm g{(const bf16*)(ws + WS_PB) + (size_t)L * T * PLE_DIM, (const bf16*)(ws + WS_WPP) + (size_t)L * D * PLE_DIM, T, D, PLE_DIM}; pg8::StaticOrder S; S.init(T, D, G, bx);
              pg8::EpiStore E{PP, D};
              pg8::gemm_phase<pg8::EpiStore, pg8::StaticOrder, true, true>(lds + RING_OFF, g, S, E); }
            { pg8::Gemm g{XB, (const bf16*)(ws + WS_WPG) + (size_t)L * D * D, T, D, D}; pg8::StaticOrder S; S.init(T, D, G, bx);
              pg8::EpiRes<true> E{X, XBN, PARTN, PART, PP};
              pg8::gemm_phase<pg8::EpiRes<true>, pg8::StaticOrder, true, true>(lds + RING_OFF, g, S, E); }
            GRID_BAR();
        }
    }
    if (3 >= l_lo && 3 < l_hi) { constexpr int L = 3;
        const bool moe = (L & 1) != 0; const int jl = L >> 1;
#define MOE_VIEW() int* tok_e = (int*)(ws + WS_MOE + MO_TOKE); float* tok_g = (float*)(ws + WS_MOE + MO_TOKG); float* tok_rs = (float*)(ws + WS_MOE + MO_TOKRS); \
            int* tok_slot = (int*)(ws + WS_MOE + MO_SLOT); float* rsx = (float*)(ws + WS_MOE + MO_RSX); int* cnts = (int*)(ws + WS_MOE + MO_CNT); int* blk = (int*)(ws + WS_MOE + MO_BLK); \
            bf16* XG = (bf16*)(ws + WS_XG); bf16* EA = (bf16*)(ws + WS_EA); \
            (void)tok_e; (void)tok_g; (void)tok_rs; (void)tok_slot; (void)rsx; (void)cnts; (void)blk; (void)XG; (void)EA
#define MIX_VIEW() bf16* Zb = (bf16*)(ws + WS_Z); bf16* Qb = (bf16*)(ws + WS_Q); bf16* Kb = (bf16*)(ws + WS_K); bf16* KZT = (bf16*)(ws + WS_KZT); bf16* VT = (bf16*)(ws + WS_VT); \
        bf16* SG = (bf16*)(ws + WS_SG); bf16* SGA = (bf16*)(ws + WS_SGA); bf16* SGB = (bf16*)(ws + WS_SGB); bf16* Cb = (bf16*)(ws + WS_C); \
        float* KVT = (float*)(ws + WS_KVT); bf16* ST = (bf16*)(ws + WS_ST); bf16* MG = (bf16*)(ws + WS_MG); \
        (void)Zb; (void)Qb; (void)Kb; (void)KZT; (void)VT; (void)SG; (void)SGA; (void)SGB; (void)Cb; (void)KVT; (void)ST; (void)MG

        if (IN(PH_A)) { PHASE_VIEW(); MIX_VIEW();
            { pg8::Gemm g{XBN, (const bf16*)(ws + WS_WIN) + (size_t)L * 5120 * D, T, 5120, D}; pg8::StaticOrder S; S.init(T, 5120, G, bx);
              pg8::EpiIn E{PARTN, (const float*)(ws + WS_COS), (const float*)(ws + WS_SIN), Zb, Qb, SG};
              static_assert(WS_K - WS_Q == 2 * pg8::EpiIn::QK_STRIDE && WS_SGA - WS_SG == 2 * pg8::EpiIn::G_STRIDE && WS_SGB - WS_SGA == 2 * pg8::EpiIn::G_STRIDE, "EpiIn strides");
              pg8::gemm_phase<pg8::EpiIn, pg8::StaticOrder, true, true>(lds + RING_OFF, g, S, E); }
            { pg8::Gemm g{(const bf16*)(ws + WS_WKVT) + (size_t)L * 1536 * D, XBN, 1536, T, D}; pg8::StaticOrder S; S.init(1536, T, G, bx);
              pg8::EpiKvT E{PARTN, (const float*)(ws + WS_COST), (const float*)(ws + WS_SINT), KZT, VT};
              pg8::gemm_phase<pg8::EpiKvT, pg8::StaticOrder, true, true>(lds + RING_OFF, g, S, E); }
            GRID_BAR();
        }

        if (IN(PH_B)) { PHASE_VIEW(); MIX_VIEW();
            {
                const float* cw = INP(4) + (size_t)L * CONV_W * CONV_DIM; const float* cb = INP(5) + L * CONV_DIM;
                const float* lg = INP(6) + L * CONV_DIM; const float* lb = INP(7) + L * CONV_DIM;
                LAS unsigned* zt = (LAS unsigned*)(lds + RING_OFF);
                LAS float* ot = (LAS float*)(lds + RING_OFF + 65536);
                const int cp = tid & 255, half = tid >> 8;
                float w0[CONV_W], w1[CONV_W];
#pragma unroll
                for (int w = 0; w < CONV_W; ++w) { w0[w] = cw[w * CONV_DIM + 2 * cp]; w1[w] = cw[w * CONV_DIM + 2 * cp + 1]; }
                const float b0 = cb[2 * cp], b1 = cb[2 * cp + 1];
                f32x4 lg0 = *(const f32x4*)(lg + 8 * lane), lg1 = *(const f32x4*)(lg + 8 * lane + 4), lb0 = *(const f32x4*)(lb + 8 * lane), lb1 = *(const f32x4*)(lb + 8 * lane + 4);
                for (int u = bx; u < T / 32; u += G) {
                    const int tok0 = u * 32, pos0 = tok0 & (SEQ - 1);
                    for (int idx = tid; idx < 62 * 64; idx += 512) { const int r = idx >> 6, ch = idx & 63; const int pos = pos0 - 30 + r;
                        v4u v = {0u, 0u, 0u, 0u}; if (pos >= 0) v = *(const GAS v4u*)(Zb + (size_t)(tok0 - 30 + r) * CONV_DIM + ch * 8);
                        *(LAS v4u*)(zt + r * 256 + ch * 4) = v; }
                    __syncthreads();
#pragma unroll 1
                    for (int tg = 0; tg < 2; ++tg) { const int tb = 16 * half + 8 * tg;
                        float a0[8], a1[8];
#pragma unroll
                        for (int q = 0; q < 8; ++q) { a0[q] = b0; a1[q] = b1; }
#pragma unroll
                        for (int r = 0; r < 38; ++r) { const unsigned pv = zt[(tb + r) * 256 + cp]; const float f0 = __uint_as_float(pv << 16), f1 = __uint_as_float(pv & 0xffff0000u);
#pragma unroll
                            for (int q = 0; q < 8; ++q) { const int w = r - q; if (w >= 0 && w < CONV_W) { a0[q] = fmaf(w0[w], f0, a0[q]); a1[q] = fmaf(w1[w], f1, a1[q]); } } }
#pragma unroll
                        for (int q = 0; q < 8; ++q) { typedef float f2 __attribute__((ext_vector_type(2))); *(LAS f2*)(ot + (tb + q) * 512 + 2 * cp) = (f2){a0[q], a1[q]}; } }
                    __syncthreads();
#pragma unroll 1
                    for (int q = 0; q < 4; ++q) { const int tk = 4 * wave + q; const LAS f32x4* op = (const LAS f32x4*)(ot + tk * 512 + 8 * lane); f32x4 v0 = op[0], v1 = op[1];
                        const float mean = wave_sum((v0.x + v0.y) + (v0.z + v0.w) + (v1.x + v1.y) + (v1.z + v1.w)) * (1.0f / 512.0f);
                        v0 = v0 - mean; v1 = v1 - mean;
                        const float var = wave_sum((v0.x * v0.x + v0.y * v0.y) + (v0.z * v0.z + v0.w * v0.w) + (v1.x * v1.x + v1.y * v1.y) + (v1.z * v1.z + v1.w * v1.w)) * (1.0f / 512.0f);
                        const float rstd = __builtin_amdgcn_rsqf(var + EPS);
                        v0 = v0 * rstd * lg0 + lb0; v1 = v1 * rstd * lg1 + lb1;
                        v0 = v0 * pg8::sigm4(v0); v1 = v1 * pg8::sigm4(v1);
                        *(GAS v4u*)(Cb + (size_t)(tok0 + tk) * CONV_DIM + 8 * lane) = pg8::pack8(v0, v1); }
                    __syncthreads();
                }
            }
            {
                const int fr = lane & 15, g4 = lane >> 4;
                for (int u = bx; u < NUNIT; u += G) {
                    const int n = u & 63, bh = u >> 6, h = bh & 7, b = bh >> 3; const size_t tok0 = (size_t)b * SEQ + n * RC;
                    bf16x8 Bv[4];
#pragma unroll
                    for (int ks = 0; ks < 4; ++ks) Bv[ks] = *(const GAS bf16x8*)(VT + (size_t)(h * RDV + 16 * wave + fr) * T + tok0 + 32 * ks + 8 * g4);
#pragma unroll
                    for (int dkt = 0; dkt < 4; ++dkt) { f32x4 acc = {0.f, 0.f, 0.f, 0.f};
#pragma unroll
                        for (int ks = 0; ks < 4; ++ks) { const bf16x8 Ak = *(const GAS bf16x8*)(KZT + (size_t)(h * RDK + 16 * dkt + fr) * T + tok0 + 32 * ks + 8 * g4);
                            acc = __builtin_amdgcn_mfma_f32_16x16x32_bf16(Ak, Bv[ks], acc, 0, 0, 0); }
                        *(GAS f32x4*)(KVT + (size_t)u * (RDV * RDK) + (16 * wave + fr) * RDK + 16 * dkt + 4 * g4) = acc; }
                }
            }
            if (moe) {
                __syncthreads();
                LAS float* scr = (LAS float*)(lds + RING_OFF + wave * 16384);
                constexpr int I_GU = 16 * 224, I_DN = 56 * 32, I_EXP = I_GU + I_DN;
                for (int it = gw; it < NEXP * I_EXP; it += NGW) { const int e = it / I_EXP, r = it % I_EXP; const size_t o = ((size_t)jl * NEXP + e) * D * EFF;
                    if (r < I_GU) conv_item(INP(16) + o, INP(17) + o, INP(11) + L * D, (bf16*)(ws + WS_WEGU) + (size_t)e * 2 * EFF * D, EFF, D, 224, 3, r, scr, lane);
                    else conv_item(INP(18) + o, nullptr, nullptr, (bf16*)(ws + WS_WED) + (size_t)e * D * EFF, D, EFF, 32, 0, r - I_GU, scr, lane); }
            }
            GRID_BAR();
        }

        if (IN(PH_C)) { PHASE_VIEW(); MIX_VIEW();
            {   const int gt = bx * 512 + tid;
                if (gt < 32 * 4096) { const int bh = gt >> 12, e2 = gt & 4095, h = bh & 7; const float gc = __builtin_amdgcn_exp2f(128.0f * log2g(h));
                    float s0 = 0.f, s1 = 0.f; typedef float f2 __attribute__((ext_vector_type(2)));
                    const GAS f2* kv = (const GAS f2*)(KVT + (size_t)bh * NCH * (RDV * RDK)) + e2; GAS unsigned* st = (GAS unsigned*)(ST + (size_t)bh * NCH * (RDV * RDK)) + e2;
#pragma unroll 8
                    for (int n = 0; n < NCH; ++n) { const f2 v = kv[(size_t)n * 4096]; st[(size_t)n * 4096] = pk2(s0, s1); s0 = fmaf(gc, s0, v.x); s1 = fmaf(gc, s1, v.y); } }
            }
            { pg8::Gemm g{Cb, (const bf16*)(ws + WS_WCO) + (size_t)L * D * CONV_DIM, T, D, CONV_DIM}; pg8::StaticOrder S; S.init(T, D, G, bx);
              pg8::EpiGate<false> E{SGA, MG};
              pg8::gemm_phase<pg8::EpiGate<false>, pg8::StaticOrder, true, true>(lds + RING_OFF, g, S, E); }
            GRID_BAR();
        }

        if (IN(PH_D)) { PHASE_VIEW(); MIX_VIEW();
            const int fr = lane & 15, g4 = lane >> 4;
            for (int u = bx; u < NUNIT; u += G) {
                const int n = u & 63, bh = u >> 6, h = bh & 7, b = bh >> 3; const size_t tok0 = (size_t)b * SEQ + n * RC; const float lg = log2g(h);
                const size_t tok = tok0 + 16 * wave + fr;
                bf16x8 Bq[2];
#pragma unroll
                for (int ks = 0; ks < 2; ++ks) Bq[ks] = *(const GAS bf16x8*)(Qb + tok * 512 + h * RDK + 32 * ks + 8 * g4);
                unsigned P[8][2];
#pragma unroll
                for (int jt2 = 0; jt2 < 8; ++jt2) {
                    if (jt2 <= wave) { f32x4 s = {0.f, 0.f, 0.f, 0.f};
#pragma unroll
                        for (int ks = 0; ks < 2; ++ks) { const bf16x8 Ak = *(const GAS bf16x8*)(Kb + (tok0 + 16 * jt2 + fr) * 512 + h * RDK + 32 * ks + 8 * g4);
                            s = __builtin_amdgcn_mfma_f32_16x16x32_bf16(Ak, Bq[ks], s, 0, 0, 0); }
                        const int dd = (16 * wave + fr) - (16 * jt2 + 4 * g4);
                        const float d0 = dd >= 0 ? s.x * __builtin_amdgcn_exp2f((float)dd * lg) : 0.f, d1 = dd >= 1 ? s.y * __builtin_amdgcn_exp2f((float)(dd - 1) * lg) : 0.f;
                        const float d2 = dd >= 2 ? s.z * __builtin_amdgcn_exp2f((float)(dd - 2) * lg) : 0.f, d3 = dd >= 3 ? s.w * __builtin_amdgcn_exp2f((float)(dd - 3) * lg) : 0.f;
                        P[jt2][0] = pg8::cvt_pk_bf16(d0, d1); P[jt2][1] = pg8::cvt_pk_bf16(d2, d3);
                    } else { P[jt2][0] = 0u; P[jt2][1] = 0u; }
                }
                f32x4 oT[8], cT[8];
#pragma unroll
                for (int dvt = 0; dvt < 8; ++dvt) { oT[dvt] = (f32x4){0.f, 0.f, 0.f, 0.f}; cT[dvt] = (f32x4){0.f, 0.f, 0.f, 0.f}; }
#pragma unroll
                for (int t2 = 0; t2 < 4; ++t2) {
                    if (2 * t2 <= wave) {
                        typedef unsigned u2 __attribute__((ext_vector_type(2)));
                        v4u bp; bp.x = P[2 * t2][0]; bp.y = P[2 * t2][1]; bp.z = P[2 * t2 + 1][0]; bp.w = P[2 * t2 + 1][1];
                        const bf16x8 Bp = __builtin_bit_cast(bf16x8, bp);
#pragma unroll
                        for (int dvt = 0; dvt < 8; ++dvt) { const GAS bf16* vp = (const GAS bf16*)VT + (size_t)(h * RDV + 16 * dvt + fr) * T + tok0 + 32 * t2 + 4 * g4;
                            const u2 lo = *(const GAS u2*)vp, hi = *(const GAS u2*)(vp + 16); v4u av; av.x = lo.x; av.y = lo.y; av.z = hi.x; av.w = hi.y;
                            oT[dvt] = __builtin_amdgcn_mfma_f32_16x16x32_bf16(__builtin_bit_cast(bf16x8, av), Bp, oT[dvt], 0, 0, 0); }
                    }
                }
#pragma unroll
                for (int dvt = 0; dvt < 8; ++dvt)
#pragma unroll
                    for (int ks = 0; ks < 2; ++ks) { const bf16x8 As = *(const GAS bf16x8*)(ST + (size_t)u * (RDV * RDK) + (16 * dvt + fr) * RDK + 32 * ks + 8 * g4);
                        cT[dvt] = __builtin_amdgcn_mfma_f32_16x16x32_bf16(As, Bq[ks], cT[dvt], 0, 0, 0); }
                const float xi = __builtin_amdgcn_exp2f((float)(16 * wave + fr + 1) * lg);
                float sm = 0.f;
#pragma unroll
                for (int dvt = 0; dvt < 8; ++dvt) { oT[dvt] = oT[dvt] + cT[dvt] * xi; sm += (oT[dvt].x + oT[dvt].y) + (oT[dvt].z + oT[dvt].w); }
                sm += __shfl_xor(sm, 16); sm += __shfl_xor(sm, 32);
                const float mean = sm * (1.0f / 128.0f); float sq = 0.f;
#pragma unroll
                for (int dvt = 0; dvt < 8; ++dvt) { oT[dvt] = oT[dvt] - mean; sq += (oT[dvt].x * oT[dvt].x + oT[dvt].y * oT[dvt].y) + (oT[dvt].z * oT[dvt].z + oT[dvt].w * oT[dvt].w); }
                sq += __shfl_xor(sq, 16); sq += __shfl_xor(sq, 32);
                const float rstd = __builtin_amdgcn_rsqf(sq * (1.0f / 128.0f) + EPS);
#pragma unroll
                for (int dvt = 0; dvt < 8; ++dvt) { typedef unsigned u2 __attribute__((ext_vector_type(2)));
                    GAS u2* gp = (GAS u2*)(SG + tok * 1024 + h * RDV + 16 * dvt + 4 * g4); const u2 gv = *gp; const f32x4 gf = pg8::bf_lo4(gv.x, gv.y);
                    const f32x4 r = oT[dvt] * rstd * gf; u2 o; o.x = pg8::cvt_pk_bf16(r.x, r.y); o.y = pg8::cvt_pk_bf16(r.z, r.w); *gp = o; }
            }
            GRID_BAR();
        }

        if (IN(PH_E)) { PHASE_VIEW(); MIX_VIEW();
            pg8::Gemm g{SG, (const bf16*)(ws + WS_WRO) + (size_t)L * D * D, T, D, D}; pg8::StaticOrder S; S.init(T, D, G, bx);
            pg8::EpiGate<true> E{SGB, MG};
            pg8::gemm_phase<pg8::EpiGate<true>, pg8::StaticOrder, true, true>(lds + RING_OFF, g, S, E);
            GRID_BAR();
        }

        if (IN(PH_F)) { PHASE_VIEW(); MIX_VIEW();
            pg8::Gemm g{MG, (const bf16*)(ws + WS_WO) + (size_t)L * D * D, T, D, D}; pg8::StaticOrder S; S.init(T, D, G, bx);
            pg8::EpiRes<false> E{X, XB, PART, nullptr, nullptr};
            pg8::gemm_phase<pg8::EpiRes<false>, pg8::StaticOrder, true, true>(lds + RING_OFF, g, S, E);
            GRID_BAR();
        }

        if (!moe) {
            if (IN(PH_G)) { PHASE_VIEW(); MOE_VIEW();
                pg8::Gemm g{XB, (const bf16*)(ws + WS_WDGU) + (size_t)jl * 2 * DFF * D, T, 2 * DFF, D}; pg8::StaticOrder S; S.init(T, 2 * DFF, G, bx);
                pg8::EpiSwi<false> E{PART, nullptr, (bf16*)(ws + WS_FA), DFF};
                pg8::gemm_phase<pg8::EpiSwi<false>, pg8::StaticOrder, true, true>(lds + RING_OFF, g, S, E);
                GRID_BAR();
            }
            if (IN(PH_H)) { PHASE_VIEW(); MOE_VIEW();
                pg8::Gemm g{(const bf16*)(ws + WS_FA), (const bf16*)(ws + WS_WDD) + (size_t)jl * D * DFF, T, D, DFF}; pg8::StaticOrder S; S.init(T, D, G, bx);
                pg8::EpiRes<false> E{X, XB, PART, nullptr, nullptr};
                pg8::gemm_phase<pg8::EpiRes<false>, pg8::StaticOrder, true, true>(lds + RING_OFF, g, S, E);
                GRID_BAR();
            }
        } else {
            if (IN(PH_G)) { PHASE_VIEW(); MOE_VIEW();
                LAS float* wrT = (LAS float*)(lds + RING_OFF);
                LAS int* lcnt = (LAS int*)(lds + RING_OFF + 32768);
                const float* wr = INP(15) + (size_t)jl * D * NEXP; const float* gf = INP(11) + L * D;
                for (int i = tid; i < D * NEXP; i += 512) { const int k = i >> 3, e = i & 7; wrT[e * 1024 + k] = wr[i] * gf[k]; }
                if (tid < 8) lcnt[tid] = 0;
                __syncthreads();
                for (int q = 0; q < 16; ++q) { const int t = bx * 128 + wave * 16 + q;
                    const GAS f32x4* xr = (const GAS f32x4*)(X + (size_t)t * D) + lane; f32x4 xv[4]; float ss = 0.f;
#pragma unroll
                    for (int j = 0; j < 4; ++j) { xv[j] = xr[64 * j]; ss += (xv[j].x * xv[j].x + xv[j].y * xv[j].y) + (xv[j].z * xv[j].z + xv[j].w * xv[j].w); }
                    float lgt[8];
#pragma unroll
                    for (int e = 0; e < 8; ++e) { float a = 0.f;
#pragma unroll
                        for (int j = 0; j < 4; ++j) { const f32x4 w = *(const LAS f32x4*)(wrT + e * 1024 + 256 * j + 4 * lane); a += (xv[j].x * w.x + xv[j].y * w.y) + (xv[j].z * w.z + xv[j].w * w.w); }
                        lgt[e] = wave_sum(a); }
                    ss = wave_sum(ss); const float rs = __builtin_amdgcn_rsqf(ss * (1.0f / 1024.0f) + EPS);
                    int e1 = 0; float v1 = lgt[0];
#pragma unroll
                    for (int e = 1; e < 8; ++e) if (lgt[e] > v1) { v1 = lgt[e]; e1 = e; }
                    int e2 = -1; float v2 = 0.f;
#pragma unroll
                    for (int e = 0; e < 8; ++e) if (e != e1 && (e2 < 0 || lgt[e] > v2)) { v2 = lgt[e]; e2 = e; }
                    const float ex = __builtin_amdgcn_exp2f((v2 - v1) * rs * kLog2e), g1 = 1.0f / (1.0f + ex), g2 = ex * g1;
                    if (lane == 0) { tok_e[2 * t] = e1; tok_e[2 * t + 1] = e2; tok_g[2 * t] = g1; tok_g[2 * t + 1] = g2; tok_rs[t] = rs; atomicAdd((int*)&lcnt[e1], 1); atomicAdd((int*)&lcnt[e2], 1); }
                }
                __syncthreads();
                if (tid < 8) cnts[bx * 8 + tid] = lcnt[tid];
                __syncthreads();
                GRID_BAR();
            }
            if (IN(PH_H)) { PHASE_VIEW(); MOE_VIEW();
                LAS int* lc = (LAS int*)(lds + RING_OFF);
                LAS int* base = lc + 2048;
                LAS int* lslot = base + 16;
                LAS int* le = lslot + 256;
                for (int i = tid; i < 2048; i += 512) lc[i] = cnts[i];
                if (tid < 256) le[tid] = tok_e[bx * 256 + tid];
                __syncthreads();
                {
                    int tot = 0, pre = 0;
#pragma unroll
                    for (int k = 0; k < 4; ++k) { const int wg = lane + 64 * k; const int c = lc[wg * 8 + wave]; tot += c; pre += (wg < bx) ? c : 0; }
#pragma unroll
                    for (int o = 1; o < 64; o <<= 1) { tot += __shfl_xor(tot, o); pre += __shfl_xor(pre, o); }
                    if (lane == 0) { base[wave] = pre; base[8 + wave] = tot; }
                }
                __syncthreads();
                if (tid == 0) { int ps = 0; for (int e = 0; e < 8; ++e) { const int tot = base[8 + e]; base[e] += ps; const int nb = (tot + 255) >> 8;
                        if (bx == 0) { for (int q = 0; q < nb; ++q) blk[1 + (ps >> 8) + q] = e; }
                        ps += nb << 8; }
                    if (bx == 0) blk[0] = ps >> 8; }
                __syncthreads();
                {
                    int run = base[wave];
#pragma unroll
                    for (int k = 0; k < 2; ++k) { const int i = lane + 64 * k; const int a = le[2 * i], b2 = le[2 * i + 1]; const bool f = (a == wave) || (b2 == wave);
                        const unsigned long long m = __ballot(f); const int rank = __popcll(m & ((1ull << lane) - 1ull));
                        if (f) lslot[2 * i + (a == wave ? 0 : 1)] = run + rank;
                        run += __popcll(m); }
                }
                __syncthreads();
                if (tid < 256) { const int t = bx * 128 + (tid >> 1); const int s = lslot[tid]; tok_slot[bx * 256 + tid] = s; rsx[s] = tok_rs[t]; }
                for (int p = wave; p < 256; p += 8) { const int t = bx * 128 + (p >> 1), s = lslot[p];
                    const GAS v4u* src = (const GAS v4u*)(XB + (size_t)t * D) + lane; GAS v4u* dst = (GAS v4u*)(XG + (size_t)s * D) + lane; dst[0] = src[0]; dst[64] = src[64]; }
                __syncthreads();
                GRID_BAR();
            }
            if (IN(PH_G1)) { PHASE_VIEW(); MOE_VIEW();
                const int nblk = blk[0];
                pg8::Gemm g{XG, (const bf16*)(ws + WS_WEGU), nblk * 256, 2 * EFF, D}; pg8::MoeOrder S; S.init(nblk * 256, 2 * EFF, G, bx); S.blk_e = blk + 1; S.ntile = 2 * EFF / 256;
                pg8::EpiSwi<true> E{nullptr, rsx, EA, EFF};
                pg8::gemm_phase<pg8::EpiSwi<true>, pg8::MoeOrder, true, true>(lds + RING_OFF, g, S, E);
                GRID_BAR();
            }
            if (IN(PH_G2)) { PHASE_VIEW(); MOE_VIEW();
                const int nblk = blk[0];
                pg8::Gemm g{EA, (const bf16*)(ws + WS_WED), nblk * 256, D, EFF}; pg8::MoeOrder S; S.init(nblk * 256, D, G, bx); S.blk_e = blk + 1; S.ntile = D / 256;
                pg8::EpiStore E{XG, D};
                pg8::gemm_phase<pg8::EpiStore, pg8::MoeOrder, true, true>(lds + RING_OFF, g, S, E);
                GRID_BAR();
            }
            if (IN(PH_CMB)) { PHASE_VIEW(); MOE_VIEW();
                for (int t = gw; t < T; t += NGW) {
                    const int s1 = tok_slot[2 * t], s2 = tok_slot[2 * t + 1]; const float g1 = tok_g[2 * t], g2 = tok_g[2 * t + 1];
                    GAS f32x4* xr = (GAS f32x4*)(X + (size_t)t * D) + lane; typedef unsigned u2 __attribute__((ext_vector_type(2)));
                    const GAS u2* y1 = (const GAS u2*)(XG + (size_t)s1 * D) + lane; const GAS u2* y2 = (const GAS u2*)(XG + (size_t)s2 * D) + lane;
                    GAS unsigned long long* o8 = (GAS unsigned long long*)(XB + (size_t)t * D) + lane; float s = 0.f;
#pragma unroll
                    for (int j = 0; j < 4; ++j) { f32x4 v = xr[64 * j]; const u2 a = y1[64 * j], b2 = y2[64 * j];
                        v = v + (pg8::bf_lo4(a.x, a.y) * g1 + pg8::bf_lo4(b2.x, b2.y) * g2); xr[64 * j] = v; s += (v.x * v.x + v.y * v.y) + (v.z * v.z + v.w * v.w);
                        o8[64 * j] = (unsigned long long)pk2(v.x, v.y) | ((unsigned long long)pk2(v.z, v.w) << 32); }
                    s = wave_sum(s);
                    if (lane < 16) PART[(size_t)t * 16 + lane] = lane == 0 ? s : 0.f;
                }
                GRID_BAR();
            }
        }

        if (IN(PH_I)) { PHASE_VIEW(); MIX_VIEW();
            bf16* PP = (bf16*)(ws + WS_PP);
            { pg8::Gemm g{(const bf16*)(ws + WS_PB) + (size_t)L * T * PLE_DIM, (const bf16*)(ws + WS_WPP) + (size_t)L * D * PLE_DIM, T, D, PLE_DIM}; pg8::StaticOrder S; S.init(T, D, G, bx);
              pg8::EpiStore E{PP, D};
              pg8::gemm_phase<pg8::EpiStore, pg8::StaticOrder, true, true>(lds + RING_OFF, g, S, E); }
            { pg8::Gemm g{XB, (const bf16*)(ws + WS_WPG) + (size_t)L * D * D, T, D, D}; pg8::StaticOrder S; S.init(T, D, G, bx);
              pg8::EpiRes<true> E{X, XBN, PARTN, PART, PP};
              pg8::gemm_phase<pg8::EpiRes<true>, pg8::StaticOrder, true, true>(lds + RING_OFF, g, S, E); }
            GRID_BAR();
        }
    }

    if (l_hi > DEPTH) { PHASE_VIEW();
        const float* gf = INP(22);
        f32x4 gv[4];
#pragma unroll
        for (int j = 0; j < 4; ++j) gv[j] = *((const f32x4*)gf + lane + 64 * j);
        for (int m = gw; m < T; m += NGW) { GAS f32x4* xr = (GAS f32x4*)(X + (size_t)m * D) + lane; f32x4 v[4]; float s = 0.f;
#pragma unroll
            for (int j = 0; j < 4; ++j) { v[j] = xr[64 * j]; s += (v[j].x * v[j].x + v[j].y * v[j].y) + (v[j].z * v[j].z + v[j].w * v[j].w); }
            const float rs = __builtin_amdgcn_rsqf(wave_sum(s) * (1.0f / 1024.0f) + EPS);
#pragma unroll
            for (int j = 0; j < 4; ++j) xr[64 * j] = v[j] * rs * gv[j]; }
    }
#undef IN
#undef GRID_BAR
#undef INP
#undef PHASE_VIEW
#undef MIX_VIEW
#undef MOE_VIEW
}

extern "C" void kernel_launch(void* const* d_in, const int* in_sizes, int n_in, void* d_out, int out_size, void* d_ws, size_t ws_size, hipStream_t stream) {
    static int grid = 0;
    if (grid == 0) {
        if (n_in != 23 || out_size != T * D || ws_size < WS_END) { fprintf(stderr, "kernel_launch: unexpected shapes: n_in %d out %d ws %zu (need %zu)\n", n_in, out_size, ws_size, (size_t)WS_END); grid = -1; return; }
        int dev = 0, cus = 0, per_cu = 0;
        if (hipGetDevice(&dev) != hipSuccess || hipDeviceGetAttribute(&cus, hipDeviceAttributeMultiprocessorCount, dev) != hipSuccess) { grid = -1; return; }
        if (hipFuncSetAttribute((const void*)hybrid_fwd, hipFuncAttributeMaxDynamicSharedMemorySize, LDS_BYTES) != hipSuccess) { fprintf(stderr, "kernel_launch: hipFuncSetAttribute failed\n"); grid = -1; return; }
        if (hipOccupancyMaxActiveBlocksPerMultiprocessor(&per_cu, (const void*)hybrid_fwd, NWAVES * 64, LDS_BYTES) != hipSuccess || per_cu < 1) { fprintf(stderr, "kernel_launch: occupancy query reports %d\n", per_cu); }
        (void)hipGetLastError();
        grid = cus;
        if (grid != 256) { fprintf(stderr, "kernel_launch: built for 256 CUs, found %d\n", cus); grid = -1; return; }
    }
    if (grid < 0) return;
    (void)hipMemsetAsync((char*)d_ws + WS_CTL, 0, CTL_ZERO_BYTES, stream);
    Args a{};
    for (int i = 0; i < 23; ++i) a.in[i] = (const float*)d_in[i];
    a.out = (float*)d_out; a.ws = (unsigned char*)d_ws; a.pad = 0;
#if MK_FUSED
    a.l_lo = -1; a.l_hi = DEPTH + 1; a.ph_lo = 0; a.ph_hi = PH_N; a.fused = 1;
    hipLaunchKernelGGL(hybrid_fwd, dim3(grid), dim3(NWAVES * 64), LDS_BYTES, stream, a);
#else
    a.fused = 0;
    a.l_lo = -1; a.l_hi = 0; a.ph_lo = 0; a.ph_hi = 0;
    hipLaunchKernelGGL(hybrid_fwd, dim3(grid), dim3(NWAVES * 64), LDS_BYTES, stream, a);
    for (int L = 0; L < DEPTH; ++L)
        for (int ph = 0; ph < PH_N; ++ph) {
            if ((L & 1) == 0 && (ph == PH_G1 || ph == PH_G2 || ph == PH_CMB)) continue;
            a.l_lo = L; a.l_hi = L + 1; a.ph_lo = ph; a.ph_hi = ph + 1;
            hipLaunchKernelGGL(hybrid_fwd, dim3(grid), dim3(NWAVES * 64), LDS_BYTES, stream, a);
        }
    a.l_lo = DEPTH; a.l_hi = DEPTH + 1; a.ph_lo = 0; a.ph_hi = 0;
    hipLaunchKernelGGL(hybrid_fwd, dim3(grid), dim3(NWAVES * 64), LDS_BYTES, stream, a);
#endif
}
```

```cpp
#include <hip/hip_runtime.h>
#include <cstdio>
#include <cstdint>
#ifndef SC_E
#define SC_E 1.0f
#endif
#ifndef SC_F
#define SC_F 1.0f
#endif
#ifndef SC_Hd
#define SC_Hd 1.0f
#endif
#ifndef SC_I
#define SC_I 1.0f
#endif
#ifndef SC_CMB
#define SC_CMB 1.0f
#endif
#ifndef PB_MODE
#define PB_MODE 0
#endif
#ifndef INPROJ8_LAYER
#define INPROJ8_LAYER 2
#endif
#ifndef A0G8
#define A0G8 1
#endif
#ifndef PLE8_LAYER
#define PLE8_LAYER 1
#endif
#ifndef MK_FUSED
#define MK_FUSED 1
#endif
namespace pg8 {
#define PG8_LAS __attribute__((address_space(3)))
typedef unsigned short bf16_t;
typedef short bf16x8 __attribute__((ext_vector_type(8)));
typedef float f32x4 __attribute__((ext_vector_type(4)));
typedef unsigned u32x4 __attribute__((ext_vector_type(4)));
typedef int i32x4 __attribute__((ext_vector_type(4)));
typedef int i32x8 __attribute__((ext_vector_type(8)));
constexpr int BM = 256, BK = 64, HALF = 128, HTB = HALF * BK * 2  , STAGE_BYTES = 8 * HTB, NXCD = 8, WGM = 8;

__host__ __device__ __forceinline__ int lds_byte(int r, int c) { const int st = (r >> 4) * 2 + (c >> 5), rr = r & 15, cc = c & 31, ob = rr * 64 + cc * 2; return st * 1024 + (ob ^ (((ob >> 9) & 1) << 5)); }
__host__ __device__ __forceinline__ void stage_rc(int b, int& R, int& C) { const int st = b / 1024, sb = b % 1024, swz = sb ^ (((sb >> 9) & 1) << 5); R = (st >> 1) * 16 + swz / 64; C = (st & 1) * 32 + (swz % 64) / 2; }
__host__ __device__ __forceinline__ int perm32(int rho) { const int n = rho >> 4, i = rho & 15; return 8 * (i >> 2) + 4 * n + (i & 3); }

struct Unit { int pm, pn, pb; };
struct Gemm { const bf16_t* A; const bf16_t* Bt; int M, N, K; };

struct StaticOrder {
    int nM, nN, nwg, G, c, rev;
    __host__ __device__ void init(int M, int N, int G_, int c_, int rev_ = 0) { nM = M / BM; nN = N / BM; nwg = nM * nN; G = G_; c = c_; rev = rev_; }
    __host__ __device__ bool next(int i, Unit& u) const {
        const long L = (long)i * G + c; if (L >= nwg) return false;
        int wgid = (int)L; { const int q = nwg / NXCD, r = nwg % NXCD, xcd = wgid % NXCD, off = wgid / NXCD; wgid = (xcd < r ? xcd * (q + 1) : r * (q + 1) + (xcd - r) * q) + off; }
        if (rev) wgid = nwg - 1 - wgid;
        const int nig = WGM * nN, gid = wgid / nig, fm = gid * WGM, gsz = (nM - fm) < WGM ? (nM - fm) : WGM;
        u.pm = fm + ((wgid % nig) % gsz); u.pn = (wgid % nig) / gsz; u.pb = u.pn; return true;
    }
    __device__ __forceinline__ void a_ready(const Unit&) const {}
    __device__ __forceinline__ void done(const Unit&) const {}
};

__device__ __forceinline__ unsigned cvt_pk_bf16(float lo, float hi) { unsigned r; asm volatile("v_cvt_pk_bf16_f32 %0, %1, %2" : "=v"(r) : "v"(lo), "v"(hi)); return r; }
typedef float f32x2 __attribute__((ext_vector_type(2)));


template <class Epi, class Sched, bool ALIGN_EPI = false, bool SP2 = false, int F8 = 0, bool TILED_A = false>
__device__ __forceinline__ void gemm_phase(PG8_LAS unsigned char* lds, const Gemm g, const Sched& S, const Epi& E) {
    int tid_ = threadIdx.x; asm volatile("" : "+v"(tid_));
    const int tid = tid_, wid = __builtin_amdgcn_readfirstlane(tid >> 6), lane = tid & 63, wr = wid >> 2, wc = wid & 3, fr = lane & 15, fq = lane >> 4;
    int K_ = g.K; asm volatile("" : "+s"(K_)); const int K = K_, nt = K / BK;
    unsigned voffA[2], voffB[2];
#pragma unroll
    for (int i = 0; i < 2; ++i) { int R, C; stage_rc(tid * 16 + i * 8192, R, C); const int Rb = Epi::PERM ? ((R & ~31) + perm32(R & 31)) : R;
        voffA[i] = TILED_A ? (unsigned)(R * 128 + C * 2) : (unsigned)(R * K + C) * 2u; voffB[i] = (unsigned)(Rb * K + C) * 2u; }
    const size_t kstep = (size_t)(BK * 2);
    const size_t hstep = (size_t)HALF * K * 2;
    const size_t tstep = 2 * hstep;
    const size_t kstepA = TILED_A ? (size_t)32768 : kstep, hstepA = TILED_A ? (size_t)16384 : hstep, tstepA = TILED_A ? (size_t)(K / BK) * 32768 : tstep;
    const unsigned ldsw = (unsigned)wid * 1024u;
    const int aoff = lds_byte(wr * 64 + fr, fq * 8), boff = lds_byte(wc * 32 + fr, fq * 8);
#define PG8_SA(b, h) (((b) * 2 + (h)) * HTB)
#define PG8_SB(b, h) ((4 + (b) * 2 + (h)) * HTB)
#define PG8_STAGE(bufoff, gbase, voff) do { _Pragma("unroll") for (int _i = 0; _i < 2; ++_i) \
        __builtin_amdgcn_global_load_lds((const unsigned*)((const char*)(gbase) + (voff)[_i]), (PG8_LAS unsigned*)(lds + (bufoff) + ldsw + _i * 8192), 16, 0, 0); } while (0)
#define PG8_LDA(dst, b, h) do { if constexpr (F8 == 0) { _Pragma("unroll") for (int m = 0; m < 4; ++m) _Pragma("unroll") for (int k = 0; k < 2; ++k) dst[m][k] = *(const PG8_LAS bf16x8*)(lds + PG8_SA(b, h) + aoff + m * 2048 + k * 1024); } \
        else { _Pragma("unroll") for (int m = 0; m < 4; ++m) dst##8[m] = __builtin_shufflevector(*(const PG8_LAS i32x4*)(lds + PG8_SA(b, h) + aoff + m * 2048), *(const PG8_LAS i32x4*)(lds + PG8_SA(b, h) + aoff + m * 2048 + 1024), 0, 1, 2, 3, 4, 5, 6, 7); } } while (0)
#define PG8_LDB(dst, b, h) do { if constexpr (F8 == 0) { _Pragma("unroll") for (int n = 0; n < 2; ++n) _Pragma("unroll") for (int k = 0; k < 2; ++k) dst[n][k] = *(const PG8_LAS bf16x8*)(lds + PG8_SB(b, h) + boff + n * 2048 + k * 1024); } \
        else { _Pragma("unroll") for (int n = 0; n < 2; ++n) dst##8[n] = __builtin_shufflevector(*(const PG8_LAS i32x4*)(lds + PG8_SB(b, h) + boff + n * 2048), *(const PG8_LAS i32x4*)(lds + PG8_SB(b, h) + boff + n * 2048 + 1024), 0, 1, 2, 3, 4, 5, 6, 7); } } while (0)
#define PG8_MMA(ai, bj, At, Bt) do { __builtin_amdgcn_s_setprio(1); \
        if constexpr (F8 == 0) { _Pragma("unroll") for (int m = 0; m < 4; ++m) _Pragma("unroll") for (int n = 0; n < 2; ++n) _Pragma("unroll") for (int k = 0; k < 2; ++k) \
            acc[ai][bj][m][n] = __builtin_amdgcn_mfma_f32_16x16x32_bf16(Bt[n][k], At[m][k], acc[ai][bj][m][n], 0, 0, 0); } \
        else {   \
            _Pragma("unroll") for (int m = 0; m < 4; ++m) _Pragma("unroll") for (int n = 0; n < 2; ++n) \
            asm volatile("v_mfma_f32_16x16x128_f8f6f4 %0, %1, %2, %0" : "+v"(acc[ai][bj][m][n]) : "v"(Bt##8[n]), "v"(At##8[m])); }   \
        __builtin_amdgcn_s_setprio(0); } while (0)
#define PG8_WAIT_V(n) asm volatile("s_waitcnt vmcnt(" #n ")" ::: "memory")
#define PG8_WAIT_L(n) asm volatile("s_waitcnt lgkmcnt(" #n ")" ::: "memory")
#define PG8_BAR __builtin_amdgcn_s_barrier()
#define PG8_SCHED __builtin_amdgcn_sched_barrier(0)
    Unit cur, nxt; int ui = 0;
    if (!S.next(0, cur)) return;
    f32x4 acc[2][2][4][2];
#pragma unroll
    for (int a = 0; a < 2; ++a)
#pragma unroll
        for (int b = 0; b < 2; ++b)
#pragma unroll
            for (int m = 0; m < 4; ++m)
#pragma unroll
                for (int n = 0; n < 2; ++n) acc[a][b][m][n] = (f32x4){0.f, 0.f, 0.f, 0.f};
    bf16x8 At[4][2], B0[2][2], B1[2][2]; i32x8 At8[4], B08[2], B18[2]; (void)At; (void)B0; (void)B1; (void)At8; (void)B08; (void)B18;
    const char* cA = (const char*)g.A + (size_t)cur.pm * tstepA; const char* cB = (const char*)g.Bt + (size_t)cur.pb * tstep;
    S.a_ready(cur);
    if constexpr (SP2) {
        PG8_STAGE(PG8_SB(0, 0), cB, voffB); PG8_STAGE(PG8_SB(0, 1), cB + hstep, voffB); PG8_STAGE(PG8_SA(0, 0), cA, voffA); PG8_STAGE(PG8_SA(0, 1), cA + hstepA, voffA);
        if (wr == 1) PG8_BAR;
        PG8_WAIT_V(2); PG8_BAR;
        PG8_STAGE(PG8_SB(1, 0), cB + kstep, voffB); PG8_STAGE(PG8_SA(1, 0), cA + kstepA, voffA); PG8_STAGE(PG8_SB(1, 1), cB + hstep + kstep, voffB);
        PG8_WAIT_V(6); PG8_BAR;
    } else {
        PG8_STAGE(PG8_SB(0, 0), cB, voffB); PG8_STAGE(PG8_SA(0, 0), cA, voffA); PG8_STAGE(PG8_SB(0, 1), cB + hstep, voffB); PG8_STAGE(PG8_SA(0, 1), cA + hstepA, voffA);
        if (wr == 1) PG8_BAR;
        PG8_WAIT_V(4); PG8_BAR;
        PG8_STAGE(PG8_SB(1, 0), cB + kstep, voffB); PG8_STAGE(PG8_SA(1, 0), cA + kstepA, voffA); PG8_STAGE(PG8_SB(1, 1), cB + hstep + kstep, voffB);
        PG8_WAIT_V(6); PG8_BAR;
    }
    for (;;) {
        const bool has_next = S.next(ui + 1, nxt);
        const char* nA = has_next ? (const char*)g.A + (size_t)nxt.pm * tstepA : cA; const char* nB = has_next ? (const char*)g.Bt + (size_t)nxt.pb * tstep : cB;
#if PB_MODE == 2
        const unsigned long long pbt = __builtin_amdgcn_s_memrealtime();
#endif
        for (int t = 0; t < nt; t += 2) {
            const bool last = (t == nt - 2);
            const char* a1 = cA + (size_t)(t + 1) * kstepA;
            const char* a2 = last ? nA : cA + (size_t)(t + 2) * kstepA; const char* b2 = last ? nB : cB + (size_t)(t + 2) * kstep;
            const char* a3 = a2 + kstepA; const char* b3 = b2 + kstep;
            if (last && has_next) S.a_ready(nxt);
            if constexpr (SP2) {
            PG8_LDB(B0, 0, 0); PG8_LDB(B1, 0, 1); PG8_SCHED; PG8_LDA(At, 0, 0); PG8_STAGE(PG8_SA(1, 1), a1 + hstepA, voffA);
            PG8_WAIT_V(8); PG8_WAIT_L(0); PG8_BAR; PG8_MMA(0, 0, At, B0); PG8_MMA(0, 1, At, B1); PG8_BAR; PG8_SCHED;
            PG8_LDA(At, 0, 1); PG8_STAGE(PG8_SB(0, 0), b2, voffB); PG8_STAGE(PG8_SB(0, 1), b2 + hstep, voffB); PG8_STAGE(PG8_SA(0, 0), a2, voffA);
            PG8_WAIT_V(8); PG8_WAIT_L(0); PG8_BAR; PG8_MMA(1, 0, At, B0); PG8_MMA(1, 1, At, B1); PG8_BAR; PG8_SCHED;
            PG8_LDB(B0, 1, 0); PG8_LDB(B1, 1, 1); PG8_SCHED; PG8_LDA(At, 1, 0); PG8_STAGE(PG8_SA(0, 1), a2 + hstepA, voffA);
            PG8_WAIT_V(8); PG8_WAIT_L(0); PG8_BAR; PG8_MMA(0, 0, At, B0); PG8_MMA(0, 1, At, B1); PG8_BAR; PG8_SCHED;
            PG8_LDA(At, 1, 1); PG8_STAGE(PG8_SB(1, 0), b3, voffB); PG8_STAGE(PG8_SB(1, 1), b3 + hstep, voffB); PG8_STAGE(PG8_SA(1, 0), a3, voffA);
            PG8_WAIT_V(8); PG8_WAIT_L(0); PG8_BAR; PG8_MMA(1, 0, At, B0); PG8_MMA(1, 1, At, B1); PG8_BAR; PG8_SCHED;
            } else {
            PG8_LDB(B0, 0, 0); PG8_SCHED; PG8_LDA(At, 0, 0); PG8_STAGE(PG8_SA(1, 1), a1 + hstepA, voffA);
            PG8_WAIT_L(8); PG8_BAR; PG8_WAIT_L(0); PG8_MMA(0, 0, At, B0); PG8_BAR; PG8_SCHED;
            PG8_LDB(B1, 0, 1); PG8_STAGE(PG8_SB(0, 0), b2, voffB);
            PG8_BAR; PG8_WAIT_L(0); PG8_MMA(0, 1, At, B1); PG8_BAR;
            PG8_LDA(At, 0, 1); PG8_STAGE(PG8_SA(0, 0), a2, voffA);
            PG8_BAR; PG8_WAIT_L(0); PG8_MMA(1, 0, At, B0); PG8_BAR; PG8_SCHED;
            PG8_STAGE(PG8_SB(0, 1), b2 + hstep, voffB);
            PG8_WAIT_V(6); PG8_BAR; PG8_MMA(1, 1, At, B1); PG8_BAR;
            PG8_LDB(B0, 1, 0); PG8_SCHED; PG8_LDA(At, 1, 0); PG8_STAGE(PG8_SA(0, 1), a2 + hstepA, voffA);
            PG8_WAIT_L(8); PG8_BAR; PG8_WAIT_L(0); PG8_MMA(0, 0, At, B0); PG8_BAR; PG8_SCHED;
            PG8_LDB(B1, 1, 1); PG8_STAGE(PG8_SB(1, 0), b3, voffB);
            PG8_BAR; PG8_WAIT_L(0); PG8_MMA(0, 1, At, B1); PG8_BAR;
            PG8_LDA(At, 1, 1); PG8_STAGE(PG8_SA(1, 0), a3, voffA);
            PG8_BAR; PG8_WAIT_L(0); PG8_MMA(1, 0, At, B0); PG8_BAR; PG8_SCHED;
            PG8_STAGE(PG8_SB(1, 1), b3 + hstep, voffB);
            PG8_WAIT_V(6); PG8_BAR; PG8_MMA(1, 1, At, B1); PG8_BAR;
            }
        }
#if PB_MODE == 2
        if (wid == 0 && lane == 0 && *(volatile PG8_LAS unsigned*)(lds + 135168) != 0u) atomicAdd((unsigned long long*)(lds + 135176), __builtin_amdgcn_s_memrealtime() - pbt);
#endif
        if constexpr (ALIGN_EPI) { if (wr == 0) PG8_BAR; }
#if PB_MODE == 1
        const unsigned long long pbt = __builtin_amdgcn_s_memrealtime();
#endif
        if constexpr (F8 != 0) asm volatile("s_nop 15\n\ts_nop 15" ::: "memory");
        if constexpr (!Epi::AFTER_DRAIN) { E(acc, cur, wr, wc, fr, fq); S.done(cur); }
#if PB_MODE == 1
        if (wid == 0 && lane == 0 && *(volatile PG8_LAS unsigned*)(lds + 135168) != 0u) atomicAdd((unsigned long long*)(lds + 135176), __builtin_amdgcn_s_memrealtime() - pbt);
#endif
        if (!has_next) break;
#pragma unroll
        for (int a = 0; a < 2; ++a)
#pragma unroll
            for (int b = 0; b < 2; ++b)
#pragma unroll
                for (int m = 0; m < 4; ++m)
#pragma unroll
                    for (int n = 0; n < 2; ++n) acc[a][b][m][n] = (f32x4){0.f, 0.f, 0.f, 0.f};
        cur = nxt; cA = nA; cB = nB; ++ui;
        if constexpr (ALIGN_EPI) { if (wr == 1) PG8_BAR; }
    }
    PG8_WAIT_V(0);
    if constexpr (!ALIGN_EPI) { if (wr == 0) PG8_BAR; }
    PG8_BAR;
    if constexpr (Epi::AFTER_DRAIN) { E.fused(acc, cur, wr, wc, fr, fq, lds, wid, lane); S.done(cur); }
#undef PG8_SA
#undef PG8_SB
#undef PG8_STAGE
#undef PG8_LDA
#undef PG8_LDB
#undef PG8_MMA
#undef PG8_WAIT_V
#undef PG8_WAIT_L
#undef PG8_BAR
#undef PG8_SCHED
}
}

namespace pg8 {
constexpr int TT = 32768;
constexpr float kLog2e = 1.4426950408889634f;
__device__ __forceinline__ float sigm(float v) { return __builtin_amdgcn_rcpf(1.0f + __builtin_amdgcn_exp2f(-v * kLog2e)); }
__device__ __forceinline__ f32x4 sigm4(f32x4 v) { f32x4 r; r.x = sigm(v.x); r.y = sigm(v.y); r.z = sigm(v.z); r.w = sigm(v.w); return r; }
__device__ __forceinline__ f32x4 ksig4(f32x4 t, float ik) { f32x4 e, r;
    e.x = __builtin_amdgcn_exp2f(t.x); e.y = __builtin_amdgcn_exp2f(t.y); e.z = __builtin_amdgcn_exp2f(t.z); e.w = __builtin_amdgcn_exp2f(t.w);
    const f32x4 d = e * ik + ik;
    r.x = __builtin_amdgcn_rcpf(d.x); r.y = __builtin_amdgcn_rcpf(d.y); r.z = __builtin_amdgcn_rcpf(d.z); r.w = __builtin_amdgcn_rcpf(d.w); return r; }
__device__ __forceinline__ u32x4 pack8(f32x4 a, f32x4 b) { u32x4 w; w.x = cvt_pk_bf16(a.x, a.y); w.y = cvt_pk_bf16(a.z, a.w); w.z = cvt_pk_bf16(b.x, b.y); w.w = cvt_pk_bf16(b.z, b.w); return w; }
__device__ __forceinline__ f32x4 bf_lo4(unsigned a, unsigned b) { f32x4 r; r.x = __uint_as_float(a << 16); r.y = __uint_as_float(a & 0xffff0000u); r.z = __uint_as_float(b << 16); r.w = __uint_as_float(b & 0xffff0000u); return r; }
__device__ __forceinline__ float row_rs(const float* part, int row) {
    const f32x4* p = (const f32x4*)(part + (size_t)row * 16);
    const f32x4 a = p[0], b = p[1], c = p[2], d = p[3];
    const float s = (((a.x + a.y) + (a.z + a.w)) + ((b.x + b.y) + (b.z + b.w))) + (((c.x + c.y) + (c.z + c.w)) + ((d.x + d.y) + (d.z + d.w)));
    return __builtin_amdgcn_rsqf(s * (1.0f / 1024.0f) + 1e-6f);
}
__device__ __forceinline__ float row_rs4(const float* part, int row, int fq) {
    const f32x4 a = *(const f32x4*)(part + (size_t)row * 16 + fq * 4);
    float s = (a.x + a.y) + (a.z + a.w); s += __shfl_xor(s, 16); s += __shfl_xor(s, 32);
    return __builtin_amdgcn_rsqf(s * (1.0f / 1024.0f) + 1e-6f);
}
__device__ __forceinline__ void rows_rs8(const float* part, int row0, int fq, float (&rs)[2][4]) {
    f32x4 a[2][4];
#pragma unroll
    for (int ai = 0; ai < 2; ++ai)
#pragma unroll
        for (int m = 0; m < 4; ++m) a[ai][m] = *(const f32x4*)(part + (size_t)(row0 + ai * HALF + m * 16) * 16 + fq * 4);
#pragma unroll
    for (int ai = 0; ai < 2; ++ai)
#pragma unroll
        for (int m = 0; m < 4; ++m) { float s = (a[ai][m].x + a[ai][m].y) + (a[ai][m].z + a[ai][m].w); s += __shfl_xor(s, 16); s += __shfl_xor(s, 32); rs[ai][m] = __builtin_amdgcn_rsqf(s * (1.0f / 1024.0f) + 1e-6f); }
    asm volatile("" ::: "memory");
}
__device__ __forceinline__ float log2g(int h) {
    const float x = __builtin_amdgcn_exp2f((float)(-5 - h));
    const float ln = -x * (1.0f + x * (0.5f + x * (0.33333334f + x * (0.25f + x * (0.2f + x * 0.16666667f)))));
    return ln * kLog2e;
}

struct EpiIn {
    static constexpr bool PERM = true, AFTER_DRAIN = false;
    const float* part; const float* ctab; const float* stab;
    bf16_t *Z, *Q, *SG;
    static constexpr size_t QK_STRIDE = 16777216, G_STRIDE = 33554432;
    float wsc;
    int pnoff;
    __device__ __forceinline__ void operator()(const f32x4 (&acc)[2][2][4][2], const Unit& u, int wr, int wc, int fr, int fq) const {
        asm volatile("" : "+v"(fr));
        const int row0 = u.pm * BM + wr * 64 + fr, pn = u.pn + pnoff;
        float rsa[2][4]; rows_rs8(part, row0, fq, rsa);
        if (wsc != 1.0f) {
#pragma unroll
            for (int ai = 0; ai < 2; ++ai)
#pragma unroll
                for (int m = 0; m < 4; ++m) rsa[ai][m] *= wsc; }
        if (pn < 4) {
#pragma unroll
            for (int ai = 0; ai < 2; ++ai)
#pragma unroll
                for (int m = 0; m < 4; ++m) { const int row = row0 + ai * HALF + m * 16; const float rs = rsa[ai][m];
                    const float nrl = -rs * kLog2e, irs = __builtin_amdgcn_rcpf(rs);
                    *(u32x4*)(Z + (size_t)row * 512 + pn * 128 + wc * 32 + fq * 8) = pack8(acc[ai][0][m][0] * ksig4(acc[ai][1][m][0] * nrl, irs), acc[ai][0][m][1] * ksig4(acc[ai][1][m][1] * nrl, irs)); }
        } else if (pn < 8) {
            const bool isk = pn >= 6; const int head = 4 * ((pn - 4) & 1) + wc; const float scale = isk ? 1.0f : 0.125f; bf16_t* dst = Q + (isk ? QK_STRIDE : (size_t)0);
#pragma unroll
            for (int ap = 0; ap < 4; ++ap) {
                const int ai = ap >> 1, mb = (ap & 1) * 2; f32x4 cc[2][2], ss[2][2];
#pragma unroll
                for (int q = 0; q < 2; ++q) { const int pos = (row0 + ai * HALF + (mb + q) * 16) & 8191;
                    cc[q][0] = *(const f32x4*)(ctab + pos * 32 + fq * 8); cc[q][1] = *(const f32x4*)(ctab + pos * 32 + fq * 8 + 4);
                    ss[q][0] = *(const f32x4*)(stab + pos * 32 + fq * 8); ss[q][1] = *(const f32x4*)(stab + pos * 32 + fq * 8 + 4); }
#pragma unroll
                for (int q = 0; q < 2; ++q) { const int m = mb + q; const int row = row0 + ai * HALF + m * 16; const float rs = rsa[ai][m] * scale;
                    const f32x4 t10 = acc[ai][0][m][0] * rs, t11 = acc[ai][0][m][1] * rs, t20 = acc[ai][1][m][0] * rs, t21 = acc[ai][1][m][1] * rs;
                    bf16_t* p = dst + (size_t)row * 512 + head * 64 + fq * 8;
                    *(u32x4*)(p) = pack8(t10 * cc[q][0] - t20 * ss[q][0], t11 * cc[q][1] - t21 * ss[q][1]);
                    *(u32x4*)(p + 32) = pack8(t10 * ss[q][0] + t20 * cc[q][0], t11 * ss[q][1] + t21 * cc[q][1]); }
                asm volatile("" ::: "memory"); }
        } else {
            const int sel = (pn - 8) >> 2, colb = ((pn - 8) & 3) * 256 + wc * 32 + fq * 8; bf16_t* dst = SG + (size_t)sel * G_STRIDE;
#pragma unroll
            for (int ai = 0; ai < 2; ++ai)
#pragma unroll
                for (int m = 0; m < 4; ++m) { const int row = row0 + ai * HALF + m * 16; const float rs = rsa[ai][m];
#pragma unroll
                    for (int bj = 0; bj < 2; ++bj)
                        *(u32x4*)(dst + (size_t)row * 1024 + colb + bj * HALF) = pack8(acc[ai][bj][m][0] * rs, acc[ai][bj][m][1] * rs); }
        }
    }
};
struct EpiKvT {
    static constexpr bool PERM = true, AFTER_DRAIN = false;
    const float* part; const float* ctT; const float* stT;
    bf16_t *KZT, *VT;
    float wsc;
    __device__ __forceinline__ void operator()(const f32x4 (&acc)[2][2][4][2], const Unit& u, int wr, int wc, int fr, int fq) const {
        asm volatile("" : "+v"(fr));
        const int col0 = u.pn * BM + wc * 32 + fq * 8;
        f32x4 rsv[2][2];
        { const int lane = fq * 16 + fr; const float mine = row_rs(part, u.pn * BM + (lane >> 5) * HALF + wc * 32 + (lane & 31)) * wsc;
          asm volatile("" ::: "memory");
#pragma unroll
          for (int bj = 0; bj < 2; ++bj)
#pragma unroll
            for (int n = 0; n < 2; ++n) { const int sl = bj * 32 + fq * 8 + n * 4; rsv[bj][n].x = __shfl(mine, sl); rsv[bj][n].y = __shfl(mine, sl + 1); rsv[bj][n].z = __shfl(mine, sl + 2); rsv[bj][n].w = __shfl(mine, sl + 3); } }
        if (u.pm < 2) {
            const int pos0 = col0 & 8191;
#pragma unroll
            for (int m = 0; m < 4; ++m) { const int head = 4 * u.pm + 2 * wr + (m >> 1), d = 16 * (m & 1) + fr; const float lg = log2g(head);
                f32x4 c4[2][2], s4[2][2];
#pragma unroll
                for (int bj = 0; bj < 2; ++bj)
#pragma unroll
                    for (int n = 0; n < 2; ++n) { const int pos = pos0 + bj * HALF + n * 4; c4[bj][n] = *(const f32x4*)(ctT + d * 8192 + pos); s4[bj][n] = *(const f32x4*)(stT + d * 8192 + pos); }
#pragma unroll
                for (int bj = 0; bj < 2; ++bj) { f32x4 o1[2], o2[2];
#pragma unroll
                    for (int n = 0; n < 2; ++n) { const int pos = pos0 + bj * HALF + n * 4;
                        const float jf = (float)(127 - (pos & 127)); f32x4 z;
                        z.x = __builtin_amdgcn_exp2f(jf * lg); z.y = __builtin_amdgcn_exp2f((jf - 1.0f) * lg); z.z = __builtin_amdgcn_exp2f((jf - 2.0f) * lg); z.w = __builtin_amdgcn_exp2f((jf - 3.0f) * lg);
                        const f32x4 t1 = acc[0][bj][m][n] * rsv[bj][n], t2 = acc[1][bj][m][n] * rsv[bj][n];
                        o1[n] = (t1 * c4[bj][n] - t2 * s4[bj][n]) * z; o2[n] = (t1 * s4[bj][n] + t2 * c4[bj][n]) * z; }
                    *(u32x4*)(KZT + (size_t)(head * 64 + d) * TT + col0 + bj * HALF) = pack8(o1[0], o1[1]);
                    *(u32x4*)(KZT + (size_t)(head * 64 + 32 + d) * TT + col0 + bj * HALF) = pack8(o2[0], o2[1]); }
                asm volatile("" ::: "memory"); }
        } else {
#pragma unroll
            for (int ai = 0; ai < 2; ++ai)
#pragma unroll
                for (int m = 0; m < 4; ++m) { const int r = (u.pm - 2) * BM + ai * HALF + wr * 64 + m * 16 + fr;
#pragma unroll
                    for (int bj = 0; bj < 2; ++bj) *(u32x4*)(VT + (size_t)r * TT + col0 + bj * HALF) = pack8(acc[ai][bj][m][0] * rsv[bj][0], acc[ai][bj][m][1] * rsv[bj][1]); }
        }
    }
};
struct EpiStore {
    static constexpr bool PERM = true, AFTER_DRAIN = false;
    bf16_t* O; int ld; float sc;
    __device__ __forceinline__ void operator()(const f32x4 (&acc)[2][2][4][2], const Unit& u, int wr, int wc, int fr, int fq) const {
        asm volatile("" : "+v"(fr));
        const int row0 = u.pm * BM + wr * 64 + fr, col0 = u.pn * BM + wc * 32 + fq * 8;
#pragma unroll
        for (int ai = 0; ai < 2; ++ai)
#pragma unroll
            for (int m = 0; m < 4; ++m) { bf16_t* rowp = O + (size_t)(row0 + ai * HALF + m * 16) * ld + col0;
#pragma unroll
                for (int bj = 0; bj < 2; ++bj) *(u32x4*)(rowp + bj * HALF) = pack8(acc[ai][bj][m][0] * sc, acc[ai][bj][m][1] * sc); }
    }
};
template <bool ADD> struct EpiGate {
    static constexpr bool PERM = true, AFTER_DRAIN = false;
    const bf16_t* G; bf16_t* O; float sc;
    __device__ __forceinline__ void operator()(const f32x4 (&acc)[2][2][4][2], const Unit& u, int wr, int wc, int fr, int fq) const {
        asm volatile("" : "+v"(fr));
        const int row0 = u.pm * BM + wr * 64 + fr, col0 = u.pn * BM + wc * 32 + fq * 8;
        const float isc = __builtin_amdgcn_rcpf(sc);
#pragma unroll
        for (int ai = 0; ai < 2; ++ai) {
            u32x4 gg[4][2], oo[4][2];
#pragma unroll
            for (int m = 0; m < 4; ++m) { const size_t off = (size_t)(row0 + ai * HALF + m * 16) * 1024 + col0;
#pragma unroll
                for (int bj = 0; bj < 2; ++bj) { gg[m][bj] = *(const u32x4*)(G + off + bj * HALF); if (ADD) oo[m][bj] = *(const u32x4*)(O + off + bj * HALF); } }
#pragma unroll
            for (int m = 0; m < 4; ++m) { const size_t off = (size_t)(row0 + ai * HALF + m * 16) * 1024 + col0;
#pragma unroll
                for (int bj = 0; bj < 2; ++bj) { const u32x4 g = gg[m][bj];
                    f32x4 o0 = acc[ai][bj][m][0] * ksig4(bf_lo4(g.x, g.y) * -kLog2e, isc), o1 = acc[ai][bj][m][1] * ksig4(bf_lo4(g.z, g.w) * -kLog2e, isc);
                    if (ADD) { const u32x4 p = oo[m][bj]; o0 = o0 + bf_lo4(p.x, p.y); o1 = o1 + bf_lo4(p.z, p.w); }
                    *(u32x4*)(O + off + bj * HALF) = pack8(o0, o1); } }
            asm volatile("" ::: "memory"); }
    }
};
template <bool PLE, bool W8 = false, bool A8 = false> struct EpiRes {
    static constexpr bool PERM = true, AFTER_DRAIN = false;
    const bf16_t* XI; bf16_t* XO; float* part_out; const float* part_in; const bf16_t* PP; unsigned char* X8; float sc;
    __device__ __forceinline__ void operator()(const f32x4 (&acc)[2][2][4][2], const Unit& u, int wr, int wc, int fr, int fq) const {
        asm volatile("" : "+v"(fr));
        const int row0 = u.pm * BM + wr * 64 + fr, col0 = u.pn * BM + wc * 32 + fq * 8;
        const float isc = PLE ? __builtin_amdgcn_rcpf(sc) : 1.0f; (void)isc;
#pragma unroll
        for (int ai = 0; ai < 2; ++ai) {
            u32x4 xi[4][2], pp[4][2]; float rs[4];
#pragma unroll
            for (int m = 0; m < 4; ++m) { const size_t off = (size_t)(row0 + ai * HALF + m * 16) * 1024 + col0;
#pragma unroll
                for (int bj = 0; bj < 2; ++bj) { xi[m][bj] = *(const u32x4*)(XI + off + bj * HALF); if (PLE) pp[m][bj] = *(const u32x4*)(PP + off + bj * HALF); }
                rs[m] = 1.0f; if (PLE) rs[m] = row_rs4(part_in, row0 + ai * HALF + m * 16, fq); }
#pragma unroll
            for (int m = 0; m < 4; ++m) { const int row = row0 + ai * HALF + m * 16; const size_t off = (size_t)row * 1024 + col0; float ss = 0.f;
#pragma unroll
                for (int bj = 0; bj < 2; ++bj) { f32x4 x0 = bf_lo4(xi[m][bj].x, xi[m][bj].y), x1 = bf_lo4(xi[m][bj].z, xi[m][bj].w);
                    if (PLE) { const float nrl = -rs[m] * (A8 ? kLog2e / 64.0f : kLog2e); x0 = x0 + ksig4(acc[ai][bj][m][0] * nrl, isc) * bf_lo4(pp[m][bj].x, pp[m][bj].y); x1 = x1 + ksig4(acc[ai][bj][m][1] * nrl, isc) * bf_lo4(pp[m][bj].z, pp[m][bj].w); }
                    else { x0 = x0 + acc[ai][bj][m][0] * sc; x1 = x1 + acc[ai][bj][m][1] * sc; }
                    *(u32x4*)(XO + off + bj * HALF) = pack8(x0, x1);
                    if constexpr (W8) { f32x2 w; w.x = __uint_as_float((unsigned)__builtin_amdgcn_cvt_pk_fp8_f32(x0.z, x0.w, __builtin_amdgcn_cvt_pk_fp8_f32(x0.x, x0.y, 0, false), true));
                        w.y = __uint_as_float((unsigned)__builtin_amdgcn_cvt_pk_fp8_f32(x1.z, x1.w, __builtin_amdgcn_cvt_pk_fp8_f32(x1.x, x1.y, 0, false), true)); *(f32x2*)(X8 + off + bj * HALF) = w; }
                    ss += ((x0.x * x0.x + x0.y * x0.y) + (x0.z * x0.z + x0.w * x0.w)) + ((x1.x * x1.x + x1.y * x1.y) + (x1.z * x1.z + x1.w * x1.w)); }
                ss += __shfl_xor(ss, 16); ss += __shfl_xor(ss, 32);
                if (fq == 0) part_out[(size_t)row * 16 + u.pn * 4 + wc] = ss; }
            asm volatile("" ::: "memory"); }
    }
};
template <bool SLOT, bool F8 = SLOT> struct EpiSwi {
    static constexpr bool PERM = true, AFTER_DRAIN = false;
    const float* part; const float* rsx; bf16_t* O; int ld;
    __device__ __forceinline__ void operator()(const f32x4 (&acc)[2][2][4][2], const Unit& u, int wr, int wc, int fr, int fq) const {
        asm volatile("" : "+v"(fr));
        const int row0 = u.pm * BM + wr * 64 + fr;
        float rsa[2][4];
        if constexpr (SLOT) {
#pragma unroll
            for (int ai = 0; ai < 2; ++ai)
#pragma unroll
                for (int m = 0; m < 4; ++m) rsa[ai][m] = rsx[row0 + ai * HALF + m * 16];
#pragma unroll
            for (int ai = 0; ai < 2; ++ai)
#pragma unroll
                for (int m = 0; m < 4; ++m) rsa[ai][m] *= (1.0f / 64.0f);
        } else { rows_rs8(part, row0, fq, rsa);
            if constexpr (F8) {
#pragma unroll
                for (int ai = 0; ai < 2; ++ai)
#pragma unroll
                    for (int m = 0; m < 4; ++m) rsa[ai][m] *= (1.0f / 64.0f); } }
#pragma unroll
        for (int ai = 0; ai < 2; ++ai)
#pragma unroll
            for (int m = 0; m < 4; ++m) { const int row = row0 + ai * HALF + m * 16; const float rs = rsa[ai][m];
                const float nrl = -rs * kLog2e, ic = __builtin_amdgcn_rcpf(rs * rs * (F8 ? 4.0f : 1.0f));
                const f32x4 ag0 = acc[ai][0][m][0], ag1 = acc[ai][0][m][1];
                const f32x4 t0 = ag0 * nrl, t1 = ag1 * nrl; f32x4 e0, e1;
                e0.x = __builtin_amdgcn_exp2f(t0.x); e0.y = __builtin_amdgcn_exp2f(t0.y); e0.z = __builtin_amdgcn_exp2f(t0.z); e0.w = __builtin_amdgcn_exp2f(t0.w);
                e1.x = __builtin_amdgcn_exp2f(t1.x); e1.y = __builtin_amdgcn_exp2f(t1.y); e1.z = __builtin_amdgcn_exp2f(t1.z); e1.w = __builtin_amdgcn_exp2f(t1.w);
                const f32x4 d0 = e0 * ic + ic, d1 = e1 * ic + ic; f32x4 r0, r1;
                r0.x = __builtin_amdgcn_rcpf(d0.x); r0.y = __builtin_amdgcn_rcpf(d0.y); r0.z = __builtin_amdgcn_rcpf(d0.z); r0.w = __builtin_amdgcn_rcpf(d0.w);
                r1.x = __builtin_amdgcn_rcpf(d1.x); r1.y = __builtin_amdgcn_rcpf(d1.y); r1.z = __builtin_amdgcn_rcpf(d1.z); r1.w = __builtin_amdgcn_rcpf(d1.w);
                const f32x4 q0 = (ag0 * acc[ai][1][m][0]) * r0, q1 = (ag1 * acc[ai][1][m][1]) * r1;
                if constexpr (F8) { const f32x4 h0 = q0, h1 = q1; f32x2 w;
                    w.x = __uint_as_float((unsigned)__builtin_amdgcn_cvt_pk_fp8_f32(h0.z, h0.w, __builtin_amdgcn_cvt_pk_fp8_f32(h0.x, h0.y, 0, false), true));
                    w.y = __uint_as_float((unsigned)__builtin_amdgcn_cvt_pk_fp8_f32(h1.z, h1.w, __builtin_amdgcn_cvt_pk_fp8_f32(h1.x, h1.y, 0, false), true));
                    *(f32x2*)((unsigned char*)O + (size_t)row * ld + u.pn * 128 + wc * 32 + fq * 8) = w; }
                else *(u32x4*)(O + (size_t)row * ld + u.pn * 128 + wc * 32 + fq * 8) = pack8(q0, q1); }
    }
};
struct MoeOrder : StaticOrder {
    const int* blk_e; int ntile;
    __device__ bool next(int i, Unit& u) const { if (!StaticOrder::next(i, u)) return false; u.pb = blk_e[u.pm] * ntile + u.pn; return true; }
};
}

#define GAS __attribute__((address_space(1)))
#define LAS __attribute__((address_space(3)))
typedef unsigned short bf16;
typedef unsigned v4u __attribute__((ext_vector_type(4)));
typedef float f32x4 __attribute__((ext_vector_type(4)));
typedef short bf16x8 __attribute__((ext_vector_type(8)));
typedef GAS unsigned gu32;
typedef GAS unsigned long long gu64;
#define RLX_AGENT __ATOMIC_RELAXED, __HIP_MEMORY_SCOPE_AGENT
#define LDS_WAIT() asm volatile("s_waitcnt lgkmcnt(0)" ::: "memory")
#define VM_WAIT() asm volatile("s_waitcnt vmcnt(0)" ::: "memory")
__device__ __forceinline__ unsigned long long rt() { return __builtin_amdgcn_s_memrealtime(); }
__device__ __forceinline__ unsigned f2bf(float f) { unsigned u = __builtin_bit_cast(unsigned, f); return (u + 0x7fffu + ((u >> 16) & 1u)) >> 16; }
__device__ __forceinline__ unsigned pk2(float lo, float hi) { return f2bf(lo) | (f2bf(hi) << 16); }

#define XB_TMO      128
#define XB_XCNT(j)  (256  + 64 * (j))
#define XB_XSUB(j)  (1280 + 64 * (j))
#define XB_XGEN(j)  (2304 + 64 * (j))
#define XB_TOP      3328
#define XB_TOPGEN   3392
#define XCD_BAR_WORDS 3456
#define XB_SPIN_CAP (1u << 18)

__device__ __forceinline__ unsigned xb_ld(unsigned* p)              { return __hip_atomic_load(p, __ATOMIC_RELAXED, __HIP_MEMORY_SCOPE_AGENT); }
__device__ __forceinline__ unsigned xb_add(unsigned* p, unsigned v) { return __hip_atomic_fetch_add(p, v, __ATOMIC_RELAXED, __HIP_MEMORY_SCOPE_AGENT); }
__device__ __forceinline__ unsigned xb_xcc_id() { return (unsigned)__builtin_amdgcn_s_getreg((3 << 11) | 20) & 0xFu; }
#define XB_SPIN(cond, bar) do { unsigned _sp = 0; while (cond) { __builtin_amdgcn_s_sleep(1); \
    if ((++_sp & 255u) == 0u) { if (xb_ld(&(bar)[XB_TMO])) break; if (_sp > XB_SPIN_CAP) { atomicAdd(&(bar)[XB_TMO], 1u); break; } } } } while (0)

struct XcdBarrier {
    unsigned* bar; unsigned x;
    volatile LAS unsigned* st;
};

__device__ __forceinline__ XcdBarrier xcd_barrier_post(unsigned* bar, volatile LAS unsigned* st) {
    XcdBarrier b; b.bar = bar; b.x = xb_xcc_id(); b.st = st;
    if (threadIdx.x == 0) (void)xb_add(&bar[XB_XCNT(b.x)], 1u);
    return b;
}
__device__ __forceinline__ void xcd_barrier_complete(unsigned* bar, unsigned x, unsigned& nloc, unsigned& nx) {
    const unsigned G = gridDim.x * gridDim.y * gridDim.z;
    unsigned sum, cnt, mine, sp = 0u;
    for (;;) {
        sum = 0u; cnt = 0u; mine = 0u;
#pragma unroll 1
        for (unsigned j = 0; j < 16; ++j) { const unsigned c = xb_ld(&bar[XB_XCNT(j)]); sum += c; cnt += (c > 0u) ? 1u : 0u; mine = (j == x) ? c : mine; }
        if (sum == G) break;
        __builtin_amdgcn_s_sleep(1);
        if ((++sp & 255u) == 0u) { if (xb_ld(&bar[XB_TMO])) break; if (sp > XB_SPIN_CAP) { atomicAdd(&bar[XB_TMO], 1u); break; } }
    }
    nloc = mine > 0u ? mine : 1u; nx = cnt > 0u ? cnt : 1u;
}

__device__ __forceinline__ void xcd_barrier(const XcdBarrier& b) {
    asm volatile("s_waitcnt vmcnt(0)" ::: "memory");
    __syncthreads();
    if (threadIdx.x == 0) {
        unsigned* bar = b.bar;
        __builtin_amdgcn_s_waitcnt(0);
        unsigned nloc = b.st[0], nx = b.st[1];
        if (nloc == 0u) { xcd_barrier_complete(bar, b.x, nloc, nx); b.st[0] = nloc; b.st[1] = nx; }
        const unsigned old = xb_add(&bar[XB_XSUB(b.x)], 1u);
        const unsigned gen = old / nloc;
        if (old + 1u == (gen + 1u) * nloc) {
            __builtin_amdgcn_fence(__ATOMIC_RELEASE, "agent");
            asm volatile("s_waitcnt vmcnt(0)" ::: "memory");
            const unsigned og = xb_add(&bar[XB_TOP], 1u);
            const unsigned tg = og / nx;
            if (og + 1u == (tg + 1u) * nx) xb_add(&bar[XB_TOPGEN], 1u);
            else XB_SPIN(xb_ld(&bar[XB_TOPGEN]) == tg, bar);
            __builtin_amdgcn_fence(__ATOMIC_ACQUIRE, "agent");
            xb_add(&bar[XB_XGEN(b.x)], 1u);
            asm volatile("s_waitcnt vmcnt(0)" ::: "memory");
        } else {
            XB_SPIN(xb_ld(&bar[XB_XGEN(b.x)]) == gen, bar);
            __builtin_amdgcn_fence(__ATOMIC_ACQUIRE, "agent");
            asm volatile("s_waitcnt vmcnt(0)" ::: "memory");
        }
    }
    __syncthreads();
}


constexpr int NWAVES = 8;
constexpr int T = 32768, D = 1024, SEQ = 8192, DEPTH = 4, PLE_DIM = 256, CONV_DIM = 512, CONV_W = 31, RH = 8, RDK = 64, RDV = 128, RC = 128;
constexpr int DFF = 2816, NEXP = 8, EFF = 3584, IN_COLS = 6144;
constexpr int NCH = SEQ / RC;
constexpr int NUNIT = (T / RC) * RH;
constexpr int MOE_ROWS = 67584;
constexpr float EPS = 1e-6f;

constexpr size_t MiB = 1u << 20;
constexpr size_t WS_CTL = 0, CTL_ZERO_BYTES = 1 * MiB;
constexpr size_t WS_COS = 1 * MiB, WS_SIN = 2 * MiB, WS_COST = 3 * MiB, WS_SINT = 4 * MiB;
constexpr size_t WS_PART = 5 * MiB, WS_PARTN = 9 * MiB;
constexpr size_t WS_MOE = 7 * MiB;
constexpr size_t MO_TOKE = 0, MO_TOKG = 256 * 1024, MO_TOKRS = 512 * 1024, MO_SLOT = 640 * 1024, MO_RSX = 896 * 1024, MO_CNT = 1280 * 1024, MO_BLK = 1296 * 1024;
constexpr size_t WS_WIN = 16 * MiB, WS_WKVT = 56 * MiB, WS_WCO = 68 * MiB, WS_WRO = 72 * MiB, WS_WO = 80 * MiB, WS_WDGU = 88 * MiB, WS_WDD = 110 * MiB, WS_WPG = 121 * MiB, WS_WPP = 129 * MiB;
constexpr size_t WS_WEGU = 131 * MiB, WS_WED = 187 * MiB;
constexpr size_t WS_XB = 215 * MiB, WS_PB = 279 * MiB, WS_XBN = 343 * MiB, WS_ACT = 407 * MiB;
constexpr size_t WS_Z = WS_ACT, WS_Q = WS_ACT + 32 * MiB, WS_K = WS_ACT + 64 * MiB, WS_KZT = WS_ACT + 96 * MiB, WS_VT = WS_ACT + 128 * MiB, WS_SG = WS_ACT + 192 * MiB, WS_SGA = WS_ACT + 256 * MiB,
                 WS_SGB = WS_ACT + 320 * MiB, WS_C = WS_ACT + 384 * MiB, WS_KVT = WS_ACT + 416 * MiB, WS_ST = WS_ACT + 480 * MiB, WS_MG = WS_ACT + 512 * MiB;
constexpr size_t WS_FA = WS_ACT, WS_XB8 = WS_ACT + 96 * MiB;
constexpr size_t WS_XG = WS_ACT, WS_EA = WS_ACT + 132 * MiB;
constexpr size_t WS_XBN8 = WS_MG;
constexpr size_t WS_PP = WS_ACT;
constexpr size_t WS_X8F = WS_C;
constexpr size_t WS_WIN8G0 = WS_WIN + 25 * MiB, WS_WIN8G_STEP = 10 * MiB;
static_assert(!A0G8 || INPROJ8_LAYER == 2, "A0G8 layout: layers 0 and 1 split, gate rows kept in the upper halves of the slots of layers 2 and 3");
constexpr size_t WS_END = WS_MG + 64 * MiB;
static_assert(WS_EA + 231 * MiB <= WS_END && WS_FA + 176 * MiB <= WS_END && WS_FA + 88 * MiB <= WS_XB8 && WS_XB8 + 32 * MiB <= WS_MG && WS_END == 983 * MiB, "ws map");
constexpr int CW_TMO = 0, CW_BAR = 4096;

constexpr int RING_OFF = 0, RING_BYTES = 131072;
constexpr int LDSCTL_OFF = RING_BYTES, MISC_OFF = LDSCTL_OFF + 320, PTAB_OFF = LDSCTL_OFF + 512, JOB_OFF = LDSCTL_OFF + 1024;
constexpr int LDS_BYTES = 147456;

__device__ __forceinline__ float wave_sum(float v) {
#pragma unroll
    for (int o = 1; o < 64; o <<= 1) v += __shfl_xor(v, o);
    return v;
}
using pg8::sigm; using pg8::log2g; using pg8::kLog2e;

__device__ __forceinline__ void job_map(int map, int b, int& col, bool& second) {
    const int t = b >> 3, jb = b & 7; second = false;
    if (map == 0) { col = 32 * b; }
    else if (map == 1) {
        if (t < 4) col = (jb < 4 ? 0 : 512) + 128 * t + 32 * (jb & 3);
        else if (t < 8) { const int base = 1024 + 512 * ((t - 4) >> 1), head = 4 * ((t - 4) & 1) + (jb & 3); col = base + head * 64 + (jb < 4 ? 0 : 32); }
        else col = 3072 + 256 * (t - 8) + 32 * jb;
    } else if (map == 2) {
        if (t < 2) { const int head = 4 * t + (jb & 3); col = 1536 + head * 64 + (jb < 4 ? 0 : 32); }
        else col = 2048 + 256 * (t - 2) + 32 * jb;
    } else { second = jb >= 4; col = 128 * t + 32 * (jb & 3); }
}
template <bool F8 = false> __device__ __forceinline__ void conv_item(const float* src, const float* src2, const float* gain, bf16* WT, int ldw, int K, int NB64, int map, int r, LAS float* scr, int lane) {
    const int kb = r / NB64, b64 = r % NB64, k0 = 64 * kb, rr = lane >> 4, c4 = lane & 15;
    int col; bool second; job_map(map, 2 * b64 + (c4 >> 3), col, second);
    const float* W = (second ? src2 : src) + col + 4 * (c4 & 7);
    f32x4 v[16];
#pragma unroll
    for (int i = 0; i < 16; ++i) v[i] = *(const GAS f32x4*)(W + (size_t)(k0 + 4 * i + rr) * ldw);
#pragma unroll
    for (int i = 0; i < 16; ++i) { float gsc = F8 ? 64.0f : 1.0f; if (gain) gsc *= gain[k0 + 4 * i + rr]; *(LAS f32x4*)(scr + (4 * i + rr) * 64 + 4 * c4) = v[i] * gsc; }
    LDS_WAIT(); asm volatile("" ::: "memory");
#pragma unroll
    for (int kc = 0; kc < 8; ++kc) { float t[8];
#pragma unroll
        for (int q = 0; q < 8; ++q) t[q] = scr[(8 * kc + q) * 64 + lane];
        if constexpr (F8) { typedef unsigned u2v __attribute__((ext_vector_type(2))); u2v o;
            o.x = (unsigned)__builtin_amdgcn_cvt_pk_fp8_f32(t[2], t[3], __builtin_amdgcn_cvt_pk_fp8_f32(t[0], t[1], 0, false), true);
            o.y = (unsigned)__builtin_amdgcn_cvt_pk_fp8_f32(t[6], t[7], __builtin_amdgcn_cvt_pk_fp8_f32(t[4], t[5], 0, false), true);
            *(GAS u2v*)((unsigned char*)WT + (size_t)(b64 * 64 + lane) * K + k0 + 8 * kc) = o; }
        else { v4u o; o.x = pk2(t[0], t[1]); o.y = pk2(t[2], t[3]); o.z = pk2(t[4], t[5]); o.w = pk2(t[6], t[7]);
            *(GAS v4u*)(WT + (size_t)(b64 * 64 + lane) * K + k0 + 8 * kc) = o; } }
    LDS_WAIT(); asm volatile("" ::: "memory");
}

struct Args { const float* in[23]; float* out; unsigned char* ws; int l_lo, l_hi, ph_lo, ph_hi, fused, pad; };
enum { PH_A = 0, PH_B, PH_C, PH_D, PH_E, PH_F, PH_G, PH_H, PH_G1, PH_G2, PH_CMB, PH_I, PH_N };

__device__ __forceinline__ bool ph_in(int lo, int hi, int k) { asm volatile("" : "+s"(lo), "+s"(hi)); return lo <= k && k < hi; }
__device__ __forceinline__ const float* inp_ptr(LAS unsigned char* lds, int k) {
    const volatile LAS unsigned* pt = (const volatile LAS unsigned*)(lds + PTAB_OFF) + 2 * k;
    const unsigned lo = __builtin_amdgcn_readfirstlane(pt[0]), hi = __builtin_amdgcn_readfirstlane(pt[1]);
    return (const float*)(const GAS float*)(((unsigned long long)hi << 32) | lo);
}
__global__ void __launch_bounds__(NWAVES * 64, 2) hybrid_fwd(Args args) {
    extern __shared__ __attribute__((aligned(16))) unsigned char lds_raw[];
    LAS unsigned char* lds = (LAS unsigned char*)lds_raw;
    volatile LAS unsigned* MISC = (volatile LAS unsigned*)(lds + MISC_OFF);
    const int tid0 = threadIdx.x;
    unsigned char* const ws0 = args.ws; float* const X0 = args.out;
    gu32* ctl = (gu32*)(ws0 + WS_CTL);
#define PHASE_VIEW() GAS unsigned char* wsg_ = (GAS unsigned char*)ws0; GAS float* xg_ = (GAS float*)X0; int tid = threadIdx.x, G = gridDim.x, bx = blockIdx.x; asm volatile("" : "+s"(wsg_), "+s"(xg_), "+v"(tid), "+s"(G), "+s"(bx)); \
    unsigned char* ws = (unsigned char*)wsg_; float* X = (float*)xg_;     \
    const int lane = tid & 63, wave = __builtin_amdgcn_readfirstlane(tid >> 6), gw = bx * NWAVES + wave, NGW = G * NWAVES; (void)lane; (void)wave; (void)gw; (void)NGW; \
    bf16* XB = (bf16*)(ws + WS_XB); bf16* XBN = (bf16*)(ws + WS_XBN); float* PART = (float*)(ws + WS_PART); float* PARTN = (float*)(ws + WS_PARTN); \
    (void)XB; (void)XBN; (void)PART; (void)PARTN; (void)X

    for (int u = tid0; u < (LDS_BYTES - LDSCTL_OFF) / 4; u += NWAVES * 64) ((LAS unsigned*)(lds + LDSCTL_OFF))[u] = 0u;
    __syncthreads();
    if (tid0 == 0) { LAS unsigned long long* pt = (LAS unsigned long long*)(lds + PTAB_OFF);
#pragma unroll
        for (int k = 0; k < 23; ++k) pt[k] = (unsigned long long)args.in[k]; }
    __syncthreads();
#define INP(k) inp_ptr(lds, (k))
    XcdBarrier bar; bar.bar = (unsigned*)(ctl + CW_BAR); bar.x = 0; bar.st = nullptr;
    if (args.fused) bar = xcd_barrier_post((unsigned*)(ctl + CW_BAR), MISC + 8);
#define GRID_BAR() do { if (args.fused) xcd_barrier(bar); } while (0)
    const int l_lo = args.l_lo, l_hi = args.l_hi, ph_lo = args.ph_lo, ph_hi = args.ph_hi;
#define IN(k) ph_in(ph_lo, ph_hi, (k))


    if (l_lo < 0) { PHASE_VIEW();
        {   LAS float* scr = (LAS float*)(lds + RING_OFF + wave * 16384);
            constexpr int I_IN = 16 * 80, I_KV = 16 * 24, I_CO = 8 * 16, I_SQ = 16 * 16, I_PP = 4 * 16, I_DG = 16 * 88, I_DD = 44 * 16;
            constexpr int I_LAYER = I_IN + I_KV + I_CO + 3 * I_SQ + I_PP + I_DG + I_DD;
            constexpr int I_G0 = A0G8 ? 2 * 16 * 48 : 0;
            for (int it = gw; it < DEPTH * I_LAYER + I_G0; it += NGW) {
                if (it >= DEPTH * I_LAYER) { const int q0 = it - DEPTH * I_LAYER, lg = q0 / (16 * 48), q = q0 % (16 * 48), r8 = (q / 48) * 80 + 32 + q % 48;
                    conv_item<true>(INP(3) + (size_t)lg * D * IN_COLS, nullptr, INP(2) + lg * D, (bf16*)(ws + WS_WIN8G0 + (size_t)lg * WS_WIN8G_STEP - (size_t)2048 * D), IN_COLS, D, 80, 1, r8, scr, lane); continue; }
                const int L = it / I_LAYER; int r = it % I_LAYER; const int j = L >> 1;
                if (r < I_IN) { if (L >= INPROJ8_LAYER) conv_item<true>(INP(3) + (size_t)L * D * IN_COLS, nullptr, INP(2) + L * D, (bf16*)(ws + WS_WIN) + (size_t)L * 5120 * D, IN_COLS, D, 80, 1, r, scr, lane);
                    else conv_item(INP(3) + (size_t)L * D * IN_COLS, nullptr, INP(2) + L * D, (bf16*)(ws + WS_WIN) + (size_t)L * 5120 * D, IN_COLS, D, 80, 1, r, scr, lane); continue; } r -= I_IN;
                if (r < I_KV) { if (L >= INPROJ8_LAYER) conv_item<true>(INP(3) + (size_t)L * D * IN_COLS, nullptr, INP(2) + L * D, (bf16*)(ws + WS_WKVT) + (size_t)L * 1536 * D, IN_COLS, D, 24, 2, r, scr, lane);
                    else conv_item(INP(3) + (size_t)L * D * IN_COLS, nullptr, INP(2) + L * D, (bf16*)(ws + WS_WKVT) + (size_t)L * 1536 * D, IN_COLS, D, 24, 2, r, scr, lane); continue; } r -= I_KV;
                if (r < I_CO) { conv_item(INP(8) + (size_t)L * CONV_DIM * D, nullptr, nullptr, (bf16*)(ws + WS_WCO) + (size_t)L * D * CONV_DIM, D, CONV_DIM, 16, 0, r, scr, lane); continue; } r -= I_CO;
                if (r < I_SQ) { conv_item(INP(9) + (size_t)L * D * D, nullptr, nullptr, (bf16*)(ws + WS_WRO) + (size_t)L * D * D, D, D, 16, 0, r, scr, lane); continue; } r -= I_SQ;
                if (r < I_SQ) { conv_item(INP(10) + (size_t)L * D * D, nullptr, nullptr, (bf16*)(ws + WS_WO) + (size_t)L * D * D, D, D, 16, 0, r, scr, lane); continue; } r -= I_SQ;
                if (r < I_SQ) { if (L >= PLE8_LAYER) conv_item<true>(INP(20) + (size_t)L * D * D, nullptr, INP(19) + L * D, (bf16*)(ws + WS_WPG) + (size_t)L * D * D, D, D, 16, 0, r, scr, lane);
                    else conv_item(INP(20) + (size_t)L * D * D, nullptr, INP(19) + L * D, (bf16*)(ws + WS_WPG) + (size_t)L * D * D, D, D, 16, 0, r, scr, lane); continue; } r -= I_SQ;
                if (r < I_PP) { conv_item(INP(21) + (size_t)L * PLE_DIM * D, nullptr, nullptr, (bf16*)(ws + WS_WPP) + (size_t)L * D * PLE_DIM, D, PLE_DIM, 16, 0, r, scr, lane); continue; } r -= I_PP;
                if (L & 1) continue;
                if (r < I_DG) { if (L == 2) conv_item<true>(INP(12) + (size_t)j * D * DFF, INP(13) + (size_t)j * D * DFF, INP(11) + L * D, (bf16*)(ws + WS_WDGU) + (size_t)j * 2 * DFF * D, DFF, D, 88, 3, r, scr, lane);
                    else conv_item(INP(12) + (size_t)j * D * DFF, INP(13) + (size_t)j * D * DFF, INP(11) + L * D, (bf16*)(ws + WS_WDGU) + (size_t)j * 2 * DFF * D, DFF, D, 88, 3, r, scr, lane); continue; } r -= I_DG;
                if (L == 2) conv_item<true>(INP(14) + (size_t)j * DFF * D, nullptr, nullptr, (bf16*)(ws + WS_WDD) + (size_t)j * D * DFF, D, DFF, 16, 0, r, scr, lane);
                else conv_item(INP(14) + (size_t)j * DFF * D, nullptr, nullptr, (bf16*)(ws + WS_WDD) + (size_t)j * D * DFF, D, DFF, 16, 0, r, scr, lane);
            }
        }
        for (int m = gw; m < T; m += NGW) {
            const GAS f32x4* xr = (const GAS f32x4*)(INP(0) + (size_t)m * D) + lane;
            GAS unsigned long long* o8 = (GAS unsigned long long*)(XBN + (size_t)m * D) + lane; float s = 0.f;
#pragma unroll
            for (int j = 0; j < 4; ++j) { const f32x4 v = xr[64 * j]; s += (v.x * v.x + v.y * v.y) + (v.z * v.z + v.w * v.w);
                o8[64 * j] = (unsigned long long)pk2(v.x, v.y) | ((unsigned long long)pk2(v.z, v.w) << 32);
                if (A0G8) ((GAS unsigned*)(ws + WS_XBN8 + (size_t)m * D))[64 * j + lane] = (unsigned)__builtin_amdgcn_cvt_pk_fp8_f32(v.z, v.w, __builtin_amdgcn_cvt_pk_fp8_f32(v.x, v.y, 0, false), true); }
            s = wave_sum(s);
            if (lane < 16) PARTN[(size_t)m * 16 + lane] = lane == 0 ? s : 0.f;
        }
        { const size_t n4 = (size_t)DEPTH * T * PLE_DIM / 4; const GAS f32x4* ps = (const GAS f32x4*)INP(1); GAS unsigned long long* pd = (GAS unsigned long long*)(ws + WS_PB);
          for (size_t i = (size_t)bx * 512 + tid; i < n4; i += (size_t)G * 512) { const f32x4 v = ps[i]; pd[i] = (unsigned long long)pk2(v.x, v.y) | ((unsigned long long)pk2(v.z, v.w) << 32); } }
        for (int i = bx * 512 + tid; i < SEQ * 32; i += G * 512) { const int pos = i >> 5, d = i & 31;
            const float inv = exp2f(-(float)d * 0.41524101186092029f);
            const float ang = (float)pos * inv; const double rev = (double)ang * 0.15915494309189535; const float fr = (float)(rev - rint(rev));
            const float sn = __builtin_amdgcn_sinf(fr), cs = __builtin_amdgcn_cosf(fr);
            ((float*)(ws + WS_COS))[i] = cs; ((float*)(ws + WS_SIN))[i] = sn; ((float*)(ws + WS_COST))[d * SEQ + pos] = cs; ((float*)(ws + WS_SINT))[d * SEQ + pos] = sn; }
        GRID_BAR();
    }

    if (0 >= l_lo && 0 < l_hi) { constexpr int L = 0;
        const bool moe = (L & 1) != 0; const int jl = L >> 1;
        constexpr bool INPROJ8 = (L >= INPROJ8_LAYER);
        constexpr bool PLE8 = (L >= PLE8_LAYER);
        constexpr bool DENSE8 = (L == 2);
#define MOE_VIEW() int* tok_e = (int*)(ws + WS_MOE + MO_TOKE); float* tok_g = (float*)(ws + WS_MOE + MO_TOKG); float* tok_rs = (float*)(ws + WS_MOE + MO_TOKRS); \
            int* tok_slot = (int*)(ws + WS_MOE + MO_SLOT); float* rsx = (float*)(ws + WS_MOE + MO_RSX); int* cnts = (int*)(ws + WS_MOE + MO_CNT); int* blk = (int*)(ws + WS_MOE + MO_BLK); \
            bf16* XG = (bf16*)(ws + WS_XG); bf16* EA = (bf16*)(ws + WS_EA); \
            (void)tok_e; (void)tok_g; (void)tok_rs; (void)tok_slot; (void)rsx; (void)cnts; (void)blk; (void)XG; (void)EA
#define MIX_VIEW() bf16* Zb = (bf16*)(ws + WS_Z); bf16* Qb = (bf16*)(ws + WS_Q); bf16* Kb = (bf16*)(ws + WS_K); bf16* KZT = (bf16*)(ws + WS_KZT); bf16* VT = (bf16*)(ws + WS_VT); \
        bf16* SG = (bf16*)(ws + WS_SG); bf16* SGA = (bf16*)(ws + WS_SGA); bf16* SGB = (bf16*)(ws + WS_SGB); bf16* Cb = (bf16*)(ws + WS_C); \
        float* KVT = (float*)(ws + WS_KVT); bf16* RB = (bf16*)(ws + WS_KVT); bf16* ST = (bf16*)(ws + WS_ST); bf16* MG = (bf16*)(ws + WS_MG); (void)RB; \
        (void)Zb; (void)Qb; (void)Kb; (void)KZT; (void)VT; (void)SG; (void)SGA; (void)SGB; (void)Cb; (void)KVT; (void)ST; (void)MG


        if (IN(PH_A)) { PHASE_VIEW(); MIX_VIEW();
            static_assert(WS_K - WS_Q == 2 * pg8::EpiIn::QK_STRIDE && WS_SGA - WS_SG == 2 * pg8::EpiIn::G_STRIDE && WS_SGB - WS_SGA == 2 * pg8::EpiIn::G_STRIDE, "EpiIn strides");
            if constexpr (L < 2 && A0G8 && !INPROJ8) {
              { pg8::Gemm g{(const bf16*)XBN, (const bf16*)(ws + WS_WIN) + (size_t)L * 5120 * D, T, 2048, D}; pg8::StaticOrder S; S.init(T, 2048, G, bx);
                pg8::EpiIn E{PARTN, (const float*)(ws + WS_COS), (const float*)(ws + WS_SIN), Zb, Qb, SG, 1.0f, 0};
                pg8::gemm_phase<pg8::EpiIn, pg8::StaticOrder, true, true, 0>(lds + RING_OFF, g, S, E); }
              { pg8::Gemm g{(const bf16*)(ws + WS_XBN8), (const bf16*)(ws + WS_WIN8G0 + (size_t)L * WS_WIN8G_STEP), T, 3072, D / 2}; pg8::StaticOrder S; S.init(T, 3072, G, bx);
                pg8::EpiIn E{PARTN, (const float*)(ws + WS_COS), (const float*)(ws + WS_SIN), Zb, Qb, SG, 1.0f / 64.0f, 8};
                pg8::gemm_phase<pg8::EpiIn, pg8::StaticOrder, true, true, 1>(lds + RING_OFF, g, S, E); }
            } else
            { pg8::Gemm g{INPROJ8 ? (const bf16*)(ws + WS_XBN8) : (const bf16*)XBN, (const bf16*)(ws + WS_WIN) + (size_t)L * 5120 * D, T, 5120, INPROJ8 ? D / 2 : D}; pg8::StaticOrder S; S.init(T, 5120, G, bx);
              pg8::EpiIn E{PARTN, (const float*)(ws + WS_COS), (const float*)(ws + WS_SIN), Zb, Qb, SG, INPROJ8 ? 1.0f / 64.0f : 1.0f, 0};
              pg8::gemm_phase<pg8::EpiIn, pg8::StaticOrder, true, true, INPROJ8 ? 1 : 0>(lds + RING_OFF, g, S, E); }

            { pg8::Gemm g{(const bf16*)(ws + WS_WKVT) + (size_t)L * 1536 * D, INPROJ8 ? (const bf16*)(ws + WS_XBN8) : (const bf16*)XBN, 1536, T, INPROJ8 ? D / 2 : D}; pg8::StaticOrder S; S.init(1536, T, G, bx);
              pg8::EpiKvT E{PARTN, (const float*)(ws + WS_COST), (const float*)(ws + WS_SINT), KZT, VT, INPROJ8 ? 1.0f / 64.0f : 1.0f};
              pg8::gemm_phase<pg8::EpiKvT, pg8::StaticOrder, true, true, INPROJ8 ? 1 : 0>(lds + RING_OFF, g, S, E); }
            GRID_BAR();
        }


        if (IN(PH_B)) { PHASE_VIEW(); MIX_VIEW();

            {
                const float* cw = INP(4) + (size_t)L * CONV_W * CONV_DIM; const float* cb = INP(5) + L * CONV_DIM;
                const float* lg = INP(6) + L * CONV_DIM; const float* lb = INP(7) + L * CONV_DIM;
                LAS unsigned* zt = (LAS unsigned*)(lds + RING_OFF);
                LAS float* ot = (LAS float*)(lds + RING_OFF + 65536);
                const int cp = tid & 255, half = tid >> 8;
                float w0[CONV_W], w1[CONV_W];
#pragma unroll
                for (int w = 0; w < CONV_W; ++w) { w0[w] = cw[w * CONV_DIM + 2 * cp]; w1[w] = cw[w * CONV_DIM + 2 * cp + 1]; }
                const float b0 = cb[2 * cp], b1 = cb[2 * cp + 1];
                f32x4 lg0 = *(const f32x4*)(lg + 8 * lane), lg1 = *(const f32x4*)(lg + 8 * lane + 4), lb0 = *(const f32x4*)(lb + 8 * lane), lb1 = *(const f32x4*)(lb + 8 * lane + 4);
                for (int u = bx; u < T / 32; u += G) {
                    const int tok0 = u * 32, pos0 = tok0 & (SEQ - 1);
                    for (int idx = tid; idx < 62 * 64; idx += 512) { const int r = idx >> 6, ch = idx & 63; const int pos = pos0 - 30 + r;
                        v4u v = {0u, 0u, 0u, 0u}; if (pos >= 0) v = *(const GAS v4u*)(Zb + (size_t)(tok0 - 30 + r) * CONV_DIM + ch * 8);
                        *(LAS v4u*)(zt + r * 256 + ch * 4) = v; }
                    __syncthreads();
#pragma unroll 1
                    for (int tg = 0; tg < 2; ++tg) { const int tb = 16 * half + 8 * tg;
                        float a0[8], a1[8];
#pragma unroll
                        for (int q = 0; q < 8; ++q) { a0[q] = b0; a1[q] = b1; }
#pragma unroll
                        for (int r = 0; r < 38; ++r) { const unsigned pv = zt[(tb + r) * 256 + cp]; const float f0 = __uint_as_float(pv << 16), f1 = __uint_as_float(pv & 0xffff0000u);
#pragma unroll
                            for (int q = 0; q < 8; ++q) { const int w = r - q; if (w >= 0 && w < CONV_W) { a0[q] = fmaf(w0[w], f0, a0[q]); a1[q] = fmaf(w1[w], f1, a1[q]); } } }
#pragma unroll
                        for (int q = 0; q < 8; ++q) { typedef float f2 __attribute__((ext_vector_type(2))); *(LAS f2*)(ot + (tb + q) * 512 + 2 * cp) = (f2){a0[q], a1[q]}; } }
                    __syncthreads();
#pragma unroll 1
                    for (int q = 0; q < 4; ++q) { const int tk = 4 * wave + q; const LAS f32x4* op = (const LAS f32x4*)(ot + tk * 512 + 8 * lane); f32x4 v0 = op[0], v1 = op[1];
                        const float mean = wave_sum((v0.x + v0.y) + (v0.z + v0.w) + (v1.x + v1.y) + (v1.z + v1.w)) * (1.0f / 512.0f);
                        v0 = v0 - mean; v1 = v1 - mean;
                        const float var = wave_sum((v0.x * v0.x + v0.y * v0.y) + (v0.z * v0.z + v0.w * v0.w) + (v1.x * v1.x + v1.y * v1.y) + (v1.z * v1.z + v1.w * v1.w)) * (1.0f / 512.0f);
                        const float rstd = __builtin_amdgcn_rsqf(var + EPS);
                        v0 = v0 * rstd * lg0 + lb0; v1 = v1 * rstd * lg1 + lb1;
                        v0 = v0 * pg8::sigm4(v0); v1 = v1 * pg8::sigm4(v1);
                        *(GAS v4u*)(Cb + (size_t)(tok0 + tk) * CONV_DIM + 8 * lane) = pg8::pack8(v0, v1); }
                    __syncthreads();
                }
            }

            {
                const int fr = lane & 15, g4 = lane >> 4;
                for (int u = bx; u < NUNIT; u += G) {
                    const int n = u & 63, bh = u >> 6, h = bh & 7, b = bh >> 3; const size_t tok0 = (size_t)b * SEQ + n * RC;
                    bf16x8 Bv[4], Ak[4][4];
#pragma unroll
                    for (int ks = 0; ks < 4; ++ks) Bv[ks] = *(const GAS bf16x8*)(VT + (size_t)(h * RDV + 16 * wave + fr) * T + tok0 + 32 * ks + 8 * g4);
#pragma unroll
                    for (int dkt = 0; dkt < 4; ++dkt)
#pragma unroll
                        for (int ks = 0; ks < 4; ++ks) Ak[dkt][ks] = *(const GAS bf16x8*)(KZT + (size_t)(h * RDK + 16 * dkt + fr) * T + tok0 + 32 * ks + 8 * g4);
                    f32x4 acc4[4];
#pragma unroll
                    for (int dkt = 0; dkt < 4; ++dkt) { acc4[dkt] = (f32x4){0.f, 0.f, 0.f, 0.f};
#pragma unroll
                        for (int ks = 0; ks < 4; ++ks) acc4[dkt] = __builtin_amdgcn_mfma_f32_16x16x32_bf16(Ak[dkt][ks], Bv[ks], acc4[dkt], 0, 0, 0); }
#pragma unroll
                    for (int dkt = 0; dkt < 4; ++dkt) { typedef unsigned u2 __attribute__((ext_vector_type(2))); u2 o; o.x = pk2(acc4[dkt].x, acc4[dkt].y); o.y = pk2(acc4[dkt].z, acc4[dkt].w);
                        *(GAS u2*)((bf16*)KVT + (size_t)u * (RDV * RDK) + (16 * wave + fr) * RDK + 16 * dkt + 4 * g4) = o; }
                }
            }

            if (moe) {
                __syncthreads();
                LAS float* scr = (LAS float*)(lds + RING_OFF + wave * 16384);
                constexpr int I_GU = 16 * 112, I_DN = 56 * 16, I_EXP = I_GU + I_DN;
                for (int it = gw; it < NEXP * I_EXP; it += NGW) { const int e = it / I_EXP, r = it % I_EXP; const size_t o = ((size_t)jl * NEXP + e) * D * EFF;
                    if (r < I_GU) conv_item<true>(INP(16) + o, INP(17) + o, INP(11) + L * D, (bf16*)(ws + WS_WEGU + (size_t)e * 2 * EFF * D), EFF, D, 112, 3, r, scr, lane);
                    else conv_item<true>(INP(18) + o, nullptr, nullptr, (bf16*)(ws + WS_WED + (size_t)e * D * EFF), D, EFF, 16, 0, r - I_GU, scr, lane); }
            }
            GRID_BAR();
        }


        if (IN(PH_C)) { PHASE_VIEW(); MIX_VIEW();
            {   const int gt = bx * 512 + tid;
                if (gt < 32 * 4096) { const int bh = gt >> 12, e2 = gt & 4095, h = bh & 7; const float gc = __builtin_amdgcn_exp2f(128.0f * log2g(h));
                    float s0 = 0.f, s1 = 0.f; typedef float f2 __attribute__((ext_vector_type(2)));
                    const GAS unsigned* kv = (const GAS unsigned*)((const bf16*)KVT + (size_t)bh * NCH * (RDV * RDK)) + e2; GAS unsigned* st = (GAS unsigned*)(ST + (size_t)bh * NCH * (RDV * RDK)) + e2;
                    unsigned wv[NCH];
#pragma unroll
                    for (int n = 0; n < NCH; ++n) wv[n] = kv[(size_t)n * 4096];
#pragma unroll
                    for (int n = 0; n < NCH; ++n) { const unsigned w = wv[n]; st[(size_t)n * 4096] = pk2(s0, s1); s0 = fmaf(gc, s0, __uint_as_float(w << 16)); s1 = fmaf(gc, s1, __uint_as_float(w & 0xffff0000u)); } }
            }
            { pg8::Gemm g{Cb, (const bf16*)(ws + WS_WCO) + (size_t)L * D * CONV_DIM, T, D, CONV_DIM}; pg8::StaticOrder S; S.init(T, D, G, bx);
              pg8::EpiGate<false> E{SGA, MG, 1.0f};
              pg8::gemm_phase<pg8::EpiGate<false>, pg8::StaticOrder, true, true>(lds + RING_OFF, g, S, E); }
            GRID_BAR();
        }


        if (IN(PH_D)) { PHASE_VIEW(); MIX_VIEW();
            const int fr = lane & 15, g4 = lane >> 4;
            unsigned offK[2], offS[2], offV[2];
#pragma unroll
            for (int i = 0; i < 2; ++i) { int R, C; pg8::stage_rc(tid * 16 + i * 8192, R, C); const int Rp = (R & ~31) + pg8::perm32(R & 31);
                offK[i] = (unsigned)(Rp * 512 + C) * 2u; offS[i] = (unsigned)(R * 64 + C) * 2u; offV[i] = (unsigned)R * (unsigned)(T * 2) + (unsigned)C * 2u; }
            const unsigned ldsw = (unsigned)wave * 1024u; const int fo = pg8::lds_byte(fr, g4 * 8);
#define RD_STAGE(bufoff, gbase, voff) do { _Pragma("unroll") for (int _i = 0; _i < 2; ++_i) \
                __builtin_amdgcn_global_load_lds((const unsigned*)((const char*)(gbase) + (voff)[_i]), (LAS unsigned*)(lds + (bufoff) + ldsw + _i * 8192), 16, 0, 0); } while (0)
#define RD_ISSUE(uu, buf) do { const int n_ = (uu) & 63, bh_ = (uu) >> 6, h_ = bh_ & 7, b_ = bh_ >> 3; const size_t t0_ = (size_t)b_ * SEQ + n_ * RC; const int so_ = (buf) * 65536; \
                RD_STAGE(so_, Kb + t0_ * 512 + h_ * RDK, offK); RD_STAGE(so_ + 16384, ST + (size_t)(uu) * (RDV * RDK), offS); \
                RD_STAGE(so_ + 32768, VT + (size_t)(h_ * RDV) * T + t0_, offV); RD_STAGE(so_ + 49152, VT + (size_t)(h_ * RDV) * T + t0_ + 64, offV); } while (0)
            int cur = 0;
            typedef unsigned u2 __attribute__((ext_vector_type(2)));
            bf16x8 Bq[2], Bqn[2]; u2 gv[8], gvn[8];
#define RD_QG(uu, BQ, GV) do { const int n_ = (uu) & 63, bh_ = (uu) >> 6, h_ = bh_ & 7, b_ = bh_ >> 3; const size_t tk_ = (size_t)b_ * SEQ + n_ * RC + 16 * wave + fr; \
                _Pragma("unroll") for (int ks = 0; ks < 2; ++ks) BQ[ks] = *(const GAS bf16x8*)(Qb + tk_ * 512 + h_ * RDK + 32 * ks + 8 * g4); \
                _Pragma("unroll") for (int dvt = 0; dvt < 8; ++dvt) GV[dvt] = *(const GAS u2*)(SG + tk_ * 1024 + h_ * RDV + 16 * dvt + 4 * g4); } while (0)
            if (bx < NUNIT) { RD_ISSUE(bx, 0); RD_QG(bx, Bq, gv); }
            for (int u = bx; u < NUNIT; u += G, cur ^= 1) {
                const int n = u & 63, bh = u >> 6, h = bh & 7, b = bh >> 3; const size_t tok0 = (size_t)b * SEQ + n * RC; const float lg = log2g(h);
                const size_t tok = tok0 + 16 * wave + fr;
                const int un = u + G;
                if (un < NUNIT) { RD_ISSUE(un, cur ^ 1); RD_QG(un, Bqn, gvn); asm volatile("s_waitcnt vmcnt(18)" ::: "memory"); } else { asm volatile("s_waitcnt vmcnt(0)" ::: "memory"); }
                __builtin_amdgcn_s_barrier(); asm volatile("" ::: "memory");
                const LAS unsigned char* sb = lds + cur * 65536 + fo;
                f32x4 oT[8], cT[8];
#pragma unroll
                for (int dvt = 0; dvt < 8; ++dvt) { oT[dvt] = (f32x4){0.f, 0.f, 0.f, 0.f}; cT[dvt] = (f32x4){0.f, 0.f, 0.f, 0.f}; }
#pragma unroll
                for (int t2 = 0; t2 < 4; ++t2) {
                    if (2 * t2 <= wave) {
                        unsigned P[2][2];
#pragma unroll
                        for (int nn = 0; nn < 2; ++nn) { f32x4 sv = {0.f, 0.f, 0.f, 0.f};
#pragma unroll
                            for (int ks = 0; ks < 2; ++ks) { const bf16x8 Ak = *(const LAS bf16x8*)(sb + (2 * t2 + nn) * 2048 + ks * 1024);
                                sv = __builtin_amdgcn_mfma_f32_16x16x32_bf16(Ak, Bq[ks], sv, 0, 0, 0); }
                            const int dd = (16 * wave + fr) - (32 * t2 + 8 * g4 + 4 * nn);
                            const float d0 = dd >= 0 ? sv.x * __builtin_amdgcn_exp2f((float)dd * lg) : 0.f, d1 = dd >= 1 ? sv.y * __builtin_amdgcn_exp2f((float)(dd - 1) * lg) : 0.f;
                            const float d2 = dd >= 2 ? sv.z * __builtin_amdgcn_exp2f((float)(dd - 2) * lg) : 0.f, d3 = dd >= 3 ? sv.w * __builtin_amdgcn_exp2f((float)(dd - 3) * lg) : 0.f;
                            P[nn][0] = pg8::cvt_pk_bf16(d0, d1); P[nn][1] = pg8::cvt_pk_bf16(d2, d3); }
                        v4u bp; bp.x = P[0][0]; bp.y = P[0][1]; bp.z = P[1][0]; bp.w = P[1][1];
                        const bf16x8 Bp = __builtin_bit_cast(bf16x8, bp);
                        const LAS unsigned char* vb = sb + 32768 + (t2 >> 1) * 16384 + (t2 & 1) * 1024;
#pragma unroll
                        for (int dvt = 0; dvt < 8; ++dvt) { const bf16x8 Av = *(const LAS bf16x8*)(vb + dvt * 2048);
                            oT[dvt] = __builtin_amdgcn_mfma_f32_16x16x32_bf16(Av, Bp, oT[dvt], 0, 0, 0); }
                    }
                }
#pragma unroll
                for (int dvt = 0; dvt < 8; ++dvt)
#pragma unroll
                    for (int ks = 0; ks < 2; ++ks) { const bf16x8 As = *(const LAS bf16x8*)(sb + 16384 + dvt * 2048 + ks * 1024);
                        cT[dvt] = __builtin_amdgcn_mfma_f32_16x16x32_bf16(As, Bq[ks], cT[dvt], 0, 0, 0); }
                const float xi = __builtin_amdgcn_exp2f((float)(16 * wave + fr + 1) * lg);
                float sm = 0.f;
#pragma unroll
                for (int dvt = 0; dvt < 8; ++dvt) { oT[dvt] = oT[dvt] + cT[dvt] * xi; sm += (oT[dvt].x + oT[dvt].y) + (oT[dvt].z + oT[dvt].w); }
                sm += __shfl_xor(sm, 16); sm += __shfl_xor(sm, 32);
                const float mean = sm * (1.0f / 128.0f); float sq = 0.f;
#pragma unroll
                for (int dvt = 0; dvt < 8; ++dvt) { oT[dvt] = oT[dvt] - mean; sq += (oT[dvt].x * oT[dvt].x + oT[dvt].y * oT[dvt].y) + (oT[dvt].z * oT[dvt].z + oT[dvt].w * oT[dvt].w); }
                sq += __shfl_xor(sq, 16); sq += __shfl_xor(sq, 32);
                const float rstd = __builtin_amdgcn_rsqf(sq * (1.0f / 128.0f) + EPS);
#pragma unroll
                for (int dvt = 0; dvt < 8; ++dvt) { const f32x4 graw = pg8::bf_lo4(gv[dvt].x, gv[dvt].y), gf = graw * pg8::sigm4(graw);
                    const f32x4 r = oT[dvt] * rstd * gf; u2 o; o.x = pg8::cvt_pk_bf16(r.x, r.y); o.y = pg8::cvt_pk_bf16(r.z, r.w); *(GAS u2*)(RB + tok * 1024 + h * RDV + 16 * dvt + 4 * g4) = o; }
                asm volatile("s_waitcnt lgkmcnt(0)" ::: "memory"); __builtin_amdgcn_s_barrier(); asm volatile("" ::: "memory");
#pragma unroll
                for (int ks = 0; ks < 2; ++ks) Bq[ks] = Bqn[ks];
#pragma unroll
                for (int dvt = 0; dvt < 8; ++dvt) gv[dvt] = gvn[dvt];
            }
#undef RD_QG
#undef RD_ISSUE
#undef RD_STAGE
            GRID_BAR();
        }


        if (IN(PH_E)) { PHASE_VIEW(); MIX_VIEW();
            pg8::Gemm g{RB, (const bf16*)(ws + WS_WRO) + (size_t)L * D * D, T, D, D}; pg8::StaticOrder S; S.init(T, D, G, bx);
            pg8::EpiGate<true> E{SGB, MG, SC_E};
            pg8::gemm_phase<pg8::EpiGate<true>, pg8::StaticOrder, true, true>(lds + RING_OFF, g, S, E);
            GRID_BAR();
        }


        if (IN(PH_F)) { PHASE_VIEW(); MIX_VIEW();
            pg8::Gemm g{MG, (const bf16*)(ws + WS_WO) + (size_t)L * D * D, T, D, D}; pg8::StaticOrder S; S.init(T, D, G, bx);
            pg8::EpiRes<false, DENSE8> E{XBN, XB, PART, nullptr, nullptr, ws + WS_XB8, SC_F};
            pg8::gemm_phase<pg8::EpiRes<false, DENSE8>, pg8::StaticOrder, true, true>(lds + RING_OFF, g, S, E);
            GRID_BAR();
        }

        if (!moe) {

            if (IN(PH_G)) { PHASE_VIEW(); MOE_VIEW();
                pg8::Gemm g{DENSE8 ? (const bf16*)(ws + WS_XB8) : (const bf16*)XB, (const bf16*)(ws + WS_WDGU) + (size_t)jl * 2 * DFF * D, T, 2 * DFF, DENSE8 ? D / 2 : D}; pg8::StaticOrder S; S.init(T, 2 * DFF, G, bx);
                pg8::EpiSwi<false, DENSE8> E{PART, nullptr, (bf16*)(ws + WS_FA), DFF};
                pg8::gemm_phase<pg8::EpiSwi<false, DENSE8>, pg8::StaticOrder, true, true, DENSE8 ? 1 : 0>(lds + RING_OFF, g, S, E);
                GRID_BAR();
            }

            if (IN(PH_H)) { PHASE_VIEW(); MOE_VIEW();
                pg8::Gemm g{(const bf16*)(ws + WS_FA), (const bf16*)(ws + WS_WDD) + (size_t)jl * D * DFF, T, D, DENSE8 ? DFF / 2 : DFF}; pg8::StaticOrder S; S.init(T, D, G, bx, 1);
                pg8::EpiRes<false, PLE8> E{XB, XB, PART, nullptr, nullptr, ws + WS_X8F, SC_Hd * (DENSE8 ? 1.0f / 256.0f : 1.0f)};
                pg8::gemm_phase<pg8::EpiRes<false, PLE8>, pg8::StaticOrder, true, true, DENSE8 ? 1 : 0>(lds + RING_OFF, g, S, E);
                GRID_BAR();
            }
        } else {

            if (IN(PH_G)) { PHASE_VIEW(); MOE_VIEW();
                LAS float* wrT = (LAS float*)(lds + RING_OFF);
                LAS int* lcnt = (LAS int*)(lds + RING_OFF + 32768);
                const float* wr = INP(15) + (size_t)jl * D * NEXP; const float* gf = INP(11) + L * D;
                for (int i = tid; i < D * NEXP; i += 512) { const int k = i >> 3, e = i & 7; wrT[e * 1024 + k] = wr[i] * gf[k]; }
                if (tid < 8) lcnt[tid] = 0;
                __syncthreads();
                f32x4 wreg[8][4];
#pragma unroll
                for (int e = 0; e < 8; ++e)
#pragma unroll
                    for (int j = 0; j < 4; ++j) wreg[e][j] = *(const LAS f32x4*)(wrT + e * 1024 + 256 * j + 4 * lane);
                typedef unsigned u2 __attribute__((ext_vector_type(2)));
                u2 xw[4], xwn[4];
                { const GAS u2* xr = (const GAS u2*)(XB + (size_t)(bx * 128 + wave * 16) * D) + lane;
#pragma unroll
                  for (int j = 0; j < 4; ++j) xw[j] = xr[64 * j]; }
                for (int q = 0; q < 16; ++q) { const int t = bx * 128 + wave * 16 + q;
                    if (q < 15) { const GAS u2* xr = (const GAS u2*)(XB + (size_t)(t + 1) * D) + lane;
#pragma unroll
                        for (int j = 0; j < 4; ++j) xwn[j] = xr[64 * j]; }
                    f32x4 xv[4]; float ss = 0.f;
#pragma unroll
                    for (int j = 0; j < 4; ++j) { xv[j] = pg8::bf_lo4(xw[j].x, xw[j].y); ss += (xv[j].x * xv[j].x + xv[j].y * xv[j].y) + (xv[j].z * xv[j].z + xv[j].w * xv[j].w); }
                    float pa[8];
#pragma unroll
                    for (int e = 0; e < 8; ++e) { float a = 0.f;
#pragma unroll
                        for (int j = 0; j < 4; ++j) { const f32x4 w = wreg[e][j]; a += (xv[j].x * w.x + xv[j].y * w.y) + (xv[j].z * w.z + xv[j].w * w.w); }
                        pa[e] = a; }
                    float r4[4], r2[2], r1;
                    { const bool hi = (lane & 32) != 0;
#pragma unroll
                      for (int i = 0; i < 4; ++i) { const float snd = hi ? pa[i] : pa[i + 4], kp = hi ? pa[i + 4] : pa[i]; r4[i] = kp + __shfl_xor(snd, 32); } }
                    { const bool hi = (lane & 16) != 0;
#pragma unroll
                      for (int i = 0; i < 2; ++i) { const float snd = hi ? r4[i] : r4[i + 2], kp = hi ? r4[i + 2] : r4[i]; r2[i] = kp + __shfl_xor(snd, 16); } }
                    { const bool hi = (lane & 8) != 0; const float snd = hi ? r2[0] : r2[1], kp = hi ? r2[1] : r2[0]; r1 = kp + __shfl_xor(snd, 8); }
                    r1 += __shfl_xor(r1, 4); r1 += __shfl_xor(r1, 2); r1 += __shfl_xor(r1, 1);
                    float lgt[8];
#pragma unroll
                    for (int e = 0; e < 8; ++e) lgt[e] = __int_as_float(__builtin_amdgcn_readlane(__float_as_int(r1), 8 * e));
                    ss = wave_sum(ss); const float rs = __builtin_amdgcn_rsqf(ss * (1.0f / 1024.0f) + EPS);
                    int e1 = 0; float v1 = lgt[0];
#pragma unroll
                    for (int e = 1; e < 8; ++e) if (lgt[e] > v1) { v1 = lgt[e]; e1 = e; }
                    int e2 = -1; float v2 = 0.f;
#pragma unroll
                    for (int e = 0; e < 8; ++e) if (e != e1 && (e2 < 0 || lgt[e] > v2)) { v2 = lgt[e]; e2 = e; }
                    const float ex = __builtin_amdgcn_exp2f((v2 - v1) * rs * kLog2e), g1 = 1.0f / (1.0f + ex), g2 = ex * g1;
                    if (lane == 0) { tok_e[2 * t] = e1; tok_e[2 * t + 1] = e2; tok_g[2 * t] = g1; tok_g[2 * t + 1] = g2; tok_rs[t] = rs; atomicAdd((int*)&lcnt[e1], 1); atomicAdd((int*)&lcnt[e2], 1); }
#pragma unroll
                    for (int j = 0; j < 4; ++j) xw[j] = xwn[j];
                }
                __syncthreads();
                if (tid < 8) cnts[bx * 8 + tid] = lcnt[tid];
                __syncthreads();
                GRID_BAR();
            }

            if (IN(PH_H)) { PHASE_VIEW(); MOE_VIEW();
                LAS int* lc = (LAS int*)(lds + RING_OFF);
                LAS int* base = lc + 2048;
                LAS int* lslot = base + 16;
                LAS int* le = lslot + 256;
                for (int i = tid; i < 2048; i += 512) lc[i] = cnts[i];
                if (tid < 256) le[tid] = tok_e[bx * 256 + tid];
                __syncthreads();
                {
                    int tot = 0, pre = 0;
#pragma unroll
                    for (int k = 0; k < 4; ++k) { const int wg = lane + 64 * k; const int c = lc[wg * 8 + wave]; tot += c; pre += (wg < bx) ? c : 0; }
#pragma unroll
                    for (int o = 1; o < 64; o <<= 1) { tot += __shfl_xor(tot, o); pre += __shfl_xor(pre, o); }
                    if (lane == 0) { base[wave] = pre; base[8 + wave] = tot; }
                }
                __syncthreads();
                if (tid == 0) { int ps = 0; for (int e = 0; e < 8; ++e) { const int tot = base[8 + e]; base[e] += ps; const int nb = (tot + 255) >> 8;
                        if (bx == 0) { for (int q = 0; q < nb; ++q) blk[1 + (ps >> 8) + q] = e; }
                        ps += nb << 8; }
                    if (bx == 0) blk[0] = ps >> 8; }
                __syncthreads();
                {
                    int run = base[wave];
#pragma unroll
                    for (int k = 0; k < 2; ++k) { const int i = lane + 64 * k; const int a = le[2 * i], b2 = le[2 * i + 1]; const bool f = (a == wave) || (b2 == wave);
                        const unsigned long long m = __ballot(f); const int rank = __popcll(m & ((1ull << lane) - 1ull));
                        if (f) lslot[2 * i + (a == wave ? 0 : 1)] = run + rank;
                        run += __popcll(m); }
                }
                __syncthreads();
                if (tid < 256) { const int t = bx * 128 + (tid >> 1); const int s = lslot[tid]; tok_slot[bx * 256 + tid] = s; rsx[s] = tok_rs[t]; }
                for (int p = wave; p < 256; p += 8) { const int t = bx * 128 + (p >> 1), s = lslot[p];
                    const GAS v4u* src = (const GAS v4u*)(XB + (size_t)t * D) + 2 * lane; const v4u a = src[0], b4 = src[1];
                    const f32x4 f0 = pg8::bf_lo4(a.x, a.y), f1 = pg8::bf_lo4(a.z, a.w), f2 = pg8::bf_lo4(b4.x, b4.y), f3 = pg8::bf_lo4(b4.z, b4.w); v4u o;
                    o.x = (unsigned)__builtin_amdgcn_cvt_pk_fp8_f32(f0.z, f0.w, __builtin_amdgcn_cvt_pk_fp8_f32(f0.x, f0.y, 0, false), true);
                    o.y = (unsigned)__builtin_amdgcn_cvt_pk_fp8_f32(f1.z, f1.w, __builtin_amdgcn_cvt_pk_fp8_f32(f1.x, f1.y, 0, false), true);
                    o.z = (unsigned)__builtin_amdgcn_cvt_pk_fp8_f32(f2.z, f2.w, __builtin_amdgcn_cvt_pk_fp8_f32(f2.x, f2.y, 0, false), true);
                    o.w = (unsigned)__builtin_amdgcn_cvt_pk_fp8_f32(f3.z, f3.w, __builtin_amdgcn_cvt_pk_fp8_f32(f3.x, f3.y, 0, false), true);
                    *((GAS v4u*)((unsigned char*)XG + (size_t)s * D) + lane) = o; }
                __syncthreads();
                GRID_BAR();
            }

            if (IN(PH_G1)) { PHASE_VIEW(); MOE_VIEW();
                const int nblk = blk[0];
                pg8::Gemm g{XG, (const bf16*)(ws + WS_WEGU), nblk * 256, 2 * EFF, D / 2}; pg8::MoeOrder S; S.init(nblk * 256, 2 * EFF, G, bx); S.blk_e = blk + 1; S.ntile = 2 * EFF / 256;
                pg8::EpiSwi<true> E{nullptr, rsx, EA, EFF};
                pg8::gemm_phase<pg8::EpiSwi<true>, pg8::MoeOrder, true, true, 1>(lds + RING_OFF, g, S, E);
                GRID_BAR();
            }

            if (IN(PH_G2)) { PHASE_VIEW(); MOE_VIEW();
                const int nblk = blk[0];
                pg8::Gemm g{EA, (const bf16*)(ws + WS_WED), nblk * 256, D, EFF / 2}; pg8::MoeOrder S; S.init(nblk * 256, D, G, bx, 1); S.blk_e = blk + 1; S.ntile = D / 256;
                pg8::EpiStore E{XG, D, 1.0f / 256.0f};
                pg8::gemm_phase<pg8::EpiStore, pg8::MoeOrder, true, true, 1>(lds + RING_OFF, g, S, E);
                GRID_BAR();
            }

            if (IN(PH_CMB)) { PHASE_VIEW(); MOE_VIEW();
                for (int t = gw; t < T; t += NGW) {
                    const int s1 = tok_slot[2 * t], s2 = tok_slot[2 * t + 1]; const float g1 = tok_g[2 * t], g2 = tok_g[2 * t + 1];
                    typedef unsigned u2 __attribute__((ext_vector_type(2))); GAS u2* xr = (GAS u2*)(XB + (size_t)t * D) + lane;
                    const GAS u2* y1 = (const GAS u2*)(XG + (size_t)s1 * D) + lane; const GAS u2* y2 = (const GAS u2*)(XG + (size_t)s2 * D) + lane;
                    float s = 0.f;
#pragma unroll
                    for (int j = 0; j < 4; ++j) { const u2 xw = xr[64 * j]; f32x4 v = pg8::bf_lo4(xw.x, xw.y); const u2 a = y1[64 * j], b2 = y2[64 * j];
                        v = v + (pg8::bf_lo4(a.x, a.y) * g1 + pg8::bf_lo4(b2.x, b2.y) * g2) * SC_CMB; s += (v.x * v.x + v.y * v.y) + (v.z * v.z + v.w * v.w);
                        u2 o; o.x = pk2(v.x, v.y); o.y = pk2(v.z, v.w); xr[64 * j] = o;
                        if (PLE8) ((GAS unsigned*)(ws + WS_X8F + (size_t)t * D))[64 * j + lane] = (unsigned)__builtin_amdgcn_cvt_pk_fp8_f32(v.z, v.w, __builtin_amdgcn_cvt_pk_fp8_f32(v.x, v.y, 0, false), true); }
                    s = wave_sum(s);
                    if (lane < 16) PART[(size_t)t * 16 + lane] = lane == 0 ? s : 0.f;
                }
                GRID_BAR();
            }
        }


        if (IN(PH_I)) { PHASE_VIEW(); MIX_VIEW();
            bf16* PP = (bf16*)(ws + WS_PP);
            { pg8::Gemm g{(const bf16*)(ws + WS_PB) + (size_t)L * T * PLE_DIM, (const bf16*)(ws + WS_WPP) + (size_t)L * D * PLE_DIM, T, D, PLE_DIM}; pg8::StaticOrder S; S.init(T, D, G, bx);
              pg8::EpiStore E{PP, D, 1.0f};
              pg8::gemm_phase<pg8::EpiStore, pg8::StaticOrder, true, true>(lds + RING_OFF, g, S, E); }
            { pg8::Gemm g{PLE8 ? (const bf16*)(ws + WS_X8F) : (const bf16*)XB, (const bf16*)(ws + WS_WPG) + (size_t)L * D * D, T, D, PLE8 ? D / 2 : D}; pg8::StaticOrder S; S.init(T, D, G, bx);
              pg8::EpiRes<true, (L + 1 >= (A0G8 ? 1 : INPROJ8_LAYER) && L + 1 < DEPTH), PLE8> E{XB, XBN, PARTN, PART, PP, ws + WS_XBN8, SC_I};
              pg8::gemm_phase<pg8::EpiRes<true, (L + 1 >= (A0G8 ? 1 : INPROJ8_LAYER) && L + 1 < DEPTH), PLE8>, pg8::StaticOrder, true, true, PLE8 ? 1 : 0>(lds + RING_OFF, g, S, E); }
            GRID_BAR();
        }
    }
    if (1 >= l_lo && 1 < l_hi) { constexpr int L = 1;
        const bool moe = (L & 1) != 0; const int jl = L >> 1;
        constexpr bool INPROJ8 = (L >= INPROJ8_LAYER);
        constexpr bool PLE8 = (L >= PLE8_LAYER);
        constexpr bool DENSE8 = (L == 2);
#define MOE_VIEW() int* tok_e = (int*)(ws + WS_MOE + MO_TOKE); float* tok_g = (float*)(ws + WS_MOE + MO_TOKG); float* tok_rs = (float*)(ws + WS_MOE + MO_TOKRS); \
            int* tok_slot = (int*)(ws + WS_MOE + MO_SLOT); float* rsx = (float*)(ws + WS_MOE + MO_RSX); int* cnts = (int*)(ws + WS_MOE + MO_CNT); int* blk = (int*)(ws + WS_MOE + MO_BLK); \
            bf16* XG = (bf16*)(ws + WS_XG); bf16* EA = (bf16*)(ws + WS_EA); \
            (void)tok_e; (void)tok_g; (void)tok_rs; (void)tok_slot; (void)rsx; (void)cnts; (void)blk; (void)XG; (void)EA
#define MIX_VIEW() bf16* Zb = (bf16*)(ws + WS_Z); bf16* Qb = (bf16*)(ws + WS_Q); bf16* Kb = (bf16*)(ws + WS_K); bf16* KZT = (bf16*)(ws + WS_KZT); bf16* VT = (bf16*)(ws + WS_VT); \
        bf16* SG = (bf16*)(ws + WS_SG); bf16* SGA = (bf16*)(ws + WS_SGA); bf16* SGB = (bf16*)(ws + WS_SGB); bf16* Cb = (bf16*)(ws + WS_C); \
        float* KVT = (float*)(ws + WS_KVT); bf16* RB = (bf16*)(ws + WS_KVT); bf16* ST = (bf16*)(ws + WS_ST); bf16* MG = (bf16*)(ws + WS_MG); (void)RB; \
        (void)Zb; (void)Qb; (void)Kb; (void)KZT; (void)VT; (void)SG; (void)SGA; (void)SGB; (void)Cb; (void)KVT; (void)ST; (void)MG


        if (IN(PH_A)) { PHASE_VIEW(); MIX_VIEW();
            static_assert(WS_K - WS_Q == 2 * pg8::EpiIn::QK_STRIDE && WS_SGA - WS_SG == 2 * pg8::EpiIn::G_STRIDE && WS_SGB - WS_SGA == 2 * pg8::EpiIn::G_STRIDE, "EpiIn strides");
            if constexpr (L < 2 && A0G8 && !INPROJ8) {
              { pg8::Gemm g{(const bf16*)XBN, (const bf16*)(ws + WS_WIN) + (size_t)L * 5120 * D, T, 2048, D}; pg8::StaticOrder S; S.init(T, 2048, G, bx);
                pg8::EpiIn E{PARTN, (const float*)(ws + WS_COS), (const float*)(ws + WS_SIN), Zb, Qb, SG, 1.0f, 0};
                pg8::gemm_phase<pg8::EpiIn, pg8::StaticOrder, true, true, 0>(lds + RING_OFF, g, S, E); }
              { pg8::Gemm g{(const bf16*)(ws + WS_XBN8), (const bf16*)(ws + WS_WIN8G0 + (size_t)L * WS_WIN8G_STEP), T, 3072, D / 2}; pg8::StaticOrder S; S.init(T, 3072, G, bx);
                pg8::EpiIn E{PARTN, (const float*)(ws + WS_COS), (const float*)(ws + WS_SIN), Zb, Qb, SG, 1.0f / 64.0f, 8};
                pg8::gemm_phase<pg8::EpiIn, pg8::StaticOrder, true, true, 1>(lds + RING_OFF, g, S, E); }
            } else
            { pg8::Gemm g{INPROJ8 ? (const bf16*)(ws + WS_XBN8) : (const bf16*)XBN, (const bf16*)(ws + WS_WIN) + (size_t)L * 5120 * D, T, 5120, INPROJ8 ? D / 2 : D}; pg8::StaticOrder S; S.init(T, 5120, G, bx);
              pg8::EpiIn E{PARTN, (const float*)(ws + WS_COS), (const float*)(ws + WS_SIN), Zb, Qb, SG, INPROJ8 ? 1.0f / 64.0f : 1.0f, 0};
              pg8::gemm_phase<pg8::EpiIn, pg8::StaticOrder, true, true, INPROJ8 ? 1 : 0>(lds + RING_OFF, g, S, E); }

            { pg8::Gemm g{(const bf16*)(ws + WS_WKVT) + (size_t)L * 1536 * D, INPROJ8 ? (const bf16*)(ws + WS_XBN8) : (const bf16*)XBN, 1536, T, INPROJ8 ? D / 2 : D}; pg8::StaticOrder S; S.init(1536, T, G, bx);
              pg8::EpiKvT E{PARTN, (const float*)(ws + WS_COST), (const float*)(ws + WS_SINT), KZT, VT, INPROJ8 ? 1.0f / 64.0f : 1.0f};
              pg8::gemm_phase<pg8::EpiKvT, pg8::StaticOrder, true, true, INPROJ8 ? 1 : 0>(lds + RING_OFF, g, S, E); }
            GRID_BAR();
        }


        if (IN(PH_B)) { PHASE_VIEW(); MIX_VIEW();

            {
                const float* cw = INP(4) + (size_t)L * CONV_W * CONV_DIM; const float* cb = INP(5) + L * CONV_DIM;
                const float* lg = INP(6) + L * CONV_DIM; const float* lb = INP(7) + L * CONV_DIM;
                LAS unsigned* zt = (LAS unsigned*)(lds + RING_OFF);
                LAS float* ot = (LAS float*)(lds + RING_OFF + 65536);
                const int cp = tid & 255, half = tid >> 8;
                float w0[CONV_W], w1[CONV_W];
#pragma unroll
                for (int w = 0; w < CONV_W; ++w) { w0[w] = cw[w * CONV_DIM + 2 * cp]; w1[w] = cw[w * CONV_DIM + 2 * cp + 1]; }
                const float b0 = cb[2 * cp], b1 = cb[2 * cp + 1];
                f32x4 lg0 = *(const f32x4*)(lg + 8 * lane), lg1 = *(const f32x4*)(lg + 8 * lane + 4), lb0 = *(const f32x4*)(lb + 8 * lane), lb1 = *(const f32x4*)(lb + 8 * lane + 4);
                for (int u = bx; u < T / 32; u += G) {
                    const int tok0 = u * 32, pos0 = tok0 & (SEQ - 1);
                    for (int idx = tid; idx < 62 * 64; idx += 512) { const int r = idx >> 6, ch = idx & 63; const int pos = pos0 - 30 + r;
                        v4u v = {0u, 0u, 0u, 0u}; if (pos >= 0) v = *(const GAS v4u*)(Zb + (size_t)(tok0 - 30 + r) * CONV_DIM + ch * 8);
                        *(LAS v4u*)(zt + r * 256 + ch * 4) = v; }
                    __syncthreads();
#pragma unroll 1
                    for (int tg = 0; tg < 2; ++tg) { const int tb = 16 * half + 8 * tg;
                        float a0[8], a1[8];
#pragma unroll
                        for (int q = 0; q < 8; ++q) { a0[q] = b0; a1[q] = b1; }
#pragma unroll
                        for (int r = 0; r < 38; ++r) { const unsigned pv = zt[(tb + r) * 256 + cp]; const float f0 = __uint_as_float(pv << 16), f1 = __uint_as_float(pv & 0xffff0000u);
#pragma unroll
                            for (int q = 0; q < 8; ++q) { const int w = r - q; if (w >= 0 && w < CONV_W) { a0[q] = fmaf(w0[w], f0, a0[q]); a1[q] = fmaf(w1[w], f1, a1[q]); } } }
#pragma unroll
                        for (int q = 0; q < 8; ++q) { typedef float f2 __attribute__((ext_vector_type(2))); *(LAS f2*)(ot + (tb + q) * 512 + 2 * cp) = (f2){a0[q], a1[q]}; } }
                    __syncthreads();
#pragma unroll 1
                    for (int q = 0; q < 4; ++q) { const int tk = 4 * wave + q; const LAS f32x4* op = (const LAS f32x4*)(ot + tk * 512 + 8 * lane); f32x4 v0 = op[0], v1 = op[1];
                        const float mean = wave_sum((v0.x + v0.y) + (v0.z + v0.w) + (v1.x + v1.y) + (v1.z + v1.w)) * (1.0f / 512.0f);
                        v0 = v0 - mean; v1 = v1 - mean;
                        const float var = wave_sum((v0.x * v0.x + v0.y * v0.y) + (v0.z * v0.z + v0.w * v0.w) + (v1.x * v1.x + v1.y * v1.y) + (v1.z * v1.z + v1.w * v1.w)) * (1.0f / 512.0f);
                        const float rstd = __builtin_amdgcn_rsqf(var + EPS);
                        v0 = v0 * rstd * lg0 + lb0; v1 = v1 * rstd * lg1 + lb1;
                        v0 = v0 * pg8::sigm4(v0); v1 = v1 * pg8::sigm4(v1);
                        *(GAS v4u*)(Cb + (size_t)(tok0 + tk) * CONV_DIM + 8 * lane) = pg8::pack8(v0, v1); }
                    __syncthreads();
                }
            }

            {
                const int fr = lane & 15, g4 = lane >> 4;
                for (int u = bx; u < NUNIT; u += G) {
                    const int n = u & 63, bh = u >> 6, h = bh & 7, b = bh >> 3; const size_t tok0 = (size_t)b * SEQ + n * RC;
                    bf16x8 Bv[4], Ak[4][4];
#pragma unroll
                    for (int ks = 0; ks < 4; ++ks) Bv[ks] = *(const GAS bf16x8*)(VT + (size_t)(h * RDV + 16 * wave + fr) * T + tok0 + 32 * ks + 8 * g4);
#pragma unroll
                    for (int dkt = 0; dkt < 4; ++dkt)
#pragma unroll
                        for (int ks = 0; ks < 4; ++ks) Ak[dkt][ks] = *(const GAS bf16x8*)(KZT + (size_t)(h * RDK + 16 * dkt + fr) * T + tok0 + 32 * ks + 8 * g4);
                    f32x4 acc4[4];
#pragma unroll
                    for (int dkt = 0; dkt < 4; ++dkt) { acc4[dkt] = (f32x4){0.f, 0.f, 0.f, 0.f};
#pragma unroll
                        for (int ks = 0; ks < 4; ++ks) acc4[dkt] = __builtin_amdgcn_mfma_f32_16x16x32_bf16(Ak[dkt][ks], Bv[ks], acc4[dkt], 0, 0, 0); }
#pragma unroll
                    for (int dkt = 0; dkt < 4; ++dkt) { typedef unsigned u2 __attribute__((ext_vector_type(2))); u2 o; o.x = pk2(acc4[dkt].x, acc4[dkt].y); o.y = pk2(acc4[dkt].z, acc4[dkt].w);
                        *(GAS u2*)((bf16*)KVT + (size_t)u * (RDV * RDK) + (16 * wave + fr) * RDK + 16 * dkt + 4 * g4) = o; }
                }
            }

            if (moe) {
                __syncthreads();
                LAS float* scr = (LAS float*)(lds + RING_OFF + wave * 16384);
                constexpr int I_GU = 16 * 112, I_DN = 56 * 16, I_EXP = I_GU + I_DN;
                for (int it = gw; it < NEXP * I_EXP; it += NGW) { const int e = it / I_EXP, r = it % I_EXP; const size_t o = ((size_t)jl * NEXP + e) * D * EFF;
                    if (r < I_GU) conv_item<true>(INP(16) + o, INP(17) + o, INP(11) + L * D, (bf16*)(ws + WS_WEGU + (size_t)e * 2 * EFF * D), EFF, D, 112, 3, r, scr, lane);
                    else conv_item<true>(INP(18) + o, nullptr, nullptr, (bf16*)(ws + WS_WED + (size_t)e * D * EFF), D, EFF, 16, 0, r - I_GU, scr, lane); }
            }
            GRID_BAR();
        }


        if (IN(PH_C)) { PHASE_VIEW(); MIX_VIEW();
            {   const int gt = bx * 512 + tid;
                if (gt < 32 * 4096) { const int bh = gt >> 12, e2 = gt & 4095, h = bh & 7; const float gc = __builtin_amdgcn_exp2f(128.0f * log2g(h));
                    float s0 = 0.f, s1 = 0.f; typedef float f2 __attribute__((ext_vector_type(2)));
                    const GAS unsigned* kv = (const GAS unsigned*)((const bf16*)KVT + (size_t)bh * NCH * (RDV * RDK)) + e2; GAS unsigned* st = (GAS unsigned*)(ST + (size_t)bh * NCH * (RDV * RDK)) + e2;
                    unsigned wv[NCH];
#pragma unroll
                    for (int n = 0; n < NCH; ++n) wv[n] = kv[(size_t)n * 4096];
#pragma unroll
                    for (int n = 0; n < NCH; ++n) { const unsigned w = wv[n]; st[(size_t)n * 4096] = pk2(s0, s1); s0 = fmaf(gc, s0, __uint_as_float(w << 16)); s1 = fmaf(gc, s1, __uint_as_float(w & 0xffff0000u)); } }
            }
            { pg8::Gemm g{Cb, (const bf16*)(ws + WS_WCO) + (size_t)L * D * CONV_DIM, T, D, CONV_DIM}; pg8::StaticOrder S; S.init(T, D, G, bx);
              pg8::EpiGate<false> E{SGA, MG, 1.0f};
              pg8::gemm_phase<pg8::EpiGate<false>, pg8::StaticOrder, true, true>(lds + RING_OFF, g, S, E); }
            GRID_BAR();
        }


        if (IN(PH_D)) { PHASE_VIEW(); MIX_VIEW();
            const int fr = lane & 15, g4 = lane >> 4;
            unsigned offK[2], offS[2], offV[2];
#pragma unroll
            for (int i = 0; i < 2; ++i) { int R, C; pg8::stage_rc(tid * 16 + i * 8192, R, C); const int Rp = (R & ~31) + pg8::perm32(R & 31);
                offK[i] = (unsigned)(Rp * 512 + C) * 2u; offS[i] = (unsigned)(R * 64 + C) * 2u; offV[i] = (unsigned)R * (unsigned)(T * 2) + (unsigned)C * 2u; }
            const unsigned ldsw = (unsigned)wave * 1024u; const int fo = pg8::lds_byte(fr, g4 * 8);
#define RD_STAGE(bufoff, gbase, voff) do { _Pragma("unroll") for (int _i = 0; _i < 2; ++_i) \
                __builtin_amdgcn_global_load_lds((const unsigned*)((const char*)(gbase) + (voff)[_i]), (LAS unsigned*)(lds + (bufoff) + ldsw + _i * 8192), 16, 0, 0); } while (0)
#define RD_ISSUE(uu, buf) do { const int n_ = (uu) & 63, bh_ = (uu) >> 6, h_ = bh_ & 7, b_ = bh_ >> 3; const size_t t0_ = (size_t)b_ * SEQ + n_ * RC; const int so_ = (buf) * 65536; \
                RD_STAGE(so_, Kb + t0_ * 512 + h_ * RDK, offK); RD_STAGE(so_ + 16384, ST + (size_t)(uu) * (RDV * RDK), offS); \
                RD_STAGE(so_ + 32768, VT + (size_t)(h_ * RDV) * T + t0_, offV); RD_STAGE(so_ + 49152, VT + (size_t)(h_ * RDV) * T + t0_ + 64, offV); } while (0)
            int cur = 0;
            typedef unsigned u2 __attribute__((ext_vector_type(2)));
            bf16x8 Bq[2], Bqn[2]; u2 gv[8], gvn[8];
#define RD_QG(uu, BQ, GV) do { const int n_ = (uu) & 63, bh_ = (uu) >> 6, h_ = bh_ & 7, b_ = bh_ >> 3; const size_t tk_ = (size_t)b_ * SEQ + n_ * RC + 16 * wave + fr; \
                _Pragma("unroll") for (int ks = 0; ks < 2; ++ks) BQ[ks] = *(const GAS bf16x8*)(Qb + tk_ * 512 + h_ * RDK + 32 * ks + 8 * g4); \
                _Pragma("unroll") for (int dvt = 0; dvt < 8; ++dvt) GV[dvt] = *(const GAS u2*)(SG + tk_ * 1024 + h_ * RDV + 16 * dvt + 4 * g4); } while (0)
            if (bx < NUNIT) { RD_ISSUE(bx, 0); RD_QG(bx, Bq, gv); }
            for (int u = bx; u < NUNIT; u += G, cur ^= 1) {
                const int n = u & 63, bh = u >> 6, h = bh & 7, b = bh >> 3; const size_t tok0 = (size_t)b * SEQ + n * RC; const float lg = log2g(h);
                const size_t tok = tok0 + 16 * wave + fr;
                const int un = u + G;
                if (un < NUNIT) { RD_ISSUE(un, cur ^ 1); RD_QG(un, Bqn, gvn); asm volatile("s_waitcnt vmcnt(18)" ::: "memory"); } else { asm volatile("s_waitcnt vmcnt(0)" ::: "memory"); }
                __builtin_amdgcn_s_barrier(); asm volatile("" ::: "memory");
                const LAS unsigned char* sb = lds + cur * 65536 + fo;
                f32x4 oT[8], cT[8];
#pragma unroll
                for (int dvt = 0; dvt < 8; ++dvt) { oT[dvt] = (f32x4){0.f, 0.f, 0.f, 0.f}; cT[dvt] = (f32x4){0.f, 0.f, 0.f, 0.f}; }
#pragma unroll
                for (int t2 = 0; t2 < 4; ++t2) {
                    if (2 * t2 <= wave) {
                        unsigned P[2][2];
#pragma unroll
                        for (int nn = 0; nn < 2; ++nn) { f32x4 sv = {0.f, 0.f, 0.f, 0.f};
#pragma unroll
                            for (int ks = 0; ks < 2; ++ks) { const bf16x8 Ak = *(const LAS bf16x8*)(sb + (2 * t2 + nn) * 2048 + ks * 1024);
                                sv = __builtin_amdgcn_mfma_f32_16x16x32_bf16(Ak, Bq[ks], sv, 0, 0, 0); }
                            const int dd = (16 * wave + fr) - (32 * t2 + 8 * g4 + 4 * nn);
                            const float d0 = dd >= 0 ? sv.x * __builtin_amdgcn_exp2f((float)dd * lg) : 0.f, d1 = dd >= 1 ? sv.y * __builtin_amdgcn_exp2f((float)(dd - 1) * lg) : 0.f;
                            const float d2 = dd >= 2 ? sv.z * __builtin_amdgcn_exp2f((float)(dd - 2) * lg) : 0.f, d3 = dd >= 3 ? sv.w * __builtin_amdgcn_exp2f((float)(dd - 3) * lg) : 0.f;
                            P[nn][0] = pg8::cvt_pk_bf16(d0, d1); P[nn][1] = pg8::cvt_pk_bf16(d2, d3); }
                        v4u bp; bp.x = P[0][0]; bp.y = P[0][1]; bp.z = P[1][0]; bp.w = P[1][1];
                        const bf16x8 Bp = __builtin_bit_cast(bf16x8, bp);
                        const LAS unsigned char* vb = sb + 32768 + (t2 >> 1) * 16384 + (t2 & 1) * 1024;
#pragma unroll
                        for (int dvt = 0; dvt < 8; ++dvt) { const bf16x8 Av = *(const LAS bf16x8*)(vb + dvt * 2048);
                            oT[dvt] = __builtin_amdgcn_mfma_f32_16x16x32_bf16(Av, Bp, oT[dvt], 0, 0, 0); }
                    }
                }
#pragma unroll
                for (int dvt = 0; dvt < 8; ++dvt)
#pragma unroll
                    for (int ks = 0; ks < 2; ++ks) { const bf16x8 As = *(const LAS bf16x8*)(sb + 16384 + dvt * 2048 + ks * 1024);
                        cT[dvt] = __builtin_amdgcn_mfma_f32_16x16x32_bf16(As, Bq[ks], cT[dvt], 0, 0, 0); }
                const float xi = __builtin_amdgcn_exp2f((float)(16 * wave + fr + 1) * lg);
                float sm = 0.f;
#pragma unroll
                for (int dvt = 0; dvt < 8; ++dvt) { oT[dvt] = oT[dvt] + cT[dvt] * xi; sm += (oT[dvt].x + oT[dvt].y) + (oT[dvt].z + oT[dvt].w); }
                sm += __shfl_xor(sm, 16); sm += __shfl_xor(sm, 32);
                const float mean = sm * (1.0f / 128.0f); float sq = 0.f;
#pragma unroll
                for (int dvt = 0; dvt < 8; ++dvt) { oT[dvt] = oT[dvt] - mean; sq += (oT[dvt].x * oT[dvt].x + oT[dvt].y * oT[dvt].y) + (oT[dvt].z * oT[dvt].z + oT[dvt].w * oT[dvt].w); }
                sq += __shfl_xor(sq, 16); sq += __shfl_xor(sq, 32);
                const float rstd = __builtin_amdgcn_rsqf(sq * (1.0f / 128.0f) + EPS);
#pragma unroll
                for (int dvt = 0; dvt < 8; ++dvt) { const f32x4 graw = pg8::bf_lo4(gv[dvt].x, gv[dvt].y), gf = graw * pg8::sigm4(graw);
                    const f32x4 r = oT[dvt] * rstd * gf; u2 o; o.x = pg8::cvt_pk_bf16(r.x, r.y); o.y = pg8::cvt_pk_bf16(r.z, r.w); *(GAS u2*)(RB + tok * 1024 + h * RDV + 16 * dvt + 4 * g4) = o; }
                asm volatile("s_waitcnt lgkmcnt(0)" ::: "memory"); __builtin_amdgcn_s_barrier(); asm volatile("" ::: "memory");
#pragma unroll
                for (int ks = 0; ks < 2; ++ks) Bq[ks] = Bqn[ks];
#pragma unroll
                for (int dvt = 0; dvt < 8; ++dvt) gv[dvt] = gvn[dvt];
            }
#undef RD_QG
#undef RD_ISSUE
#undef RD_STAGE
            GRID_BAR();
        }


        if (IN(PH_E)) { PHASE_VIEW(); MIX_VIEW();
            pg8::Gemm g{RB, (const bf16*)(ws + WS_WRO) + (size_t)L * D * D, T, D, D}; pg8::StaticOrder S; S.init(T, D, G, bx);
            pg8::EpiGate<true> E{SGB, MG, SC_E};
            pg8::gemm_phase<pg8::EpiGate<true>, pg8::StaticOrder, true, true>(lds + RING_OFF, g, S, E);
            GRID_BAR();
        }


        if (IN(PH_F)) { PHASE_VIEW(); MIX_VIEW();
            pg8::Gemm g{MG, (const bf16*)(ws + WS_WO) + (size_t)L * D * D, T, D, D}; pg8::StaticOrder S; S.init(T, D, G, bx);
            pg8::EpiRes<false, DENSE8> E{XBN, XB, PART, nullptr, nullptr, ws + WS_XB8, SC_F};
            pg8::gemm_phase<pg8::EpiRes<false, DENSE8>, pg8::StaticOrder, true, true>(lds + RING_OFF, g, S, E);
            GRID_BAR();
        }

        if (!moe) {

            if (IN(PH_G)) { PHASE_VIEW(); MOE_VIEW();
                pg8::Gemm g{DENSE8 ? (const bf16*)(ws + WS_XB8) : (const bf16*)XB, (const bf16*)(ws + WS_WDGU) + (size_t)jl * 2 * DFF * D, T, 2 * DFF, DENSE8 ? D / 2 : D}; pg8::StaticOrder S; S.init(T, 2 * DFF, G, bx);
                pg8::EpiSwi<false, DENSE8> E{PART, nullptr, (bf16*)(ws + WS_FA), DFF};
                pg8::gemm_phase<pg8::EpiSwi<false, DENSE8>, pg8::StaticOrder, true, true, DENSE8 ? 1 : 0>(lds + RING_OFF, g, S, E);
                GRID_BAR();
            }

            if (IN(PH_H)) { PHASE_VIEW(); MOE_VIEW();
                pg8::Gemm g{(const bf16*)(ws + WS_FA), (const bf16*)(ws + WS_WDD) + (size_t)jl * D * DFF, T, D, DENSE8 ? DFF / 2 : DFF}; pg8::StaticOrder S; S.init(T, D, G, bx, 1);
                pg8::EpiRes<false, PLE8> E{XB, XB, PART, nullptr, nullptr, ws + WS_X8F, SC_Hd * (DENSE8 ? 1.0f / 256.0f : 1.0f)};
                pg8::gemm_phase<pg8::EpiRes<false, PLE8>, pg8::StaticOrder, true, true, DENSE8 ? 1 : 0>(lds + RING_OFF, g, S, E);
                GRID_BAR();
            }
        } else {

            if (IN(PH_G)) { PHASE_VIEW(); MOE_VIEW();
                LAS float* wrT = (LAS float*)(lds + RING_OFF);
                LAS int* lcnt = (LAS int*)(lds + RING_OFF + 32768);
                const float* wr = INP(15) + (size_t)jl * D * NEXP; const float* gf = INP(11) + L * D;
                for (int i = tid; i < D * NEXP; i += 512) { const int k = i >> 3, e = i & 7; wrT[e * 1024 + k] = wr[i] * gf[k]; }
                if (tid < 8) lcnt[tid] = 0;
                __syncthreads();
                f32x4 wreg[8][4];
#pragma unroll
                for (int e = 0; e < 8; ++e)
#pragma unroll
                    for (int j = 0; j < 4; ++j) wreg[e][j] = *(const LAS f32x4*)(wrT + e * 1024 + 256 * j + 4 * lane);
                typedef unsigned u2 __attribute__((ext_vector_type(2)));
                u2 xw[4], xwn[4];
                { const GAS u2* xr = (const GAS u2*)(XB + (size_t)(bx * 128 + wave * 16) * D) + lane;
#pragma unroll
                  for (int j = 0; j < 4; ++j) xw[j] = xr[64 * j]; }
                for (int q = 0; q < 16; ++q) { const int t = bx * 128 + wave * 16 + q;
                    if (q < 15) { const GAS u2* xr = (const GAS u2*)(XB + (size_t)(t + 1) * D) + lane;
#pragma unroll
                        for (int j = 0; j < 4; ++j) xwn[j] = xr[64 * j]; }
                    f32x4 xv[4]; float ss = 0.f;
#pragma unroll
                    for (int j = 0; j < 4; ++j) { xv[j] = pg8::bf_lo4(xw[j].x, xw[j].y); ss += (xv[j].x * xv[j].x + xv[j].y * xv[j].y) + (xv[j].z * xv[j].z + xv[j].w * xv[j].w); }
                    float pa[8];
#pragma unroll
                    for (int e = 0; e < 8; ++e) { float a = 0.f;
#pragma unroll
                        for (int j = 0; j < 4; ++j) { const f32x4 w = wreg[e][j]; a += (xv[j].x * w.x + xv[j].y * w.y) + (xv[j].z * w.z + xv[j].w * w.w); }
                        pa[e] = a; }
                    float r4[4], r2[2], r1;
                    { const bool hi = (lane & 32) != 0;
#pragma unroll
                      for (int i = 0; i < 4; ++i) { const float snd = hi ? pa[i] : pa[i + 4], kp = hi ? pa[i + 4] : pa[i]; r4[i] = kp + __shfl_xor(snd, 32); } }
                    { const bool hi = (lane & 16) != 0;
#pragma unroll
                      for (int i = 0; i < 2; ++i) { const float snd = hi ? r4[i] : r4[i + 2], kp = hi ? r4[i + 2] : r4[i]; r2[i] = kp + __shfl_xor(snd, 16); } }
                    { const bool hi = (lane & 8) != 0; const float snd = hi ? r2[0] : r2[1], kp = hi ? r2[1] : r2[0]; r1 = kp + __shfl_xor(snd, 8); }
                    r1 += __shfl_xor(r1, 4); r1 += __shfl_xor(r1, 2); r1 += __shfl_xor(r1, 1);
                    float lgt[8];
#pragma unroll
                    for (int e = 0; e < 8; ++e) lgt[e] = __int_as_float(__builtin_amdgcn_readlane(__float_as_int(r1), 8 * e));
                    ss = wave_sum(ss); const float rs = __builtin_amdgcn_rsqf(ss * (1.0f / 1024.0f) + EPS);
                    int e1 = 0; float v1 = lgt[0];
#pragma unroll
                    for (int e = 1; e < 8; ++e) if (lgt[e] > v1) { v1 = lgt[e]; e1 = e; }
                    int e2 = -1; float v2 = 0.f;
#pragma unroll
                    for (int e = 0; e < 8; ++e) if (e != e1 && (e2 < 0 || lgt[e] > v2)) { v2 = lgt[e]; e2 = e; }
                    const float ex = __builtin_amdgcn_exp2f((v2 - v1) * rs * kLog2e), g1 = 1.0f / (1.0f + ex), g2 = ex * g1;
                    if (lane == 0) { tok_e[2 * t] = e1; tok_e[2 * t + 1] = e2; tok_g[2 * t] = g1; tok_g[2 * t + 1] = g2; tok_rs[t] = rs; atomicAdd((int*)&lcnt[e1], 1); atomicAdd((int*)&lcnt[e2], 1); }
#pragma unroll
                    for (int j = 0; j < 4; ++j) xw[j] = xwn[j];
                }
                __syncthreads();
                if (tid < 8) cnts[bx * 8 + tid] = lcnt[tid];
                __syncthreads();
                GRID_BAR();
            }

            if (IN(PH_H)) { PHASE_VIEW(); MOE_VIEW();
                LAS int* lc = (LAS int*)(lds + RING_OFF);
                LAS int* base = lc + 2048;
                LAS int* lslot = base + 16;
                LAS int* le = lslot + 256;
                for (int i = tid; i < 2048; i += 512) lc[i] = cnts[i];
                if (tid < 256) le[tid] = tok_e[bx * 256 + tid];
                __syncthreads();
                {
                    int tot = 0, pre = 0;
#pragma unroll
                    for (int k = 0; k < 4; ++k) { const int wg = lane + 64 * k; const int c = lc[wg * 8 + wave]; tot += c; pre += (wg < bx) ? c : 0; }
#pragma unroll
                    for (int o = 1; o < 64; o <<= 1) { tot += __shfl_xor(tot, o); pre += __shfl_xor(pre, o); }
                    if (lane == 0) { base[wave] = pre; base[8 + wave] = tot; }
                }
                __syncthreads();
                if (tid == 0) { int ps = 0; for (int e = 0; e < 8; ++e) { const int tot = base[8 + e]; base[e] += ps; const int nb = (tot + 255) >> 8;
                        if (bx == 0) { for (int q = 0; q < nb; ++q) blk[1 + (ps >> 8) + q] = e; }
                        ps += nb << 8; }
                    if (bx == 0) blk[0] = ps >> 8; }
                __syncthreads();
                {
                    int run = base[wave];
#pragma unroll
                    for (int k = 0; k < 2; ++k) { const int i = lane + 64 * k; const int a = le[2 * i], b2 = le[2 * i + 1]; const bool f = (a == wave) || (b2 == wave);
                        const unsigned long long m = __ballot(f); const int rank = __popcll(m & ((1ull << lane) - 1ull));
                        if (f) lslot[2 * i + (a == wave ? 0 : 1)] = run + rank;
                        run += __popcll(m); }
                }
                __syncthreads();
                if (tid < 256) { const int t = bx * 128 + (tid >> 1); const int s = lslot[tid]; tok_slot[bx * 256 + tid] = s; rsx[s] = tok_rs[t]; }
                for (int p = wave; p < 256; p += 8) { const int t = bx * 128 + (p >> 1), s = lslot[p];
                    const GAS v4u* src = (const GAS v4u*)(XB + (size_t)t * D) + 2 * lane; const v4u a = src[0], b4 = src[1];
                    const f32x4 f0 = pg8::bf_lo4(a.x, a.y), f1 = pg8::bf_lo4(a.z, a.w), f2 = pg8::bf_lo4(b4.x, b4.y), f3 = pg8::bf_lo4(b4.z, b4.w); v4u o;
                    o.x = (unsigned)__builtin_amdgcn_cvt_pk_fp8_f32(f0.z, f0.w, __builtin_amdgcn_cvt_pk_fp8_f32(f0.x, f0.y, 0, false), true);
                    o.y = (unsigned)__builtin_amdgcn_cvt_pk_fp8_f32(f1.z, f1.w, __builtin_amdgcn_cvt_pk_fp8_f32(f1.x, f1.y, 0, false), true);
                    o.z = (unsigned)__builtin_amdgcn_cvt_pk_fp8_f32(f2.z, f2.w, __builtin_amdgcn_cvt_pk_fp8_f32(f2.x, f2.y, 0, false), true);
                    o.w = (unsigned)__builtin_amdgcn_cvt_pk_fp8_f32(f3.z, f3.w, __builtin_amdgcn_cvt_pk_fp8_f32(f3.x, f3.y, 0, false), true);
                    *((GAS v4u*)((unsigned char*)XG + (size_t)s * D) + lane) = o; }
                __syncthreads();
                GRID_BAR();
            }

            if (IN(PH_G1)) { PHASE_VIEW(); MOE_VIEW();
                const int nblk = blk[0];
                pg8::Gemm g{XG, (const bf16*)(ws + WS_WEGU), nblk * 256, 2 * EFF, D / 2}; pg8::MoeOrder S; S.init(nblk * 256, 2 * EFF, G, bx); S.blk_e = blk + 1; S.ntile = 2 * EFF / 256;
                pg8::EpiSwi<true> E{nullptr, rsx, EA, EFF};
                pg8::gemm_phase<pg8::EpiSwi<true>, pg8::MoeOrder, true, true, 1>(lds + RING_OFF, g, S, E);
                GRID_BAR();
            }

            if (IN(PH_G2)) { PHASE_VIEW(); MOE_VIEW();
                const int nblk = blk[0];
                pg8::Gemm g{EA, (const bf16*)(ws + WS_WED), nblk * 256, D, EFF / 2}; pg8::MoeOrder S; S.init(nblk * 256, D, G, bx, 1); S.blk_e = blk + 1; S.ntile = D / 256;
                pg8::EpiStore E{XG, D, 1.0f / 256.0f};
                pg8::gemm_phase<pg8::EpiStore, pg8::MoeOrder, true, true, 1>(lds + RING_OFF, g, S, E);
                GRID_BAR();
            }

            if (IN(PH_CMB)) { PHASE_VIEW(); MOE_VIEW();
                for (int t = gw; t < T; t += NGW) {
                    const int s1 = tok_slot[2 * t], s2 = tok_slot[2 * t + 1]; const float g1 = tok_g[2 * t], g2 = tok_g[2 * t + 1];
                    typedef unsigned u2 __attribute__((ext_vector_type(2))); GAS u2* xr = (GAS u2*)(XB + (size_t)t * D) + lane;
                    const GAS u2* y1 = (const GAS u2*)(XG + (size_t)s1 * D) + lane; const GAS u2* y2 = (const GAS u2*)(XG + (size_t)s2 * D) + lane;
                    float s = 0.f;
#pragma unroll
                    for (int j = 0; j < 4; ++j) { const u2 xw = xr[64 * j]; f32x4 v = pg8::bf_lo4(xw.x, xw.y); const u2 a = y1[64 * j], b2 = y2[64 * j];
                        v = v + (pg8::bf_lo4(a.x, a.y) * g1 + pg8::bf_lo4(b2.x, b2.y) * g2) * SC_CMB; s += (v.x * v.x + v.y * v.y) + (v.z * v.z + v.w * v.w);
                        u2 o; o.x = pk2(v.x, v.y); o.y = pk2(v.z, v.w); xr[64 * j] = o;
                        if (PLE8) ((GAS unsigned*)(ws + WS_X8F + (size_t)t * D))[64 * j + lane] = (unsigned)__builtin_amdgcn_cvt_pk_fp8_f32(v.z, v.w, __builtin_amdgcn_cvt_pk_fp8_f32(v.x, v.y, 0, false), true); }
                    s = wave_sum(s);
                    if (lane < 16) PART[(size_t)t * 16 + lane] = lane == 0 ? s : 0.f;
                }
                GRID_BAR();
            }
        }


        if (IN(PH_I)) { PHASE_VIEW(); MIX_VIEW();
            bf16* PP = (bf16*)(ws + WS_PP);
            { pg8::Gemm g{(const bf16*)(ws + WS_PB) + (size_t)L * T * PLE_DIM, (const bf16*)(ws + WS_WPP) + (size_t)L * D * PLE_DIM, T, D, PLE_DIM}; pg8::StaticOrder S; S.init(T, D, G, bx);
              pg8::EpiStore E{PP, D, 1.0f};
              pg8::gemm_phase<pg8::EpiStore, pg8::StaticOrder, true, true>(lds + RING_OFF, g, S, E); }
            { pg8::Gemm g{PLE8 ? (const bf16*)(ws + WS_X8F) : (const bf16*)XB, (const bf16*)(ws + WS_WPG) + (size_t)L * D * D, T, D, PLE8 ? D / 2 : D}; pg8::StaticOrder S; S.init(T, D, G, bx);
              pg8::EpiRes<true, (L + 1 >= (A0G8 ? 1 : INPROJ8_LAYER) && L + 1 < DEPTH), PLE8> E{XB, XBN, PARTN, PART, PP, ws + WS_XBN8, SC_I};
              pg8::gemm_phase<pg8::EpiRes<true, (L + 1 >= (A0G8 ? 1 : INPROJ8_LAYER) && L + 1 < DEPTH), PLE8>, pg8::StaticOrder, true, true, PLE8 ? 1 : 0>(lds + RING_OFF, g, S, E); }
            GRID_BAR();
        }
    }
    if (2 >= l_lo && 2 < l_hi) { constexpr int L = 2;
        const bool moe = (L & 1) != 0; const int jl = L >> 1;
        constexpr bool INPROJ8 = (L >= INPROJ8_LAYER);
        constexpr bool PLE8 = (L >= PLE8_LAYER);
        constexpr bool DENSE8 = (L == 2);
#define MOE_VIEW() int* tok_e = (int*)(ws + WS_MOE + MO_TOKE); float* tok_g = (float*)(ws + WS_MOE + MO_TOKG); float* tok_rs = (float*)(ws + WS_MOE + MO_TOKRS); \
            int* tok_slot = (int*)(ws + WS_MOE + MO_SLOT); float* rsx = (float*)(ws + WS_MOE + MO_RSX); int* cnts = (int*)(ws + WS_MOE + MO_CNT); int* blk = (int*)(ws + WS_MOE + MO_BLK); \
            bf16* XG = (bf16*)(ws + WS_XG); bf16* EA = (bf16*)(ws + WS_EA); \
            (void)tok_e; (void)tok_g; (void)tok_rs; (void)tok_slot; (void)rsx; (void)cnts; (void)blk; (void)XG; (void)EA
#define MIX_VIEW() bf16* Zb = (bf16*)(ws + WS_Z); bf16* Qb = (bf16*)(ws + WS_Q); bf16* Kb = (bf16*)(ws + WS_K); bf16* KZT = (bf16*)(ws + WS_KZT); bf16* VT = (bf16*)(ws + WS_VT); \
        bf16* SG = (bf16*)(ws + WS_SG); bf16* SGA = (bf16*)(ws + WS_SGA); bf16* SGB = (bf16*)(ws + WS_SGB); bf16* Cb = (bf16*)(ws + WS_C); \
        float* KVT = (float*)(ws + WS_KVT); bf16* RB = (bf16*)(ws + WS_KVT); bf16* ST = (bf16*)(ws + WS_ST); bf16* MG = (bf16*)(ws + WS_MG); (void)RB; \
        (void)Zb; (void)Qb; (void)Kb; (void)KZT; (void)VT; (void)SG; (void)SGA; (void)SGB; (void)Cb; (void)KVT; (void)ST; (void)MG


        if (IN(PH_A)) { PHASE_VIEW(); MIX_VIEW();
            static_assert(WS_K - WS_Q == 2 * pg8::EpiIn::QK_STRIDE && WS_SGA - WS_SG == 2 * pg8::EpiIn::G_STRIDE && WS_SGB - WS_SGA == 2 * pg8::EpiIn::G_STRIDE, "EpiIn strides");
            if constexpr (L < 2 && A0G8 && !INPROJ8) {
              { pg8::Gemm g{(const bf16*)XBN, (const bf16*)(ws + WS_WIN) + (size_t)L * 5120 * D, T, 2048, D}; pg8::StaticOrder S; S.init(T, 2048, G, bx);
                pg8::EpiIn E{PARTN, (const float*)(ws + WS_COS), (const float*)(ws + WS_SIN), Zb, Qb, SG, 1.0f, 0};
                pg8::gemm_phase<pg8::EpiIn, pg8::StaticOrder, true, true, 0>(lds + RING_OFF, g, S, E); }
              { pg8::Gemm g{(const bf16*)(ws + WS_XBN8), (const bf16*)(ws + WS_WIN8G0 + (size_t)L * WS_WIN8G_STEP), T, 3072, D / 2}; pg8::StaticOrder S; S.init(T, 3072, G, bx);
                pg8::EpiIn E{PARTN, (const float*)(ws + WS_COS), (const float*)(ws + WS_SIN), Zb, Qb, SG, 1.0f / 64.0f, 8};
                pg8::gemm_phase<pg8::EpiIn, pg8::StaticOrder, true, true, 1>(lds + RING_OFF, g, S, E); }
            } else
            { pg8::Gemm g{INPROJ8 ? (const bf16*)(ws + WS_XBN8) : (const bf16*)XBN, (const bf16*)(ws + WS_WIN) + (size_t)L * 5120 * D, T, 5120, INPROJ8 ? D / 2 : D}; pg8::StaticOrder S; S.init(T, 5120, G, bx);
              pg8::EpiIn E{PARTN, (const float*)(ws + WS_COS), (const float*)(ws + WS_SIN), Zb, Qb, SG, INPROJ8 ? 1.0f / 64.0f : 1.0f, 0};
              pg8::gemm_phase<pg8::EpiIn, pg8::StaticOrder, true, true, INPROJ8 ? 1 : 0>(lds + RING_OFF, g, S, E); }

            { pg8::Gemm g{(const bf16*)(ws + WS_WKVT) + (size_t)L * 1536 * D, INPROJ8 ? (const bf16*)(ws + WS_XBN8) : (const bf16*)XBN, 1536, T, INPROJ8 ? D / 2 : D}; pg8::StaticOrder S; S.init(1536, T, G, bx);
              pg8::EpiKvT E{PARTN, (const float*)(ws + WS_COST), (const float*)(ws + WS_SINT), KZT, VT, INPROJ8 ? 1.0f / 64.0f : 1.0f};
              pg8::gemm_phase<pg8::EpiKvT, pg8::StaticOrder, true, true, INPROJ8 ? 1 : 0>(lds + RING_OFF, g, S, E); }
            GRID_BAR();
        }


        if (IN(PH_B)) { PHASE_VIEW(); MIX_VIEW();

            {
                const float* cw = INP(4) + (size_t)L * CONV_W * CONV_DIM; const float* cb = INP(5) + L * CONV_DIM;
                const float* lg = INP(6) + L * CONV_DIM; const float* lb = INP(7) + L * CONV_DIM;
                LAS unsigned* zt = (LAS unsigned*)(lds + RING_OFF);
                LAS float* ot = (LAS float*)(lds + RING_OFF + 65536);
                const int cp = tid & 255, half = tid >> 8;
                float w0[CONV_W], w1[CONV_W];
#pragma unroll
                for (int w = 0; w < CONV_W; ++w) { w0[w] = cw[w * CONV_DIM + 2 * cp]; w1[w] = cw[w * CONV_DIM + 2 * cp + 1]; }
                const float b0 = cb[2 * cp], b1 = cb[2 * cp + 1];
                f32x4 lg0 = *(const f32x4*)(lg + 8 * lane), lg1 = *(const f32x4*)(lg + 8 * lane + 4), lb0 = *(const f32x4*)(lb + 8 * lane), lb1 = *(const f32x4*)(lb + 8 * lane + 4);
                for (int u = bx; u < T / 32; u += G) {
                    const int tok0 = u * 32, pos0 = tok0 & (SEQ - 1);
                    for (int idx = tid; idx < 62 * 64; idx += 512) { const int r = idx >> 6, ch = idx & 63; const int pos = pos0 - 30 + r;
                        v4u v = {0u, 0u, 0u, 0u}; if (pos >= 0) v = *(const GAS v4u*)(Zb + (size_t)(tok0 - 30 + r) * CONV_DIM + ch * 8);
                        *(LAS v4u*)(zt + r * 256 + ch * 4) = v; }
                    __syncthreads();
#pragma unroll 1
                    for (int tg = 0; tg < 2; ++tg) { const int tb = 16 * half + 8 * tg;
                        float a0[8], a1[8];
#pragma unroll
                        for (int q = 0; q < 8; ++q) { a0[q] = b0; a1[q] = b1; }
#pragma unroll
                        for (int r = 0; r < 38; ++r) { const unsigned pv = zt[(tb + r) * 256 + cp]; const float f0 = __uint_as_float(pv << 16), f1 = __uint_as_float(pv & 0xffff0000u);
#pragma unroll
                            for (int q = 0; q < 8; ++q) { const int w = r - q; if (w >= 0 && w < CONV_W) { a0[q] = fmaf(w0[w], f0, a0[q]); a1[q] = fmaf(w1[w], f1, a1[q]); } } }
#pragma unroll
                        for (int q = 0; q < 8; ++q) { typedef float f2 __attribute__((ext_vector_type(2))); *(LAS f2*)(ot + (tb + q) * 512 + 2 * cp) = (f2){a0[q], a1[q]}; } }
                    __syncthreads();
#pragma unroll 1
                    for (int q = 0; q < 4; ++q) { const int tk = 4 * wave + q; const LAS f32x4* op = (const LAS f32x4*)(ot + tk * 512 + 8 * lane); f32x4 v0 = op[0], v1 = op[1];
                        const float mean = wave_sum((v0.x + v0.y) + (v0.z + v0.w) + (v1.x + v1.y) + (v1.z + v1.w)) * (1.0f / 512.0f);
                        v0 = v0 - mean; v1 = v1 - mean;
                        const float var = wave_sum((v0.x * v0.x + v0.y * v0.y) + (v0.z * v0.z + v0.w * v0.w) + (v1.x * v1.x + v1.y * v1.y) + (v1.z * v1.z + v1.w * v1.w)) * (1.0f / 512.0f);
                        const float rstd = __builtin_amdgcn_rsqf(var + EPS);
                        v0 = v0 * rstd * lg0 + lb0; v1 = v1 * rstd * lg1 + lb1;
                        v0 = v0 * pg8::sigm4(v0); v1 = v1 * pg8::sigm4(v1);
                        *(GAS v4u*)(Cb + (size_t)(tok0 + tk) * CONV_DIM + 8 * lane) = pg8::pack8(v0, v1); }
                    __syncthreads();
                }
            }

            {
                const int fr = lane & 15, g4 = lane >> 4;
                for (int u = bx; u < NUNIT; u += G) {
                    const int n = u & 63, bh = u >> 6, h = bh & 7, b = bh >> 3; const size_t tok0 = (size_t)b * SEQ + n * RC;
                    bf16x8 Bv[4], Ak[4][4];
#pragma unroll
                    for (int ks = 0; ks < 4; ++ks) Bv[ks] = *(const GAS bf16x8*)(VT + (size_t)(h * RDV + 16 * wave + fr) * T + tok0 + 32 * ks + 8 * g4);
#pragma unroll
                    for (int dkt = 0; dkt < 4; ++dkt)
#pragma unroll
                        for (int ks = 0; ks < 4; ++ks) Ak[dkt][ks] = *(const GAS bf16x8*)(KZT + (size_t)(h * RDK + 16 * dkt + fr) * T + tok0 + 32 * ks + 8 * g4);
                    f32x4 acc4[4];
#pragma unroll
                    for (int dkt = 0; dkt < 4; ++dkt) { acc4[dkt] = (f32x4){0.f, 0.f, 0.f, 0.f};
#pragma unroll
                        for (int ks = 0; ks < 4; ++ks) acc4[dkt] = __builtin_amdgcn_mfma_f32_16x16x32_bf16(Ak[dkt][ks], Bv[ks], acc4[dkt], 0, 0, 0); }
#pragma unroll
                    for (int dkt = 0; dkt < 4; ++dkt) { typedef unsigned u2 __attribute__((ext_vector_type(2))); u2 o; o.x = pk2(acc4[dkt].x, acc4[dkt].y); o.y = pk2(acc4[dkt].z, acc4[dkt].w);
                        *(GAS u2*)((bf16*)KVT + (size_t)u * (RDV * RDK) + (16 * wave + fr) * RDK + 16 * dkt + 4 * g4) = o; }
                }
            }

            if (moe) {
                __syncthreads();
                LAS float* scr = (LAS float*)(lds + RING_OFF + wave * 16384);
                constexpr int I_GU = 16 * 112, I_DN = 56 * 16, I_EXP = I_GU + I_DN;
                for (int it = gw; it < NEXP * I_EXP; it += NGW) { const int e = it / I_EXP, r = it % I_EXP; const size_t o = ((size_t)jl * NEXP + e) * D * EFF;
                    if (r < I_GU) conv_item<true>(INP(16) + o, INP(17) + o, INP(11) + L * D, (bf16*)(ws + WS_WEGU + (size_t)e * 2 * EFF * D), EFF, D, 112, 3, r, scr, lane);
                    else conv_item<true>(INP(18) + o, nullptr, nullptr, (bf16*)(ws + WS_WED + (size_t)e * D * EFF), D, EFF, 16, 0, r - I_GU, scr, lane); }
            }
            GRID_BAR();
        }


        if (IN(PH_C)) { PHASE_VIEW(); MIX_VIEW();
            {   const int gt = bx * 512 + tid;
                if (gt < 32 * 4096) { const int bh = gt >> 12, e2 = gt & 4095, h = bh & 7; const float gc = __builtin_amdgcn_exp2f(128.0f * log2g(h));
                    float s0 = 0.f, s1 = 0.f; typedef float f2 __attribute__((ext_vector_type(2)));
                    const GAS unsigned* kv = (const GAS unsigned*)((const bf16*)KVT + (size_t)bh * NCH * (RDV * RDK)) + e2; GAS unsigned* st = (GAS unsigned*)(ST + (size_t)bh * NCH * (RDV * RDK)) + e2;
                    unsigned wv[NCH];
#pragma unroll
                    for (int n = 0; n < NCH; ++n) wv[n] = kv[(size_t)n * 4096];
#pragma unroll
                    for (int n = 0; n < NCH; ++n) { const unsigned w = wv[n]; st[(size_t)n * 4096] = pk2(s0, s1); s0 = fmaf(gc, s0, __uint_as_float(w << 16)); s1 = fmaf(gc, s1, __uint_as_float(w & 0xffff0000u)); } }
            }
            { pg8::Gemm g{Cb, (const bf16*)(ws + WS_WCO) + (size_t)L * D * CONV_DIM, T, D, CONV_DIM}; pg8::StaticOrder S; S.init(T, D, G, bx);
              pg8::EpiGate<false> E{SGA, MG, 1.0f};
              pg8::gemm_phase<pg8::EpiGate<false>, pg8::StaticOrder, true, true>(lds + RING_OFF, g, S, E); }
            GRID_BAR();
        }


        if (IN(PH_D)) { PHASE_VIEW(); MIX_VIEW();
            const int fr = lane & 15, g4 = lane >> 4;
            unsigned offK[2], offS[2], offV[2];
#pragma unroll
            for (int i = 0; i < 2; ++i) { int R, C; pg8::stage_rc(tid * 16 + i * 8192, R, C); const int Rp = (R & ~31) + pg8::perm32(R & 31);
                offK[i] = (unsigned)(Rp * 512 + C) * 2u; offS[i] = (unsigned)(R * 64 + C) * 2u; offV[i] = (unsigned)R * (unsigned)(T * 2) + (unsigned)C * 2u; }
            const unsigned ldsw = (unsigned)wave * 1024u; const int fo = pg8::lds_byte(fr, g4 * 8);
#define RD_STAGE(bufoff, gbase, voff) do { _Pragma("unroll") for (int _i = 0; _i < 2; ++_i) \
                __builtin_amdgcn_global_load_lds((const unsigned*)((const char*)(gbase) + (voff)[_i]), (LAS unsigned*)(lds + (bufoff) + ldsw + _i * 8192), 16, 0, 0); } while (0)
#define RD_ISSUE(uu, buf) do { const int n_ = (uu) & 63, bh_ = (uu) >> 6, h_ = bh_ & 7, b_ = bh_ >> 3; const size_t t0_ = (size_t)b_ * SEQ + n_ * RC; const int so_ = (buf) * 65536; \
                RD_STAGE(so_, Kb + t0_ * 512 + h_ * RDK, offK); RD_STAGE(so_ + 16384, ST + (size_t)(uu) * (RDV * RDK), offS); \
                RD_STAGE(so_ + 32768, VT + (size_t)(h_ * RDV) * T + t0_, offV); RD_STAGE(so_ + 49152, VT + (size_t)(h_ * RDV) * T + t0_ + 64, offV); } while (0)
            int cur = 0;
            typedef unsigned u2 __attribute__((ext_vector_type(2)));
            bf16x8 Bq[2], Bqn[2]; u2 gv[8], gvn[8];
#define RD_QG(uu, BQ, GV) do { const int n_ = (uu) & 63, bh_ = (uu) >> 6, h_ = bh_ & 7, b_ = bh_ >> 3; const size_t tk_ = (size_t)b_ * SEQ + n_ * RC + 16 * wave + fr; \
                _Pragma("unroll") for (int ks = 0; ks < 2; ++ks) BQ[ks] = *(const GAS bf16x8*)(Qb + tk_ * 512 + h_ * RDK + 32 * ks + 8 * g4); \
                _Pragma("unroll") for (int dvt = 0; dvt < 8; ++dvt) GV[dvt] = *(const GAS u2*)(SG + tk_ * 1024 + h_ * RDV + 16 * dvt + 4 * g4); } while (0)
            if (bx < NUNIT) { RD_ISSUE(bx, 0); RD_QG(bx, Bq, gv); }
            for (int u = bx; u < NUNIT; u += G, cur ^= 1) {
                const int n = u & 63, bh = u >> 6, h = bh & 7, b = bh >> 3; const size_t tok0 = (size_t)b * SEQ + n * RC; const float lg = log2g(h);
                const size_t tok = tok0 + 16 * wave + fr;
                const int un = u + G;
                if (un < NUNIT) { RD_ISSUE(un, cur ^ 1); RD_QG(un, Bqn, gvn); asm volatile("s_waitcnt vmcnt(18)" ::: "memory"); } else { asm volatile("s_waitcnt vmcnt(0)" ::: "memory"); }
                __builtin_amdgcn_s_barrier(); asm volatile("" ::: "memory");
                const LAS unsigned char* sb = lds + cur * 65536 + fo;
                f32x4 oT[8], cT[8];
#pragma unroll
                for (int dvt = 0; dvt < 8; ++dvt) { oT[dvt] = (f32x4){0.f, 0.f, 0.f, 0.f}; cT[dvt] = (f32x4){0.f, 0.f, 0.f, 0.f}; }
#pragma unroll
                for (int t2 = 0; t2 < 4; ++t2) {
                    if (2 * t2 <= wave) {
                        unsigned P[2][2];
#pragma unroll
                        for (int nn = 0; nn < 2; ++nn) { f32x4 sv = {0.f, 0.f, 0.f, 0.f};
#pragma unroll
                            for (int ks = 0; ks < 2; ++ks) { const bf16x8 Ak = *(const LAS bf16x8*)(sb + (2 * t2 + nn) * 2048 + ks * 1024);
                                sv = __builtin_amdgcn_mfma_f32_16x16x32_bf16(Ak, Bq[ks], sv, 0, 0, 0); }
                            const int dd = (16 * wave + fr) - (32 * t2 + 8 * g4 + 4 * nn);
                            const float d0 = dd >= 0 ? sv.x * __builtin_amdgcn_exp2f((float)dd * lg) : 0.f, d1 = dd >= 1 ? sv.y * __builtin_amdgcn_exp2f((float)(dd - 1) * lg) : 0.f;
                            const float d2 = dd >= 2 ? sv.z * __builtin_amdgcn_exp2f((float)(dd - 2) * lg) : 0.f, d3 = dd >= 3 ? sv.w * __builtin_amdgcn_exp2f((float)(dd - 3) * lg) : 0.f;
                            P[nn][0] = pg8::cvt_pk_bf16(d0, d1); P[nn][1] = pg8::cvt_pk_bf16(d2, d3); }
                        v4u bp; bp.x = P[0][0]; bp.y = P[0][1]; bp.z = P[1][0]; bp.w = P[1][1];
                        const bf16x8 Bp = __builtin_bit_cast(bf16x8, bp);
                        const LAS unsigned char* vb = sb + 32768 + (t2 >> 1) * 16384 + (t2 & 1) * 1024;
#pragma unroll
                        for (int dvt = 0; dvt < 8; ++dvt) { const bf16x8 Av = *(const LAS bf16x8*)(vb + dvt * 2048);
                            oT[dvt] = __builtin_amdgcn_mfma_f32_16x16x32_bf16(Av, Bp, oT[dvt], 0, 0, 0); }
                    }
                }
#pragma unroll
                for (int dvt = 0; dvt < 8; ++dvt)
#pragma unroll
                    for (int ks = 0; ks < 2; ++ks) { const bf16x8 As = *(const LAS bf16x8*)(sb + 16384 + dvt * 2048 + ks * 1024);
                        cT[dvt] = __builtin_amdgcn_mfma_f32_16x16x32_bf16(As, Bq[ks], cT[dvt], 0, 0, 0); }
                const float xi = __builtin_amdgcn_exp2f((float)(16 * wave + fr + 1) * lg);
                float sm = 0.f;
#pragma unroll
                for (int dvt = 0; dvt < 8; ++dvt) { oT[dvt] = oT[dvt] + cT[dvt] * xi; sm += (oT[dvt].x + oT[dvt].y) + (oT[dvt].z + oT[dvt].w); }
                sm += __shfl_xor(sm, 16); sm += __shfl_xor(sm, 32);
                const float mean = sm * (1.0f / 128.0f); float sq = 0.f;
#pragma unroll
                for (int dvt = 0; dvt < 8; ++dvt) { oT[dvt] = oT[dvt] - mean; sq += (oT[dvt].x * oT[dvt].x + oT[dvt].y * oT[dvt].y) + (oT[dvt].z * oT[dvt].z + oT[dvt].w * oT[dvt].w); }
                sq += __shfl_xor(sq, 16); sq += __shfl_xor(sq, 32);
                const float rstd = __builtin_amdgcn_rsqf(sq * (1.0f / 128.0f) + EPS);
#pragma unroll
                for (int dvt = 0; dvt < 8; ++dvt) { const f32x4 graw = pg8::bf_lo4(gv[dvt].x, gv[dvt].y), gf = graw * pg8::sigm4(graw);
                    const f32x4 r = oT[dvt] * rstd * gf; u2 o; o.x = pg8::cvt_pk_bf16(r.x, r.y); o.y = pg8::cvt_pk_bf16(r.z, r.w); *(GAS u2*)(RB + tok * 1024 + h * RDV + 16 * dvt + 4 * g4) = o; }
                asm volatile("s_waitcnt lgkmcnt(0)" ::: "memory"); __builtin_amdgcn_s_barrier(); asm volatile("" ::: "memory");
#pragma unroll
                for (int ks = 0; ks < 2; ++ks) Bq[ks] = Bqn[ks];
#pragma unroll
                for (int dvt = 0; dvt < 8; ++dvt) gv[dvt] = gvn[dvt];
            }
#undef RD_QG
#undef RD_ISSUE
#undef RD_STAGE
            GRID_BAR();
        }


        if (IN(PH_E)) { PHASE_VIEW(); MIX_VIEW();
            pg8::Gemm g{RB, (const bf16*)(ws + WS_WRO) + (size_t)L * D * D, T, D, D}; pg8::StaticOrder S; S.init(T, D, G, bx);
            pg8::EpiGate<true> E{SGB, MG, SC_E};
            pg8::gemm_phase<pg8::EpiGate<true>, pg8::StaticOrder, true, true>(lds + RING_OFF, g, S, E);
            GRID_BAR();
        }


        if (IN(PH_F)) { PHASE_VIEW(); MIX_VIEW();
            pg8::Gemm g{MG, (const bf16*)(ws + WS_WO) + (size_t)L * D * D, T, D, D}; pg8::StaticOrder S; S.init(T, D, G, bx);
            pg8::EpiRes<false, DENSE8> E{XBN, XB, PART, nullptr, nullptr, ws + WS_XB8, SC_F};
            pg8::gemm_phase<pg8::EpiRes<false, DENSE8>, pg8::StaticOrder, true, true>(lds + RING_OFF, g, S, E);
            GRID_BAR();
        }

        if (!moe) {

            if (IN(PH_G)) { PHASE_VIEW(); MOE_VIEW();
                pg8::Gemm g{DENSE8 ? (const bf16*)(ws + WS_XB8) : (const bf16*)XB, (const bf16*)(ws + WS_WDGU) + (size_t)jl * 2 * DFF * D, T, 2 * DFF, DENSE8 ? D / 2 : D}; pg8::StaticOrder S; S.init(T, 2 * DFF, G, bx);
                pg8::EpiSwi<false, DENSE8> E{PART, nullptr, (bf16*)(ws + WS_FA), DFF};
                pg8::gemm_phase<pg8::EpiSwi<false, DENSE8>, pg8::StaticOrder, true, true, DENSE8 ? 1 : 0>(lds + RING_OFF, g, S, E);
                GRID_BAR();
            }

            if (IN(PH_H)) { PHASE_VIEW(); MOE_VIEW();
                pg8::Gemm g{(const bf16*)(ws + WS_FA), (const bf16*)(ws + WS_WDD) + (size_t)jl * D * DFF, T, D, DENSE8 ? DFF / 2 : DFF}; pg8::StaticOrder S; S.init(T, D, G, bx, 1);
                pg8::EpiRes<false, PLE8> E{XB, XB, PART, nullptr, nullptr, ws + WS_X8F, SC_Hd * (DENSE8 ? 1.0f / 256.0f : 1.0f)};
                pg8::gemm_phase<pg8::EpiRes<false, PLE8>, pg8::StaticOrder, true, true, DENSE8 ? 1 : 0>(lds + RING_OFF, g, S, E);
                GRID_BAR();
            }
        } else {

            if (IN(PH_G)) { PHASE_VIEW(); MOE_VIEW();
                LAS float* wrT = (LAS float*)(lds + RING_OFF);
                LAS int* lcnt = (LAS int*)(lds + RING_OFF + 32768);
                const float* wr = INP(15) + (size_t)jl * D * NEXP; const float* gf = INP(11) + L * D;
                for (int i = tid; i < D * NEXP; i += 512) { const int k = i >> 3, e = i & 7; wrT[e * 1024 + k] = wr[i] * gf[k]; }
                if (tid < 8) lcnt[tid] = 0;
                __syncthreads();
                f32x4 wreg[8][4];
#pragma unroll
                for (int e = 0; e < 8; ++e)
#pragma unroll
                    for (int j = 0; j < 4; ++j) wreg[e][j] = *(const LAS f32x4*)(wrT + e * 1024 + 256 * j + 4 * lane);
                typedef unsigned u2 __attribute__((ext_vector_type(2)));
                u2 xw[4], xwn[4];
                { const GAS u2* xr = (const GAS u2*)(XB + (size_t)(bx * 128 + wave * 16) * D) + lane;
#pragma unroll
                  for (int j = 0; j < 4; ++j) xw[j] = xr[64 * j]; }
                for (int q = 0; q < 16; ++q) { const int t = bx * 128 + wave * 16 + q;
                    if (q < 15) { const GAS u2* xr = (const GAS u2*)(XB + (size_t)(t + 1) * D) + lane;
#pragma unroll
                        for (int j = 0; j < 4; ++j) xwn[j] = xr[64 * j]; }
                    f32x4 xv[4]; float ss = 0.f;
#pragma unroll
                    for (int j = 0; j < 4; ++j) { xv[j] = pg8::bf_lo4(xw[j].x, xw[j].y); ss += (xv[j].x * xv[j].x + xv[j].y * xv[j].y) + (xv[j].z * xv[j].z + xv[j].w * xv[j].w); }
                    float pa[8];
#pragma unroll
                    for (int e = 0; e < 8; ++e) { float a = 0.f;
#pragma unroll
                        for (int j = 0; j < 4; ++j) { const f32x4 w = wreg[e][j]; a += (xv[j].x * w.x + xv[j].y * w.y) + (xv[j].z * w.z + xv[j].w * w.w); }
                        pa[e] = a; }
                    float r4[4], r2[2], r1;
                    { const bool hi = (lane & 32) != 0;
#pragma unroll
                      for (int i = 0; i < 4; ++i) { const float snd = hi ? pa[i] : pa[i + 4], kp = hi ? pa[i + 4] : pa[i]; r4[i] = kp + __shfl_xor(snd, 32); } }
                    { const bool hi = (lane & 16) != 0;
#pragma unroll
                      for (int i = 0; i < 2; ++i) { const float snd = hi ? r4[i] : r4[i + 2], kp = hi ? r4[i + 2] : r4[i]; r2[i] = kp + __shfl_xor(snd, 16); } }
                    { const bool hi = (lane & 8) != 0; const float snd = hi ? r2[0] : r2[1], kp = hi ? r2[1] : r2[0]; r1 = kp + __shfl_xor(snd, 8); }
                    r1 += __shfl_xor(r1, 4); r1 += __shfl_xor(r1, 2); r1 += __shfl_xor(r1, 1);
                    float lgt[8];
#pragma unroll
                    for (int e = 0; e < 8; ++e) lgt[e] = __int_as_float(__builtin_amdgcn_readlane(__float_as_int(r1), 8 * e));
                    ss = wave_sum(ss); const float rs = __builtin_amdgcn_rsqf(ss * (1.0f / 1024.0f) + EPS);
                    int e1 = 0; float v1 = lgt[0];
#pragma unroll
                    for (int e = 1; e < 8; ++e) if (lgt[e] > v1) { v1 = lgt[e]; e1 = e; }
                    int e2 = -1; float v2 = 0.f;
#pragma unroll
                    for (int e = 0; e < 8; ++e) if (e != e1 && (e2 < 0 || lgt[e] > v2)) { v2 = lgt[e]; e2 = e; }
                    const float ex = __builtin_amdgcn_exp2f((v2 - v1) * rs * kLog2e), g1 = 1.0f / (1.0f + ex), g2 = ex * g1;
                    if (lane == 0) { tok_e[2 * t] = e1; tok_e[2 * t + 1] = e2; tok_g[2 * t] = g1; tok_g[2 * t + 1] = g2; tok_rs[t] = rs; atomicAdd((int*)&lcnt[e1], 1); atomicAdd((int*)&lcnt[e2], 1); }
#pragma unroll
                    for (int j = 0; j < 4; ++j) xw[j] = xwn[j];
                }
                __syncthreads();
                if (tid < 8) cnts[bx * 8 + tid] = lcnt[tid];
                __syncthreads();
                GRID_BAR();
            }

            if (IN(PH_H)) { PHASE_VIEW(); MOE_VIEW();
                LAS int* lc = (LAS int*)(lds + RING_OFF);
                LAS int* base = lc + 2048;
                LAS int* lslot = base + 16;
                LAS int* le = lslot + 256;
                for (int i = tid; i < 2048; i += 512) lc[i] = cnts[i];
                if (tid < 256) le[tid] = tok_e[bx * 256 + tid];
                __syncthreads();
                {
                    int tot = 0, pre = 0;
#pragma unroll
                    for (int k = 0; k < 4; ++k) { const int wg = lane + 64 * k; const int c = lc[wg * 8 + wave]; tot += c; pre += (wg < bx) ? c : 0; }
#pragma unroll
                    for (int o = 1; o < 64; o <<= 1) { tot += __shfl_xor(tot, o); pre += __shfl_xor(pre, o); }
                    if (lane == 0) { base[wave] = pre; base[8 + wave] = tot; }
                }
                __syncthreads();
                if (tid == 0) { int ps = 0; for (int e = 0; e < 8; ++e) { const int tot = base[8 + e]; base[e] += ps; const int nb = (tot + 255) >> 8;
                        if (bx == 0) { for (int q = 0; q < nb; ++q) blk[1 + (ps >> 8) + q] = e; }
                        ps += nb << 8; }
                    if (bx == 0) blk[0] = ps >> 8; }
                __syncthreads();
                {
                    int run = base[wave];
#pragma unroll
                    for (int k = 0; k < 2; ++k) { const int i = lane + 64 * k; const int a = le[2 * i], b2 = le[2 * i + 1]; const bool f = (a == wave) || (b2 == wave);
                        const unsigned long long m = __ballot(f); const int rank = __popcll(m & ((1ull << lane) - 1ull));
                        if (f) lslot[2 * i + (a == wave ? 0 : 1)] = run + rank;
                        run += __popcll(m); }
                }
                __syncthreads();
                if (tid < 256) { const int t = bx * 128 + (tid >> 1); const int s = lslot[tid]; tok_slot[bx * 256 + tid] = s; rsx[s] = tok_rs[t]; }
                for (int p = wave; p < 256; p += 8) { const int t = bx * 128 + (p >> 1), s = lslot[p];
                    const GAS v4u* src = (const GAS v4u*)(XB + (size_t)t * D) + 2 * lane; const v4u a = src[0], b4 = src[1];
                    const f32x4 f0 = pg8::bf_lo4(a.x, a.y), f1 = pg8::bf_lo4(a.z, a.w), f2 = pg8::bf_lo4(b4.x, b4.y), f3 = pg8::bf_lo4(b4.z, b4.w); v4u o;
                    o.x = (unsigned)__builtin_amdgcn_cvt_pk_fp8_f32(f0.z, f0.w, __builtin_amdgcn_cvt_pk_fp8_f32(f0.x, f0.y, 0, false), true);
                    o.y = (unsigned)__builtin_amdgcn_cvt_pk_fp8_f32(f1.z, f1.w, __builtin_amdgcn_cvt_pk_fp8_f32(f1.x, f1.y, 0, false), true);
                    o.z = (unsigned)__builtin_amdgcn_cvt_pk_fp8_f32(f2.z, f2.w, __builtin_amdgcn_cvt_pk_fp8_f32(f2.x, f2.y, 0, false), true);
                    o.w = (unsigned)__builtin_amdgcn_cvt_pk_fp8_f32(f3.z, f3.w, __builtin_amdgcn_cvt_pk_fp8_f32(f3.x, f3.y, 0, false), true);
                    *((GAS v4u*)((unsigned char*)XG + (size_t)s * D) + lane) = o; }
                __syncthreads();
                GRID_BAR();
            }

            if (IN(PH_G1)) { PHASE_VIEW(); MOE_VIEW();
                const int nblk = blk[0];
                pg8::Gemm g{XG, (const bf16*)(ws + WS_WEGU), nblk * 256, 2 * EFF, D / 2}; pg8::MoeOrder S; S.init(nblk * 256, 2 * EFF, G, bx); S.blk_e = blk + 1; S.ntile = 2 * EFF / 256;
                pg8::EpiSwi<true> E{nullptr, rsx, EA, EFF};
                pg8::gemm_phase<pg8::EpiSwi<true>, pg8::MoeOrder, true, true, 1>(lds + RING_OFF, g, S, E);
                GRID_BAR();
            }

            if (IN(PH_G2)) { PHASE_VIEW(); MOE_VIEW();
                const int nblk = blk[0];
                pg8::Gemm g{EA, (const bf16*)(ws + WS_WED), nblk * 256, D, EFF / 2}; pg8::MoeOrder S; S.init(nblk * 256, D, G, bx, 1); S.blk_e = blk + 1; S.ntile = D / 256;
                pg8::EpiStore E{XG, D, 1.0f / 256.0f};
                pg8::gemm_phase<pg8::EpiStore, pg8::MoeOrder, true, true, 1>(lds + RING_OFF, g, S, E);
                GRID_BAR();
            }

            if (IN(PH_CMB)) { PHASE_VIEW(); MOE_VIEW();
                for (int t = gw; t < T; t += NGW) {
                    const int s1 = tok_slot[2 * t], s2 = tok_slot[2 * t + 1]; const float g1 = tok_g[2 * t], g2 = tok_g[2 * t + 1];
                    typedef unsigned u2 __attribute__((ext_vector_type(2))); GAS u2* xr = (GAS u2*)(XB + (size_t)t * D) + lane;
                    const GAS u2* y1 = (const GAS u2*)(XG + (size_t)s1 * D) + lane; const GAS u2* y2 = (const GAS u2*)(XG + (size_t)s2 * D) + lane;
                    float s = 0.f;
#pragma unroll
                    for (int j = 0; j < 4; ++j) { const u2 xw = xr[64 * j]; f32x4 v = pg8::bf_lo4(xw.x, xw.y); const u2 a = y1[64 * j], b2 = y2[64 * j];
                        v = v + (pg8::bf_lo4(a.x, a.y) * g1 + pg8::bf_lo4(b2.x, b2.y) * g2) * SC_CMB; s += (v.x * v.x + v.y * v.y) + (v.z * v.z + v.w * v.w);
                        u2 o; o.x = pk2(v.x, v.y); o.y = pk2(v.z, v.w); xr[64 * j] = o;
                        if (PLE8) ((GAS unsigned*)(ws + WS_X8F + (size_t)t * D))[64 * j + lane] = (unsigned)__builtin_amdgcn_cvt_pk_fp8_f32(v.z, v.w, __builtin_amdgcn_cvt_pk_fp8_f32(v.x, v.y, 0, false), true); }
                    s = wave_sum(s);
                    if (lane < 16) PART[(size_t)t * 16 + lane] = lane == 0 ? s : 0.f;
                }
                GRID_BAR();
            }
        }


        if (IN(PH_I)) { PHASE_VIEW(); MIX_VIEW();
            bf16* PP = (bf16*)(ws + WS_PP);
            { pg8::Gemm g{(const bf16*)(ws + WS_PB) + (size_t)L * T * PLE_DIM, (const bf16*)(ws + WS_WPP) + (size_t)L * D * PLE_DIM, T, D, PLE_DIM}; pg8::StaticOrder S; S.init(T, D, G, bx);
              pg8::EpiStore E{PP, D, 1.0f};
              pg8::gemm_phase<pg8::EpiStore, pg8::StaticOrder, true, true>(lds + RING_OFF, g, S, E); }
            { pg8::Gemm g{PLE8 ? (const bf16*)(ws + WS_X8F) : (const bf16*)XB, (const bf16*)(ws + WS_WPG) + (size_t)L * D * D, T, D, PLE8 ? D / 2 : D}; pg8::StaticOrder S; S.init(T, D, G, bx);
              pg8::EpiRes<true, (L + 1 >= (A0G8 ? 1 : INPROJ8_LAYER) && L + 1 < DEPTH), PLE8> E{XB, XBN, PARTN, PART, PP, ws + WS_XBN8, SC_I};
              pg8::gemm_phase<pg8::EpiRes<true, (L + 1 >= (A0G8 ? 1 : INPROJ8_LAYER) && L + 1 < DEPTH), PLE8>, pg8::StaticOrder, true, true, PLE8 ? 1 : 0>(lds + RING_OFF, g, S, E); }
            GRID_BAR();
        }
    }
    if (3 >= l_lo && 3 < l_hi) { constexpr int L = 3;
        const bool moe = (L & 1) != 0; const int jl = L >> 1;
        constexpr bool INPROJ8 = (L >= INPROJ8_LAYER);
        constexpr bool PLE8 = (L >= PLE8_LAYER);
        constexpr bool DENSE8 = (L == 2);
#define MOE_VIEW() int* tok_e = (int*)(ws + WS_MOE + MO_TOKE); float* tok_g = (float*)(ws + WS_MOE + MO_TOKG); float* tok_rs = (float*)(ws + WS_MOE + MO_TOKRS); \
            int* tok_slot = (int*)(ws + WS_MOE + MO_SLOT); float* rsx = (float*)(ws + WS_MOE + MO_RSX); int* cnts = (int*)(ws + WS_MOE + MO_CNT); int* blk = (int*)(ws + WS_MOE + MO_BLK); \
            bf16* XG = (bf16*)(ws + WS_XG); bf16* EA = (bf16*)(ws + WS_EA); \
            (void)tok_e; (void)tok_g; (void)tok_rs; (void)tok_slot; (void)rsx; (void)cnts; (void)blk; (void)XG; (void)EA
#define MIX_VIEW() bf16* Zb = (bf16*)(ws + WS_Z); bf16* Qb = (bf16*)(ws + WS_Q); bf16* Kb = (bf16*)(ws + WS_K); bf16* KZT = (bf16*)(ws + WS_KZT); bf16* VT = (bf16*)(ws + WS_VT); \
        bf16* SG = (bf16*)(ws + WS_SG); bf16* SGA = (bf16*)(ws + WS_SGA); bf16* SGB = (bf16*)(ws + WS_SGB); bf16* Cb = (bf16*)(ws + WS_C); \
        float* KVT = (float*)(ws + WS_KVT); bf16* RB = (bf16*)(ws + WS_KVT); bf16* ST = (bf16*)(ws + WS_ST); bf16* MG = (bf16*)(ws + WS_MG); (void)RB; \
        (void)Zb; (void)Qb; (void)Kb; (void)KZT; (void)VT; (void)SG; (void)SGA; (void)SGB; (void)Cb; (void)KVT; (void)ST; (void)MG


        if (IN(PH_A)) { PHASE_VIEW(); MIX_VIEW();
            static_assert(WS_K - WS_Q == 2 * pg8::EpiIn::QK_STRIDE && WS_SGA - WS_SG == 2 * pg8::EpiIn::G_STRIDE && WS_SGB - WS_SGA == 2 * pg8::EpiIn::G_STRIDE, "EpiIn strides");
            if constexpr (L < 2 && A0G8 && !INPROJ8) {
              { pg8::Gemm g{(const bf16*)XBN, (const bf16*)(ws + WS_WIN) + (size_t)L * 5120 * D, T, 2048, D}; pg8::StaticOrder S; S.init(T, 2048, G, bx);
                pg8::EpiIn E{PARTN, (const float*)(ws + WS_COS), (const float*)(ws + WS_SIN), Zb, Qb, SG, 1.0f, 0};
                pg8::gemm_phase<pg8::EpiIn, pg8::StaticOrder, true, true, 0>(lds + RING_OFF, g, S, E); }
              { pg8::Gemm g{(const bf16*)(ws + WS_XBN8), (const bf16*)(ws + WS_WIN8G0 + (size_t)L * WS_WIN8G_STEP), T, 3072, D / 2}; pg8::StaticOrder S; S.init(T, 3072, G, bx);
                pg8::EpiIn E{PARTN, (const float*)(ws + WS_COS), (const float*)(ws + WS_SIN), Zb, Qb, SG, 1.0f / 64.0f, 8};
                pg8::gemm_phase<pg8::EpiIn, pg8::StaticOrder, true, true, 1>(lds + RING_OFF, g, S, E); }
            } else
            { pg8::Gemm g{INPROJ8 ? (const bf16*)(ws + WS_XBN8) : (const bf16*)XBN, (const bf16*)(ws + WS_WIN) + (size_t)L * 5120 * D, T, 5120, INPROJ8 ? D / 2 : D}; pg8::StaticOrder S; S.init(T, 5120, G, bx);
              pg8::EpiIn E{PARTN, (const float*)(ws + WS_COS), (const float*)(ws + WS_SIN), Zb, Qb, SG, INPROJ8 ? 1.0f / 64.0f : 1.0f, 0};
              pg8::gemm_phase<pg8::EpiIn, pg8::StaticOrder, true, true, INPROJ8 ? 1 : 0>(lds + RING_OFF, g, S, E); }

            { pg8::Gemm g{(const bf16*)(ws + WS_WKVT) + (size_t)L * 1536 * D, INPROJ8 ? (const bf16*)(ws + WS_XBN8) : (const bf16*)XBN, 1536, T, INPROJ8 ? D / 2 : D}; pg8::StaticOrder S; S.init(1536, T, G, bx);
              pg8::EpiKvT E{PARTN, (const float*)(ws + WS_COST), (const float*)(ws + WS_SINT), KZT, VT, INPROJ8 ? 1.0f / 64.0f : 1.0f};
              pg8::gemm_phase<pg8::EpiKvT, pg8::StaticOrder, true, true, INPROJ8 ? 1 : 0>(lds + RING_OFF, g, S, E); }
            GRID_BAR();
        }


        if (IN(PH_B)) { PHASE_VIEW(); MIX_VIEW();

            {
                const float* cw = INP(4) + (size_t)L * CONV_W * CONV_DIM; const float* cb = INP(5) + L * CONV_DIM;
                const float* lg = INP(6) + L * CONV_DIM; const float* lb = INP(7) + L * CONV_DIM;
                LAS unsigned* zt = (LAS unsigned*)(lds + RING_OFF);
                LAS float* ot = (LAS float*)(lds + RING_OFF + 65536);
                const int cp = tid & 255, half = tid >> 8;
                float w0[CONV_W], w1[CONV_W];
#pragma unroll
                for (int w = 0; w < CONV_W; ++w) { w0[w] = cw[w * CONV_DIM + 2 * cp]; w1[w] = cw[w * CONV_DIM + 2 * cp + 1]; }
                const float b0 = cb[2 * cp], b1 = cb[2 * cp + 1];
                f32x4 lg0 = *(const f32x4*)(lg + 8 * lane), lg1 = *(const f32x4*)(lg + 8 * lane + 4), lb0 = *(const f32x4*)(lb + 8 * lane), lb1 = *(const f32x4*)(lb + 8 * lane + 4);
                for (int u = bx; u < T / 32; u += G) {
                    const int tok0 = u * 32, pos0 = tok0 & (SEQ - 1);
                    for (int idx = tid; idx < 62 * 64; idx += 512) { const int r = idx >> 6, ch = idx & 63; const int pos = pos0 - 30 + r;
                        v4u v = {0u, 0u, 0u, 0u}; if (pos >= 0) v = *(const GAS v4u*)(Zb + (size_t)(tok0 - 30 + r) * CONV_DIM + ch * 8);
                        *(LAS v4u*)(zt + r * 256 + ch * 4) = v; }
                    __syncthreads();
#pragma unroll 1
                    for (int tg = 0; tg < 2; ++tg) { const int tb = 16 * half + 8 * tg;
                        float a0[8], a1[8];
#pragma unroll
                        for (int q = 0; q < 8; ++q) { a0[q] = b0; a1[q] = b1; }
#pragma unroll
                        for (int r = 0; r < 38; ++r) { const unsigned pv = zt[(tb + r) * 256 + cp]; const float f0 = __uint_as_float(pv << 16), f1 = __uint_as_float(pv & 0xffff0000u);
#pragma unroll
                            for (int q = 0; q < 8; ++q) { const int w = r - q; if (w >= 0 && w < CONV_W) { a0[q] = fmaf(w0[w], f0, a0[q]); a1[q] = fmaf(w1[w], f1, a1[q]); } } }
#pragma unroll
                        for (int q = 0; q < 8; ++q) { typedef float f2 __attribute__((ext_vector_type(2))); *(LAS f2*)(ot + (tb + q) * 512 + 2 * cp) = (f2){a0[q], a1[q]}; } }
                    __syncthreads();
#pragma unroll 1
                    for (int q = 0; q < 4; ++q) { const int tk = 4 * wave + q; const LAS f32x4* op = (const LAS f32x4*)(ot + tk * 512 + 8 * lane); f32x4 v0 = op[0], v1 = op[1];
                        const float mean = wave_sum((v0.x + v0.y) + (v0.z + v0.w) + (v1.x + v1.y) + (v1.z + v1.w)) * (1.0f / 512.0f);
                        v0 = v0 - mean; v1 = v1 - mean;
                        const float var = wave_sum((v0.x * v0.x + v0.y * v0.y) + (v0.z * v0.z + v0.w * v0.w) + (v1.x * v1.x + v1.y * v1.y) + (v1.z * v1.z + v1.w * v1.w)) * (1.0f / 512.0f);
                        const float rstd = __builtin_amdgcn_rsqf(var + EPS);
                        v0 = v0 * rstd * lg0 + lb0; v1 = v1 * rstd * lg1 + lb1;
                        v0 = v0 * pg8::sigm4(v0); v1 = v1 * pg8::sigm4(v1);
                        *(GAS v4u*)(Cb + (size_t)(tok0 + tk) * CONV_DIM + 8 * lane) = pg8::pack8(v0, v1); }
                    __syncthreads();
                }
            }

            {
                const int fr = lane & 15, g4 = lane >> 4;
                for (int u = bx; u < NUNIT; u += G) {
                    const int n = u & 63, bh = u >> 6, h = bh & 7, b = bh >> 3; const size_t tok0 = (size_t)b * SEQ + n * RC;
                    bf16x8 Bv[4], Ak[4][4];
#pragma unroll
                    for (int ks = 0; ks < 4; ++ks) Bv[ks] = *(const GAS bf16x8*)(VT + (size_t)(h * RDV + 16 * wave + fr) * T + tok0 + 32 * ks + 8 * g4);
#pragma unroll
                    for (int dkt = 0; dkt < 4; ++dkt)
#pragma unroll
                        for (int ks = 0; ks < 4; ++ks) Ak[dkt][ks] = *(const GAS bf16x8*)(KZT + (size_t)(h * RDK + 16 * dkt + fr) * T + tok0 + 32 * ks + 8 * g4);
                    f32x4 acc4[4];
#pragma unroll
                    for (int dkt = 0; dkt < 4; ++dkt) { acc4[dkt] = (f32x4){0.f, 0.f, 0.f, 0.f};
#pragma unroll
                        for (int ks = 0; ks < 4; ++ks) acc4[dkt] = __builtin_amdgcn_mfma_f32_16x16x32_bf16(Ak[dkt][ks], Bv[ks], acc4[dkt], 0, 0, 0); }
#pragma unroll
                    for (int dkt = 0; dkt < 4; ++dkt) { typedef unsigned u2 __attribute__((ext_vector_type(2))); u2 o; o.x = pk2(acc4[dkt].x, acc4[dkt].y); o.y = pk2(acc4[dkt].z, acc4[dkt].w);
                        *(GAS u2*)((bf16*)KVT + (size_t)u * (RDV * RDK) + (16 * wave + fr) * RDK + 16 * dkt + 4 * g4) = o; }
                }
            }

            if (moe) {
                __syncthreads();
                LAS float* scr = (LAS float*)(lds + RING_OFF + wave * 16384);
                constexpr int I_GU = 16 * 112, I_DN = 56 * 16, I_EXP = I_GU + I_DN;
                for (int it = gw; it < NEXP * I_EXP; it += NGW) { const int e = it / I_EXP, r = it % I_EXP; const size_t o = ((size_t)jl * NEXP + e) * D * EFF;
                    if (r < I_GU) conv_item<true>(INP(16) + o, INP(17) + o, INP(11) + L * D, (bf16*)(ws + WS_WEGU + (size_t)e * 2 * EFF * D), EFF, D, 112, 3, r, scr, lane);
                    else conv_item<true>(INP(18) + o, nullptr, nullptr, (bf16*)(ws + WS_WED + (size_t)e * D * EFF), D, EFF, 16, 0, r - I_GU, scr, lane); }
            }
            GRID_BAR();
        }


        if (IN(PH_C)) { PHASE_VIEW(); MIX_VIEW();
            {   const int gt = bx * 512 + tid;
                if (gt < 32 * 4096) { const int bh = gt >> 12, e2 = gt & 4095, h = bh & 7; const float gc = __builtin_amdgcn_exp2f(128.0f * log2g(h));
                    float s0 = 0.f, s1 = 0.f; typedef float f2 __attribute__((ext_vector_type(2)));
                    const GAS unsigned* kv = (const GAS unsigned*)((const bf16*)KVT + (size_t)bh * NCH * (RDV * RDK)) + e2; GAS unsigned* st = (GAS unsigned*)(ST + (size_t)bh * NCH * (RDV * RDK)) + e2;
                    unsigned wv[NCH];
#pragma unroll
                    for (int n = 0; n < NCH; ++n) wv[n] = kv[(size_t)n * 4096];
#pragma unroll
                    for (int n = 0; n < NCH; ++n) { const unsigned w = wv[n]; st[(size_t)n * 4096] = pk2(s0, s1); s0 = fmaf(gc, s0, __uint_as_float(w << 16)); s1 = fmaf(gc, s1, __uint_as_float(w & 0xffff0000u)); } }
            }
            { pg8::Gemm g{Cb, (const bf16*)(ws + WS_WCO) + (size_t)L * D * CONV_DIM, T, D, CONV_DIM}; pg8::StaticOrder S; S.init(T, D, G, bx);
              pg8::EpiGate<false> E{SGA, MG, 1.0f};
              pg8::gemm_phase<pg8::EpiGate<false>, pg8::StaticOrder, true, true>(lds + RING_OFF, g, S, E); }
            GRID_BAR();
        }


        if (IN(PH_D)) { PHASE_VIEW(); MIX_VIEW();
            const int fr = lane & 15, g4 = lane >> 4;
            unsigned offK[2], offS[2], offV[2];
#pragma unroll
            for (int i = 0; i < 2; ++i) { int R, C; pg8::stage_rc(tid * 16 + i * 8192, R, C); const int Rp = (R & ~31) + pg8::perm32(R & 31);
                offK[i] = (unsigned)(Rp * 512 + C) * 2u; offS[i] = (unsigned)(R * 64 + C) * 2u; offV[i] = (unsigned)R * (unsigned)(T * 2) + (unsigned)C * 2u; }
            const unsigned ldsw = (unsigned)wave * 1024u; const int fo = pg8::lds_byte(fr, g4 * 8);
#define RD_STAGE(bufoff, gbase, voff) do { _Pragma("unroll") for (int _i = 0; _i < 2; ++_i) \
                __builtin_amdgcn_global_load_lds((const unsigned*)((const char*)(gbase) + (voff)[_i]), (LAS unsigned*)(lds + (bufoff) + ldsw + _i * 8192), 16, 0, 0); } while (0)
#define RD_ISSUE(uu, buf) do { const int n_ = (uu) & 63, bh_ = (uu) >> 6, h_ = bh_ & 7, b_ = bh_ >> 3; const size_t t0_ = (size_t)b_ * SEQ + n_ * RC; const int so_ = (buf) * 65536; \
                RD_STAGE(so_, Kb + t0_ * 512 + h_ * RDK, offK); RD_STAGE(so_ + 16384, ST + (size_t)(uu) * (RDV * RDK), offS); \
                RD_STAGE(so_ + 32768, VT + (size_t)(h_ * RDV) * T + t0_, offV); RD_STAGE(so_ + 49152, VT + (size_t)(h_ * RDV) * T + t0_ + 64, offV); } while (0)
            int cur = 0;
            typedef unsigned u2 __attribute__((ext_vector_type(2)));
            bf16x8 Bq[2], Bqn[2]; u2 gv[8], gvn[8];
#define RD_QG(uu, BQ, GV) do { const int n_ = (uu) & 63, bh_ = (uu) >> 6, h_ = bh_ & 7, b_ = bh_ >> 3; const size_t tk_ = (size_t)b_ * SEQ + n_ * RC + 16 * wave + fr; \
                _Pragma("unroll") for (int ks = 0; ks < 2; ++ks) BQ[ks] = *(const GAS bf16x8*)(Qb + tk_ * 512 + h_ * RDK + 32 * ks + 8 * g4); \
                _Pragma("unroll") for (int dvt = 0; dvt < 8; ++dvt) GV[dvt] = *(const GAS u2*)(SG + tk_ * 1024 + h_ * RDV + 16 * dvt + 4 * g4); } while (0)
            if (bx < NUNIT) { RD_ISSUE(bx, 0); RD_QG(bx, Bq, gv); }
            for (int u = bx; u < NUNIT; u += G, cur ^= 1) {
                const int n = u & 63, bh = u >> 6, h = bh & 7, b = bh >> 3; const size_t tok0 = (size_t)b * SEQ + n * RC; const float lg = log2g(h);
                const size_t tok = tok0 + 16 * wave + fr;
                const int un = u + G;
                if (un < NUNIT) { RD_ISSUE(un, cur ^ 1); RD_QG(un, Bqn, gvn); asm volatile("s_waitcnt vmcnt(18)" ::: "memory"); } else { asm volatile("s_waitcnt vmcnt(0)" ::: "memory"); }
                __builtin_amdgcn_s_barrier(); asm volatile("" ::: "memory");
                const LAS unsigned char* sb = lds + cur * 65536 + fo;
                f32x4 oT[8], cT[8];
#pragma unroll
                for (int dvt = 0; dvt < 8; ++dvt) { oT[dvt] = (f32x4){0.f, 0.f, 0.f, 0.f}; cT[dvt] = (f32x4){0.f, 0.f, 0.f, 0.f}; }
#pragma unroll
                for (int t2 = 0; t2 < 4; ++t2) {
                    if (2 * t2 <= wave) {
                        unsigned P[2][2];
#pragma unroll
                        for (int nn = 0; nn < 2; ++nn) { f32x4 sv = {0.f, 0.f, 0.f, 0.f};
#pragma unroll
                            for (int ks = 0; ks < 2; ++ks) { const bf16x8 Ak = *(const LAS bf16x8*)(sb + (2 * t2 + nn) * 2048 + ks * 1024);
                                sv = __builtin_amdgcn_mfma_f32_16x16x32_bf16(Ak, Bq[ks], sv, 0, 0, 0); }
                            const int dd = (16 * wave + fr) - (32 * t2 + 8 * g4 + 4 * nn);
                            const float d0 = dd >= 0 ? sv.x * __builtin_amdgcn_exp2f((float)dd * lg) : 0.f, d1 = dd >= 1 ? sv.y * __builtin_amdgcn_exp2f((float)(dd - 1) * lg) : 0.f;
                            const float d2 = dd >= 2 ? sv.z * __builtin_amdgcn_exp2f((float)(dd - 2) * lg) : 0.f, d3 = dd >= 3 ? sv.w * __builtin_amdgcn_exp2f((float)(dd - 3) * lg) : 0.f;
                            P[nn][0] = pg8::cvt_pk_bf16(d0, d1); P[nn][1] = pg8::cvt_pk_bf16(d2, d3); }
                        v4u bp; bp.x = P[0][0]; bp.y = P[0][1]; bp.z = P[1][0]; bp.w = P[1][1];
                        const bf16x8 Bp = __builtin_bit_cast(bf16x8, bp);
                        const LAS unsigned char* vb = sb + 32768 + (t2 >> 1) * 16384 + (t2 & 1) * 1024;
#pragma unroll
                        for (int dvt = 0; dvt < 8; ++dvt) { const bf16x8 Av = *(const LAS bf16x8*)(vb + dvt * 2048);
                            oT[dvt] = __builtin_amdgcn_mfma_f32_16x16x32_bf16(Av, Bp, oT[dvt], 0, 0, 0); }
                    }
                }
#pragma unroll
                for (int dvt = 0; dvt < 8; ++dvt)
#pragma unroll
                    for (int ks = 0; ks < 2; ++ks) { const bf16x8 As = *(const LAS bf16x8*)(sb + 16384 + dvt * 2048 + ks * 1024);
                        cT[dvt] = __builtin_amdgcn_mfma_f32_16x16x32_bf16(As, Bq[ks], cT[dvt], 0, 0, 0); }
                const float xi = __builtin_amdgcn_exp2f((float)(16 * wave + fr + 1) * lg);
                float sm = 0.f;
#pragma unroll
                for (int dvt = 0; dvt < 8; ++dvt) { oT[dvt] = oT[dvt] + cT[dvt] * xi; sm += (oT[dvt].x + oT[dvt].y) + (oT[dvt].z + oT[dvt].w); }
                sm += __shfl_xor(sm, 16); sm += __shfl_xor(sm, 32);
                const float mean = sm * (1.0f / 128.0f); float sq = 0.f;
#pragma unroll
                for (int dvt = 0; dvt < 8; ++dvt) { oT[dvt] = oT[dvt] - mean; sq += (oT[dvt].x * oT[dvt].x + oT[dvt].y * oT[dvt].y) + (oT[dvt].z * oT[dvt].z + oT[dvt].w * oT[dvt].w); }
                sq += __shfl_xor(sq, 16); sq += __shfl_xor(sq, 32);
                const float rstd = __builtin_amdgcn_rsqf(sq * (1.0f / 128.0f) + EPS);
#pragma unroll
                for (int dvt = 0; dvt < 8; ++dvt) { const f32x4 graw = pg8::bf_lo4(gv[dvt].x, gv[dvt].y), gf = graw * pg8::sigm4(graw);
                    const f32x4 r = oT[dvt] * rstd * gf; u2 o; o.x = pg8::cvt_pk_bf16(r.x, r.y); o.y = pg8::cvt_pk_bf16(r.z, r.w); *(GAS u2*)(RB + tok * 1024 + h * RDV + 16 * dvt + 4 * g4) = o; }
                asm volatile("s_waitcnt lgkmcnt(0)" ::: "memory"); __builtin_amdgcn_s_barrier(); asm volatile("" ::: "memory");
#pragma unroll
                for (int ks = 0; ks < 2; ++ks) Bq[ks] = Bqn[ks];
#pragma unroll
                for (int dvt = 0; dvt < 8; ++dvt) gv[dvt] = gvn[dvt];
            }
#undef RD_QG
#undef RD_ISSUE
#undef RD_STAGE
            GRID_BAR();
        }


        if (IN(PH_E)) { PHASE_VIEW(); MIX_VIEW();
            pg8::Gemm g{RB, (const bf16*)(ws + WS_WRO) + (size_t)L * D * D, T, D, D}; pg8::StaticOrder S; S.init(T, D, G, bx);
            pg8::EpiGate<true> E{SGB, MG, SC_E};
            pg8::gemm_phase<pg8::EpiGate<true>, pg8::StaticOrder, true, true>(lds + RING_OFF, g, S, E);
            GRID_BAR();
        }


        if (IN(PH_F)) { PHASE_VIEW(); MIX_VIEW();
            pg8::Gemm g{MG, (const bf16*)(ws + WS_WO) + (size_t)L * D * D, T, D, D}; pg8::StaticOrder S; S.init(T, D, G, bx);
            pg8::EpiRes<false, DENSE8> E{XBN, XB, PART, nullptr, nullptr, ws + WS_XB8, SC_F};
            pg8::gemm_phase<pg8::EpiRes<false, DENSE8>, pg8::StaticOrder, true, true>(lds + RING_OFF, g, S, E);
            GRID_BAR();
        }

        if (!moe) {

            if (IN(PH_G)) { PHASE_VIEW(); MOE_VIEW();
                pg8::Gemm g{DENSE8 ? (const bf16*)(ws + WS_XB8) : (const bf16*)XB, (const bf16*)(ws + WS_WDGU) + (size_t)jl * 2 * DFF * D, T, 2 * DFF, DENSE8 ? D / 2 : D}; pg8::StaticOrder S; S.init(T, 2 * DFF, G, bx);
                pg8::EpiSwi<false, DENSE8> E{PART, nullptr, (bf16*)(ws + WS_FA), DFF};
                pg8::gemm_phase<pg8::EpiSwi<false, DENSE8>, pg8::StaticOrder, true, true, DENSE8 ? 1 : 0>(lds + RING_OFF, g, S, E);
                GRID_BAR();
            }

            if (IN(PH_H)) { PHASE_VIEW(); MOE_VIEW();
                pg8::Gemm g{(const bf16*)(ws + WS_FA), (const bf16*)(ws + WS_WDD) + (size_t)jl * D * DFF, T, D, DENSE8 ? DFF / 2 : DFF}; pg8::StaticOrder S; S.init(T, D, G, bx, 1);
                pg8::EpiRes<false, PLE8> E{XB, XB, PART, nullptr, nullptr, ws + WS_X8F, SC_Hd * (DENSE8 ? 1.0f / 256.0f : 1.0f)};
                pg8::gemm_phase<pg8::EpiRes<false, PLE8>, pg8::StaticOrder, true, true, DENSE8 ? 1 : 0>(lds + RING_OFF, g, S, E);
                GRID_BAR();
            }
        } else {

            if (IN(PH_G)) { PHASE_VIEW(); MOE_VIEW();
                LAS float* wrT = (LAS float*)(lds + RING_OFF);
                LAS int* lcnt = (LAS int*)(lds + RING_OFF + 32768);
                const float* wr = INP(15) + (size_t)jl * D * NEXP; const float* gf = INP(11) + L * D;
                for (int i = tid; i < D * NEXP; i += 512) { const int k = i >> 3, e = i & 7; wrT[e * 1024 + k] = wr[i] * gf[k]; }
                if (tid < 8) lcnt[tid] = 0;
                __syncthreads();
                f32x4 wreg[8][4];
#pragma unroll
                for (int e = 0; e < 8; ++e)
#pragma unroll
                    for (int j = 0; j < 4; ++j) wreg[e][j] = *(const LAS f32x4*)(wrT + e * 1024 + 256 * j + 4 * lane);
                typedef unsigned u2 __attribute__((ext_vector_type(2)));
                u2 xw[4], xwn[4];
                { const GAS u2* xr = (const GAS u2*)(XB + (size_t)(bx * 128 + wave * 16) * D) + lane;
#pragma unroll
                  for (int j = 0; j < 4; ++j) xw[j] = xr[64 * j]; }
                for (int q = 0; q < 16; ++q) { const int t = bx * 128 + wave * 16 + q;
                    if (q < 15) { const GAS u2* xr = (const GAS u2*)(XB + (size_t)(t + 1) * D) + lane;
#pragma unroll
                        for (int j = 0; j < 4; ++j) xwn[j] = xr[64 * j]; }
                    f32x4 xv[4]; float ss = 0.f;
#pragma unroll
                    for (int j = 0; j < 4; ++j) { xv[j] = pg8::bf_lo4(xw[j].x, xw[j].y); ss += (xv[j].x * xv[j].x + xv[j].y * xv[j].y) + (xv[j].z * xv[j].z + xv[j].w * xv[j].w); }
                    float pa[8];
#pragma unroll
                    for (int e = 0; e < 8; ++e) { float a = 0.f;
#pragma unroll
                        for (int j = 0; j < 4; ++j) { const f32x4 w = wreg[e][j]; a += (xv[j].x * w.x + xv[j].y * w.y) + (xv[j].z * w.z + xv[j].w * w.w); }
                        pa[e] = a; }
                    float r4[4], r2[2], r1;
                    { const bool hi = (lane & 32) != 0;
#pragma unroll
                      for (int i = 0; i < 4; ++i) { const float snd = hi ? pa[i] : pa[i + 4], kp = hi ? pa[i + 4] : pa[i]; r4[i] = kp + __shfl_xor(snd, 32); } }
                    { const bool hi = (lane & 16) != 0;
#pragma unroll
                      for (int i = 0; i < 2; ++i) { const float snd = hi ? r4[i] : r4[i + 2], kp = hi ? r4[i + 2] : r4[i]; r2[i] = kp + __shfl_xor(snd, 16); } }
                    { const bool hi = (lane & 8) != 0; const float snd = hi ? r2[0] : r2[1], kp = hi ? r2[1] : r2[0]; r1 = kp + __shfl_xor(snd, 8); }
                    r1 += __shfl_xor(r1, 4); r1 += __shfl_xor(r1, 2); r1 += __shfl_xor(r1, 1);
                    float lgt[8];
#pragma unroll
                    for (int e = 0; e < 8; ++e) lgt[e] = __int_as_float(__builtin_amdgcn_readlane(__float_as_int(r1), 8 * e));
                    ss = wave_sum(ss); const float rs = __builtin_amdgcn_rsqf(ss * (1.0f / 1024.0f) + EPS);
                    int e1 = 0; float v1 = lgt[0];
#pragma unroll
                    for (int e = 1; e < 8; ++e) if (lgt[e] > v1) { v1 = lgt[e]; e1 = e; }
                    int e2 = -1; float v2 = 0.f;
#pragma unroll
                    for (int e = 0; e < 8; ++e) if (e != e1 && (e2 < 0 || lgt[e] > v2)) { v2 = lgt[e]; e2 = e; }
                    const float ex = __builtin_amdgcn_exp2f((v2 - v1) * rs * kLog2e), g1 = 1.0f / (1.0f + ex), g2 = ex * g1;
                    if (lane == 0) { tok_e[2 * t] = e1; tok_e[2 * t + 1] = e2; tok_g[2 * t] = g1; tok_g[2 * t + 1] = g2; tok_rs[t] = rs; atomicAdd((int*)&lcnt[e1], 1); atomicAdd((int*)&lcnt[e2], 1); }
#pragma unroll
                    for (int j = 0; j < 4; ++j) xw[j] = xwn[j];
                }
                __syncthreads();
                if (tid < 8) cnts[bx * 8 + tid] = lcnt[tid];
                __syncthreads();
                GRID_BAR();
            }

            if (IN(PH_H)) { PHASE_VIEW(); MOE_VIEW();
                LAS int* lc = (LAS int*)(lds + RING_OFF);
                LAS int* base = lc + 2048;
                LAS int* lslot = base + 16;
                LAS int* le = lslot + 256;
                for (int i = tid; i < 2048; i += 512) lc[i] = cnts[i];
                if (tid < 256) le[tid] = tok_e[bx * 256 + tid];
                __syncthreads();
                {
                    int tot = 0, pre = 0;
#pragma unroll
                    for (int k = 0; k < 4; ++k) { const int wg = lane + 64 * k; const int c = lc[wg * 8 + wave]; tot += c; pre += (wg < bx) ? c : 0; }
#pragma unroll
                    for (int o = 1; o < 64; o <<= 1) { tot += __shfl_xor(tot, o); pre += __shfl_xor(pre, o); }
                    if (lane == 0) { base[wave] = pre; base[8 + wave] = tot; }
                }
                __syncthreads();
                if (tid == 0) { int ps = 0; for (int e = 0; e < 8; ++e) { const int tot = base[8 + e]; base[e] += ps; const int nb = (tot + 255) >> 8;
                        if (bx == 0) { for (int q = 0; q < nb; ++q) blk[1 + (ps >> 8) + q] = e; }
                        ps += nb << 8; }
                    if (bx == 0) blk[0] = ps >> 8; }
                __syncthreads();
                {
                    int run = base[wave];
#pragma unroll
                    for (int k = 0; k < 2; ++k) { const int i = lane + 64 * k; const int a = le[2 * i], b2 = le[2 * i + 1]; const bool f = (a == wave) || (b2 == wave);
                        const unsigned long long m = __ballot(f); const int rank = __popcll(m & ((1ull << lane) - 1ull));
                        if (f) lslot[2 * i + (a == wave ? 0 : 1)] = run + rank;
                        run += __popcll(m); }
                }
                __syncthreads();
                if (tid < 256) { const int t = bx * 128 + (tid >> 1); const int s = lslot[tid]; tok_slot[bx * 256 + tid] = s; rsx[s] = tok_rs[t]; }
                for (int p = wave; p < 256; p += 8) { const int t = bx * 128 + (p >> 1), s = lslot[p];
                    const GAS v4u* src = (const GAS v4u*)(XB + (size_t)t * D) + 2 * lane; const v4u a = src[0], b4 = src[1];
                    const f32x4 f0 = pg8::bf_lo4(a.x, a.y), f1 = pg8::bf_lo4(a.z, a.w), f2 = pg8::bf_lo4(b4.x, b4.y), f3 = pg8::bf_lo4(b4.z, b4.w); v4u o;
                    o.x = (unsigned)__builtin_amdgcn_cvt_pk_fp8_f32(f0.z, f0.w, __builtin_amdgcn_cvt_pk_fp8_f32(f0.x, f0.y, 0, false), true);
                    o.y = (unsigned)__builtin_amdgcn_cvt_pk_fp8_f32(f1.z, f1.w, __builtin_amdgcn_cvt_pk_fp8_f32(f1.x, f1.y, 0, false), true);
                    o.z = (unsigned)__builtin_amdgcn_cvt_pk_fp8_f32(f2.z, f2.w, __builtin_amdgcn_cvt_pk_fp8_f32(f2.x, f2.y, 0, false), true);
                    o.w = (unsigned)__builtin_amdgcn_cvt_pk_fp8_f32(f3.z, f3.w, __builtin_amdgcn_cvt_pk_fp8_f32(f3.x, f3.y, 0, false), true);
                    *((GAS v4u*)((unsigned char*)XG + (size_t)s * D) + lane) = o; }
                __syncthreads();
                GRID_BAR();
            }

            if (IN(PH_G1)) { PHASE_VIEW(); MOE_VIEW();
                const int nblk = blk[0];
                pg8::Gemm g{XG, (const bf16*)(ws + WS_WEGU), nblk * 256, 2 * EFF, D / 2}; pg8::MoeOrder S; S.init(nblk * 256, 2 * EFF, G, bx); S.blk_e = blk + 1; S.ntile = 2 * EFF / 256;
                pg8::EpiSwi<true> E{nullptr, rsx, EA, EFF};
                pg8::gemm_phase<pg8::EpiSwi<true>, pg8::MoeOrder, true, true, 1>(lds + RING_OFF, g, S, E);
                GRID_BAR();
            }

            if (IN(PH_G2)) { PHASE_VIEW(); MOE_VIEW();
                const int nblk = blk[0];
                pg8::Gemm g{EA, (const bf16*)(ws + WS_WED), nblk * 256, D, EFF / 2}; pg8::MoeOrder S; S.init(nblk * 256, D, G, bx, 1); S.blk_e = blk + 1; S.ntile = D / 256;
                pg8::EpiStore E{XG, D, 1.0f / 256.0f};
                pg8::gemm_phase<pg8::EpiStore, pg8::MoeOrder, true, true, 1>(lds + RING_OFF, g, S, E);
                GRID_BAR();
            }

            if (IN(PH_CMB)) { PHASE_VIEW(); MOE_VIEW();
                for (int t = gw; t < T; t += NGW) {
                    const int s1 = tok_slot[2 * t], s2 = tok_slot[2 * t + 1]; const float g1 = tok_g[2 * t], g2 = tok_g[2 * t + 1];
                    typedef unsigned u2 __attribute__((ext_vector_type(2))); GAS u2* xr = (GAS u2*)(XB + (size_t)t * D) + lane;
                    const GAS u2* y1 = (const GAS u2*)(XG + (size_t)s1 * D) + lane; const GAS u2* y2 = (const GAS u2*)(XG + (size_t)s2 * D) + lane;
                    float s = 0.f;
#pragma unroll
                    for (int j = 0; j < 4; ++j) { const u2 xw = xr[64 * j]; f32x4 v = pg8::bf_lo4(xw.x, xw.y); const u2 a = y1[64 * j], b2 = y2[64 * j];
                        v = v + (pg8::bf_lo4(a.x, a.y) * g1 + pg8::bf_lo4(b2.x, b2.y) * g2) * SC_CMB; s += (v.x * v.x + v.y * v.y) + (v.z * v.z + v.w * v.w);
                        u2 o; o.x = pk2(v.x, v.y); o.y = pk2(v.z, v.w); xr[64 * j] = o;
                        if (PLE8) ((GAS unsigned*)(ws + WS_X8F + (size_t)t * D))[64 * j + lane] = (unsigned)__builtin_amdgcn_cvt_pk_fp8_f32(v.z, v.w, __builtin_amdgcn_cvt_pk_fp8_f32(v.x, v.y, 0, false), true); }
                    s = wave_sum(s);
                    if (lane < 16) PART[(size_t)t * 16 + lane] = lane == 0 ? s : 0.f;
                }
                GRID_BAR();
            }
        }


        if (IN(PH_I)) { PHASE_VIEW(); MIX_VIEW();
            bf16* PP = (bf16*)(ws + WS_PP);
            { pg8::Gemm g{(const bf16*)(ws + WS_PB) + (size_t)L * T * PLE_DIM, (const bf16*)(ws + WS_WPP) + (size_t)L * D * PLE_DIM, T, D, PLE_DIM}; pg8::StaticOrder S; S.init(T, D, G, bx);
              pg8::EpiStore E{PP, D, 1.0f};
              pg8::gemm_phase<pg8::EpiStore, pg8::StaticOrder, true, true>(lds + RING_OFF, g, S, E); }
            { pg8::Gemm g{PLE8 ? (const bf16*)(ws + WS_X8F) : (const bf16*)XB, (const bf16*)(ws + WS_WPG) + (size_t)L * D * D, T, D, PLE8 ? D / 2 : D}; pg8::StaticOrder S; S.init(T, D, G, bx);
              pg8::EpiRes<true, (L + 1 >= (A0G8 ? 1 : INPROJ8_LAYER) && L + 1 < DEPTH), PLE8> E{XB, XBN, PARTN, PART, PP, ws + WS_XBN8, SC_I};
              pg8::gemm_phase<pg8::EpiRes<true, (L + 1 >= (A0G8 ? 1 : INPROJ8_LAYER) && L + 1 < DEPTH), PLE8>, pg8::StaticOrder, true, true, PLE8 ? 1 : 0>(lds + RING_OFF, g, S, E); }
            GRID_BAR();
        }
    }


    if (l_hi > DEPTH) { PHASE_VIEW();
        const float* gf = INP(22);
        f32x4 gv[4];
#pragma unroll
        for (int j = 0; j < 4; ++j) gv[j] = *((const f32x4*)gf + lane + 64 * j);
        for (int m = gw; m < T; m += NGW) { typedef unsigned u2 __attribute__((ext_vector_type(2))); const GAS u2* xr = (const GAS u2*)(XBN + (size_t)m * D) + lane; GAS f32x4* xo = (GAS f32x4*)(X + (size_t)m * D) + lane; f32x4 v[4]; float s = 0.f;
#pragma unroll
            for (int j = 0; j < 4; ++j) { const u2 xw = xr[64 * j]; v[j] = pg8::bf_lo4(xw.x, xw.y); s += (v[j].x * v[j].x + v[j].y * v[j].y) + (v[j].z * v[j].z + v[j].w * v[j].w); }
            const float rs = __builtin_amdgcn_rsqf(wave_sum(s) * (1.0f / 1024.0f) + EPS);
#pragma unroll
            for (int j = 0; j < 4; ++j) xo[64 * j] = v[j] * rs * gv[j]; }
    }
#undef IN
#undef GRID_BAR
#undef INP
#undef PHASE_VIEW
#undef MIX_VIEW
#undef MOE_VIEW
}

extern "C" void kernel_launch(void* const* d_in, const int* in_sizes, int n_in, void* d_out, int out_size, void* d_ws, size_t ws_size, hipStream_t stream) {
    static int grid = 0;
    if (grid == 0) {
        if (n_in != 23 || out_size != T * D || ws_size < WS_END) { fprintf(stderr, "kernel_launch: unexpected shapes: n_in %d out %d ws %zu (need %zu)\n", n_in, out_size, ws_size, (size_t)WS_END); grid = -1; return; }
        int dev = 0, cus = 0, per_cu = 0;
        if (hipGetDevice(&dev) != hipSuccess || hipDeviceGetAttribute(&cus, hipDeviceAttributeMultiprocessorCount, dev) != hipSuccess) { grid = -1; return; }
        if (hipFuncSetAttribute((const void*)hybrid_fwd, hipFuncAttributeMaxDynamicSharedMemorySize, LDS_BYTES) != hipSuccess) { fprintf(stderr, "kernel_launch: hipFuncSetAttribute failed\n"); grid = -1; return; }
        if (hipOccupancyMaxActiveBlocksPerMultiprocessor(&per_cu, (const void*)hybrid_fwd, NWAVES * 64, LDS_BYTES) != hipSuccess || per_cu < 1) { fprintf(stderr, "kernel_launch: occupancy query reports %d\n", per_cu); }
        (void)hipGetLastError();
        grid = cus;
        if (grid != 256) { fprintf(stderr, "kernel_launch: built for 256 CUs, found %d\n", cus); grid = -1; return; }
    }
    if (grid < 0) return;
    (void)hipMemsetAsync((char*)d_ws + WS_CTL, 0, CTL_ZERO_BYTES, stream);
    Args a{};
    for (int i = 0; i < 23; ++i) a.in[i] = (const float*)d_in[i];
    a.out = (float*)d_out; a.ws = (unsigned char*)d_ws; a.pad = 0;
#if MK_FUSED
    a.l_lo = -1; a.l_hi = DEPTH + 1; a.ph_lo = 0; a.ph_hi = PH_N; a.fused = 1;
    hipLaunchKernelGGL(hybrid_fwd, dim3(grid), dim3(NWAVES * 64), LDS_BYTES, stream, a);
#else
    a.fused = 0;
    a.l_lo = -1; a.l_hi = 0; a.ph_lo = 0; a.ph_hi = 0;
    hipLaunchKernelGGL(hybrid_fwd, dim3(grid), dim3(NWAVES * 64), LDS_BYTES, stream, a);
    for (int L = 0; L < DEPTH; ++L)
        for (int ph = 0; ph < PH_N; ++ph) {
            if ((L & 1) == 0 && (ph == PH_G1 || ph == PH_G2 || ph == PH_CMB)) continue;
            a.l_lo = L; a.l_hi = L + 1; a.ph_lo = ph; a.ph_hi = ph + 1;
            hipLaunchKernelGGL(hybrid_fwd, dim3(grid), dim3(NWAVES * 64), LDS_BYTES, stream, a);
        }
    a.l_lo = DEPTH; a.l_hi = DEPTH + 1; a.ph_lo = 0; a.ph_hi = 0;
    hipLaunchKernelGGL(hybrid_fwd, dim3(grid), dim3(NWAVES * 64), LDS_BYTES, stream, a);
#endif
}
```

```cpp
#include <hip/hip_runtime.h>
#include <cstdio>
#include <cstdint>
#ifndef SC_E
#define SC_E 1.0f
#endif
#ifndef SC_F
#define SC_F 1.0f
#endif
#ifndef SC_Hd
#define SC_Hd 1.0f
#endif
#ifndef SC_I
#define SC_I 1.0f
#endif
#ifndef SC_CMB
#define SC_CMB 1.0f
#endif
#ifndef PB_MODE
#define PB_MODE 0
#endif
#ifndef INPROJ8_LAYER
#define INPROJ8_LAYER 1
#endif
#ifndef A0G8
#define A0G8 1
#endif
#ifndef PLE8_LAYER
#define PLE8_LAYER 1
#endif
#ifndef MK_FUSED
#define MK_FUSED 1
#endif
namespace pg8 {
#define PG8_LAS __attribute__((address_space(3)))
typedef unsigned short bf16_t;
typedef short bf16x8 __attribute__((ext_vector_type(8)));
typedef float f32x4 __attribute__((ext_vector_type(4)));
typedef unsigned u32x4 __attribute__((ext_vector_type(4)));
typedef int i32x4 __attribute__((ext_vector_type(4)));
typedef int i32x8 __attribute__((ext_vector_type(8)));
constexpr int BM = 256, BK = 64, HALF = 128, HTB = HALF * BK * 2  , STAGE_BYTES = 8 * HTB, NXCD = 8, WGM = 8;

__host__ __device__ __forceinline__ int lds_byte(int r, int c) { const int st = (r >> 4) * 2 + (c >> 5), rr = r & 15, cc = c & 31, ob = rr * 64 + cc * 2; return st * 1024 + (ob ^ (((ob >> 9) & 1) << 5)); }
__host__ __device__ __forceinline__ void stage_rc(int b, int& R, int& C) { const int st = b / 1024, sb = b % 1024, swz = sb ^ (((sb >> 9) & 1) << 5); R = (st >> 1) * 16 + swz / 64; C = (st & 1) * 32 + (swz % 64) / 2; }
__host__ __device__ __forceinline__ int perm32(int rho) { const int n = rho >> 4, i = rho & 15; return 8 * (i >> 2) + 4 * n + (i & 3); }

struct Unit { int pm, pn, pb; };
struct Gemm { const bf16_t* A; const bf16_t* Bt; int M, N, K; };

struct StaticOrder {
    int nM, nN, nwg, G, c, rev;
    __host__ __device__ void init(int M, int N, int G_, int c_, int rev_ = 0) { nM = M / BM; nN = N / BM; nwg = nM * nN; G = G_; c = c_; rev = rev_; }
    __host__ __device__ bool next(int i, Unit& u) const {
        const long L = (long)i * G + c; if (L >= nwg) return false;
        int wgid = (int)L; { const int q = nwg / NXCD, r = nwg % NXCD, xcd = wgid % NXCD, off = wgid / NXCD; wgid = (xcd < r ? xcd * (q + 1) : r * (q + 1) + (xcd - r) * q) + off; }
        if (rev) wgid = nwg - 1 - wgid;
        const int nig = WGM * nN, gid = wgid / nig, fm = gid * WGM, gsz = (nM - fm) < WGM ? (nM - fm) : WGM;
        u.pm = fm + ((wgid % nig) % gsz); u.pn = (wgid % nig) / gsz; u.pb = u.pn; return true;
    }
    __device__ __forceinline__ void a_ready(const Unit&) const {}
    __device__ __forceinline__ void done(const Unit&) const {}
};

__device__ __forceinline__ unsigned cvt_pk_bf16(float lo, float hi) { unsigned r; asm volatile("v_cvt_pk_bf16_f32 %0, %1, %2" : "=v"(r) : "v"(lo), "v"(hi)); return r; }
typedef float f32x2 __attribute__((ext_vector_type(2)));


template <class Epi, class Sched, bool ALIGN_EPI = false, bool SP2 = false, int F8 = 0, bool TILED_A = false>
__device__ __forceinline__ void gemm_phase(PG8_LAS unsigned char* lds, const Gemm g, const Sched& S, const Epi& E) {
    int tid_ = threadIdx.x; asm volatile("" : "+v"(tid_));
    const int tid = tid_, wid = __builtin_amdgcn_readfirstlane(tid >> 6), lane = tid & 63, wr = wid >> 2, wc = wid & 3, fr = lane & 15, fq = lane >> 4;
    int K_ = g.K; asm volatile("" : "+s"(K_)); const int K = K_, nt = K / BK;
    unsigned voffA[2], voffB[2];
#pragma unroll
    for (int i = 0; i < 2; ++i) { int R, C; stage_rc(tid * 16 + i * 8192, R, C); const int Rb = Epi::PERM ? ((R & ~31) + perm32(R & 31)) : R;
        voffA[i] = TILED_A ? (unsigned)(R * 128 + C * 2) : (unsigned)(R * K + C) * 2u; voffB[i] = (unsigned)(Rb * K + C) * 2u; }
    const size_t kstep = (size_t)(BK * 2);
    const size_t hstep = (size_t)HALF * K * 2;
    const size_t tstep = 2 * hstep;
    const size_t kstepA = TILED_A ? (size_t)32768 : kstep, hstepA = TILED_A ? (size_t)16384 : hstep, tstepA = TILED_A ? (size_t)(K / BK) * 32768 : tstep;
    const unsigned ldsw = (unsigned)wid * 1024u;
    const int aoff = lds_byte(wr * 64 + fr, fq * 8), boff = lds_byte(wc * 32 + fr, fq * 8);
#define PG8_SA(b, h) (((b) * 2 + (h)) * HTB)
#define PG8_SB(b, h) ((4 + (b) * 2 + (h)) * HTB)
#define PG8_STAGE(bufoff, gbase, voff) do { _Pragma("unroll") for (int _i = 0; _i < 2; ++_i) \
        __builtin_amdgcn_global_load_lds((const unsigned*)((const char*)(gbase) + (voff)[_i]), (PG8_LAS unsigned*)(lds + (bufoff) + ldsw + _i * 8192), 16, 0, 0); } while (0)
#define PG8_LDA(dst, b, h) do { if constexpr (F8 == 0) { _Pragma("unroll") for (int m = 0; m < 4; ++m) _Pragma("unroll") for (int k = 0; k < 2; ++k) dst[m][k] = *(const PG8_LAS bf16x8*)(lds + PG8_SA(b, h) + aoff + m * 2048 + k * 1024); } \
        else { _Pragma("unroll") for (int m = 0; m < 4; ++m) dst##8[m] = __builtin_shufflevector(*(const PG8_LAS i32x4*)(lds + PG8_SA(b, h) + aoff + m * 2048), *(const PG8_LAS i32x4*)(lds + PG8_SA(b, h) + aoff + m * 2048 + 1024), 0, 1, 2, 3, 4, 5, 6, 7); } } while (0)
#define PG8_LDB(dst, b, h) do { if constexpr (F8 == 0) { _Pragma("unroll") for (int n = 0; n < 2; ++n) _Pragma("unroll") for (int k = 0; k < 2; ++k) dst[n][k] = *(const PG8_LAS bf16x8*)(lds + PG8_SB(b, h) + boff + n * 2048 + k * 1024); } \
        else { _Pragma("unroll") for (int n = 0; n < 2; ++n) dst##8[n] = __builtin_shufflevector(*(const PG8_LAS i32x4*)(lds + PG8_SB(b, h) + boff + n * 2048), *(const PG8_LAS i32x4*)(lds + PG8_SB(b, h) + boff + n * 2048 + 1024), 0, 1, 2, 3, 4, 5, 6, 7); } } while (0)
#define PG8_MMA(ai, bj, At, Bt) do { __builtin_amdgcn_s_setprio(1); \
        if constexpr (F8 == 0) { _Pragma("unroll") for (int m = 0; m < 4; ++m) _Pragma("unroll") for (int n = 0; n < 2; ++n) _Pragma("unroll") for (int k = 0; k < 2; ++k) \
            acc[ai][bj][m][n] = __builtin_amdgcn_mfma_f32_16x16x32_bf16(Bt[n][k], At[m][k], acc[ai][bj][m][n], 0, 0, 0); } \
        else {   \
            _Pragma("unroll") for (int m = 0; m < 4; ++m) _Pragma("unroll") for (int n = 0; n < 2; ++n) \
            asm volatile("v_mfma_f32_16x16x128_f8f6f4 %0, %1, %2, %0" : "+v"(acc[ai][bj][m][n]) : "v"(Bt##8[n]), "v"(At##8[m])); }   \
        __builtin_amdgcn_s_setprio(0); } while (0)
#define PG8_WAIT_V(n) asm volatile("s_waitcnt vmcnt(" #n ")" ::: "memory")
#define PG8_WAIT_L(n) asm volatile("s_waitcnt lgkmcnt(" #n ")" ::: "memory")
#define PG8_BAR __builtin_amdgcn_s_barrier()
#define PG8_SCHED __builtin_amdgcn_sched_barrier(0)
    Unit cur, nxt; int ui = 0;
    if (!S.next(0, cur)) return;
    f32x4 acc[2][2][4][2];
#pragma unroll
    for (int a = 0; a < 2; ++a)
#pragma unroll
        for (int b = 0; b < 2; ++b)
#pragma unroll
            for (int m = 0; m < 4; ++m)
#pragma unroll
                for (int n = 0; n < 2; ++n) acc[a][b][m][n] = (f32x4){0.f, 0.f, 0.f, 0.f};
    bf16x8 At[4][2], B0[2][2], B1[2][2]; i32x8 At8[4], B08[2], B18[2]; (void)At; (void)B0; (void)B1; (void)At8; (void)B08; (void)B18;
    const char* cA = (const char*)g.A + (size_t)cur.pm * tstepA; const char* cB = (const char*)g.Bt + (size_t)cur.pb * tstep;
    S.a_ready(cur);
    if constexpr (SP2) {
        PG8_STAGE(PG8_SB(0, 0), cB, voffB); PG8_STAGE(PG8_SB(0, 1), cB + hstep, voffB); PG8_STAGE(PG8_SA(0, 0), cA, voffA); PG8_STAGE(PG8_SA(0, 1), cA + hstepA, voffA);
        if (wr == 1) PG8_BAR;
        PG8_WAIT_V(2); PG8_BAR;
        PG8_STAGE(PG8_SB(1, 0), cB + kstep, voffB); PG8_STAGE(PG8_SA(1, 0), cA + kstepA, voffA); PG8_STAGE(PG8_SB(1, 1), cB + hstep + kstep, voffB);
        PG8_WAIT_V(6); PG8_BAR;
    } else {
        PG8_STAGE(PG8_SB(0, 0), cB, voffB); PG8_STAGE(PG8_SA(0, 0), cA, voffA); PG8_STAGE(PG8_SB(0, 1), cB + hstep, voffB); PG8_STAGE(PG8_SA(0, 1), cA + hstepA, voffA);
        if (wr == 1) PG8_BAR;
        PG8_WAIT_V(4); PG8_BAR;
        PG8_STAGE(PG8_SB(1, 0), cB + kstep, voffB); PG8_STAGE(PG8_SA(1, 0), cA + kstepA, voffA); PG8_STAGE(PG8_SB(1, 1), cB + hstep + kstep, voffB);
        PG8_WAIT_V(6); PG8_BAR;
    }
    for (;;) {
        const bool has_next = S.next(ui + 1, nxt);
        const char* nA = has_next ? (const char*)g.A + (size_t)nxt.pm * tstepA : cA; const char* nB = has_next ? (const char*)g.Bt + (size_t)nxt.pb * tstep : cB;
#if PB_MODE == 2
        const unsigned long long pbt = __builtin_amdgcn_s_memrealtime();
#endif
        for (int t = 0; t < nt; t += 2) {
            const bool last = (t == nt - 2);
            const char* a1 = cA + (size_t)(t + 1) * kstepA;
            const char* a2 = last ? nA : cA + (size_t)(t + 2) * kstepA; const char* b2 = last ? nB : cB + (size_t)(t + 2) * kstep;
            const char* a3 = a2 + kstepA; const char* b3 = b2 + kstep;
            if (last && has_next) S.a_ready(nxt);
            if constexpr (SP2) {
            PG8_LDB(B0, 0, 0); PG8_LDB(B1, 0, 1); PG8_SCHED; PG8_LDA(At, 0, 0); PG8_STAGE(PG8_SA(1, 1), a1 + hstepA, voffA);
            PG8_WAIT_V(8); PG8_WAIT_L(0); PG8_BAR; PG8_MMA(0, 0, At, B0); PG8_MMA(0, 1, At, B1); PG8_BAR; PG8_SCHED;
            PG8_LDA(At, 0, 1); PG8_STAGE(PG8_SB(0, 0), b2, voffB); PG8_STAGE(PG8_SB(0, 1), b2 + hstep, voffB); PG8_STAGE(PG8_SA(0, 0), a2, voffA);
            PG8_WAIT_V(8); PG8_WAIT_L(0); PG8_BAR; PG8_MMA(1, 0, At, B0); PG8_MMA(1, 1, At, B1); PG8_BAR; PG8_SCHED;
            PG8_LDB(B0, 1, 0); PG8_LDB(B1, 1, 1); PG8_SCHED; PG8_LDA(At, 1, 0); PG8_STAGE(PG8_SA(0, 1), a2 + hstepA, voffA);
            PG8_WAIT_V(8); PG8_WAIT_L(0); PG8_BAR; PG8_MMA(0, 0, At, B0); PG8_MMA(0, 1, At, B1); PG8_BAR; PG8_SCHED;
            PG8_LDA(At, 1, 1); PG8_STAGE(PG8_SB(1, 0), b3, voffB); PG8_STAGE(PG8_SB(1, 1), b3 + hstep, voffB); PG8_STAGE(PG8_SA(1, 0), a3, voffA);
            PG8_WAIT_V(8); PG8_WAIT_L(0); PG8_BAR; PG8_MMA(1, 0, At, B0); PG8_MMA(1, 1, At, B1); PG8_BAR; PG8_SCHED;
            } else {
            PG8_LDB(B0, 0, 0); PG8_SCHED; PG8_LDA(At, 0, 0); PG8_STAGE(PG8_SA(1, 1), a1 + hstepA, voffA);
            PG8_WAIT_L(8); PG8_BAR; PG8_WAIT_L(0); PG8_MMA(0, 0, At, B0); PG8_BAR; PG8_SCHED;
            PG8_LDB(B1, 0, 1); PG8_STAGE(PG8_SB(0, 0), b2, voffB);
            PG8_BAR; PG8_WAIT_L(0); PG8_MMA(0, 1, At, B1); PG8_BAR;
            PG8_LDA(At, 0, 1); PG8_STAGE(PG8_SA(0, 0), a2, voffA);
            PG8_BAR; PG8_WAIT_L(0); PG8_MMA(1, 0, At, B0); PG8_BAR; PG8_SCHED;
            PG8_STAGE(PG8_SB(0, 1), b2 + hstep, voffB);
            PG8_WAIT_V(6); PG8_BAR; PG8_MMA(1, 1, At, B1); PG8_BAR;
            PG8_LDB(B0, 1, 0); PG8_SCHED; PG8_LDA(At, 1, 0); PG8_STAGE(PG8_SA(0, 1), a2 + hstepA, voffA);
            PG8_WAIT_L(8); PG8_BAR; PG8_WAIT_L(0); PG8_MMA(0, 0, At, B0); PG8_BAR; PG8_SCHED;
            PG8_LDB(B1, 1, 1); PG8_STAGE(PG8_SB(1, 0), b3, voffB);
            PG8_BAR; PG8_WAIT_L(0); PG8_MMA(0, 1, At, B1); PG8_BAR;
            PG8_LDA(At, 1, 1); PG8_STAGE(PG8_SA(1, 0), a3, voffA);
            PG8_BAR; PG8_WAIT_L(0); PG8_MMA(1, 0, At, B0); PG8_BAR; PG8_SCHED;
            PG8_STAGE(PG8_SB(1, 1), b3 + hstep, voffB);
            PG8_WAIT_V(6); PG8_BAR; PG8_MMA(1, 1, At, B1); PG8_BAR;
            }
        }
#if PB_MODE == 2
        if (wid == 0 && lane == 0 && *(volatile PG8_LAS unsigned*)(lds + 135168) != 0u) atomicAdd((unsigned long long*)(lds + 135176), __builtin_amdgcn_s_memrealtime() - pbt);
#endif
        if constexpr (ALIGN_EPI) { if (wr == 0) PG8_BAR; }
#if PB_MODE == 1
        const unsigned long long pbt = __builtin_amdgcn_s_memrealtime();
#endif
        if constexpr (F8 != 0) asm volatile("s_nop 15\n\ts_nop 15" ::: "memory");
        if constexpr (!Epi::AFTER_DRAIN) { E(acc, cur, wr, wc, fr, fq); S.done(cur); }
#if PB_MODE == 1
        if (wid == 0 && lane == 0 && *(volatile PG8_LAS unsigned*)(lds + 135168) != 0u) atomicAdd((unsigned long long*)(lds + 135176), __builtin_amdgcn_s_memrealtime() - pbt);
#endif
        if (!has_next) break;
#pragma unroll
        for (int a = 0; a < 2; ++a)
#pragma unroll
            for (int b = 0; b < 2; ++b)
#pragma unroll
                for (int m = 0; m < 4; ++m)
#pragma unroll
                    for (int n = 0; n < 2; ++n) acc[a][b][m][n] = (f32x4){0.f, 0.f, 0.f, 0.f};
        cur = nxt; cA = nA; cB = nB; ++ui;
        if constexpr (ALIGN_EPI) { if (wr == 1) PG8_BAR; }
    }
    PG8_WAIT_V(0);
    if constexpr (!ALIGN_EPI) { if (wr == 0) PG8_BAR; }
    PG8_BAR;
    if constexpr (Epi::AFTER_DRAIN) { E.fused(acc, cur, wr, wc, fr, fq, lds, wid, lane); S.done(cur); }
#undef PG8_SA
#undef PG8_SB
#undef PG8_STAGE
#undef PG8_LDA
#undef PG8_LDB
#undef PG8_MMA
#undef PG8_WAIT_V
#undef PG8_WAIT_L
#undef PG8_BAR
#undef PG8_SCHED
}
}

namespace pg8 {
constexpr int TT = 32768;
constexpr float kLog2e = 1.4426950408889634f;
__device__ __forceinline__ float sigm(float v) { return __builtin_amdgcn_rcpf(1.0f + __builtin_amdgcn_exp2f(-v * kLog2e)); }
__device__ __forceinline__ f32x4 sigm4(f32x4 v) { f32x4 r; r.x = sigm(v.x); r.y = sigm(v.y); r.z = sigm(v.z); r.w = sigm(v.w); return r; }
__device__ __forceinline__ f32x4 ksig4(f32x4 t, float ik) { f32x4 e, r;
    e.x = __builtin_amdgcn_exp2f(t.x); e.y = __builtin_amdgcn_exp2f(t.y); e.z = __builtin_amdgcn_exp2f(t.z); e.w = __builtin_amdgcn_exp2f(t.w);
    const f32x4 d = e * ik + ik;
    r.x = __builtin_amdgcn_rcpf(d.x); r.y = __builtin_amdgcn_rcpf(d.y); r.z = __builtin_amdgcn_rcpf(d.z); r.w = __builtin_amdgcn_rcpf(d.w); return r; }
__device__ __forceinline__ u32x4 pack8(f32x4 a, f32x4 b) { u32x4 w; w.x = cvt_pk_bf16(a.x, a.y); w.y = cvt_pk_bf16(a.z, a.w); w.z = cvt_pk_bf16(b.x, b.y); w.w = cvt_pk_bf16(b.z, b.w); return w; }
__device__ __forceinline__ f32x4 bf_lo4(unsigned a, unsigned b) { f32x4 r; r.x = __uint_as_float(a << 16); r.y = __uint_as_float(a & 0xffff0000u); r.z = __uint_as_float(b << 16); r.w = __uint_as_float(b & 0xffff0000u); return r; }
__device__ __forceinline__ float row_rs(const float* part, int row) {
    const f32x4* p = (const f32x4*)(part + (size_t)row * 16);
    const f32x4 a = p[0], b = p[1], c = p[2], d = p[3];
    const float s = (((a.x + a.y) + (a.z + a.w)) + ((b.x + b.y) + (b.z + b.w))) + (((c.x + c.y) + (c.z + c.w)) + ((d.x + d.y) + (d.z + d.w)));
    return __builtin_amdgcn_rsqf(s * (1.0f / 1024.0f) + 1e-6f);
}
__device__ __forceinline__ float row_rs4(const float* part, int row, int fq) {
    const f32x4 a = *(const f32x4*)(part + (size_t)row * 16 + fq * 4);
    float s = (a.x + a.y) + (a.z + a.w); s += __shfl_xor(s, 16); s += __shfl_xor(s, 32);
    return __builtin_amdgcn_rsqf(s * (1.0f / 1024.0f) + 1e-6f);
}
__device__ __forceinline__ void rows_rs8(const float* part, int row0, int fq, float (&rs)[2][4]) {
    f32x4 a[2][4];
#pragma unroll
    for (int ai = 0; ai < 2; ++ai)
#pragma unroll
        for (int m = 0; m < 4; ++m) a[ai][m] = *(const f32x4*)(part + (size_t)(row0 + ai * HALF + m * 16) * 16 + fq * 4);
#pragma unroll
    for (int ai = 0; ai < 2; ++ai)
#pragma unroll
        for (int m = 0; m < 4; ++m) { float s = (a[ai][m].x + a[ai][m].y) + (a[ai][m].z + a[ai][m].w); s += __shfl_xor(s, 16); s += __shfl_xor(s, 32); rs[ai][m] = __builtin_amdgcn_rsqf(s * (1.0f / 1024.0f) + 1e-6f); }
    asm volatile("" ::: "memory");
}
__device__ __forceinline__ float log2g(int h) {
    const float x = __builtin_amdgcn_exp2f((float)(-5 - h));
    const float ln = -x * (1.0f + x * (0.5f + x * (0.33333334f + x * (0.25f + x * (0.2f + x * 0.16666667f)))));
    return ln * kLog2e;
}

struct EpiIn {
    static constexpr bool PERM = true, AFTER_DRAIN = false;
    const float* part; const float* ctab; const float* stab;
    bf16_t *Z, *Q, *SG;
    static constexpr size_t QK_STRIDE = 16777216, G_STRIDE = 33554432;
    float wsc;
    int pnoff;
    __device__ __forceinline__ void operator()(const f32x4 (&acc)[2][2][4][2], const Unit& u, int wr, int wc, int fr, int fq) const {
        asm volatile("" : "+v"(fr));
        const int row0 = u.pm * BM + wr * 64 + fr, pn = u.pn + pnoff;
        float rsa[2][4]; rows_rs8(part, row0, fq, rsa);
        if (wsc != 1.0f) {
#pragma unroll
            for (int ai = 0; ai < 2; ++ai)
#pragma unroll
                for (int m = 0; m < 4; ++m) rsa[ai][m] *= wsc; }
        if (pn < 4) {
#pragma unroll
            for (int ai = 0; ai < 2; ++ai)
#pragma unroll
                for (int m = 0; m < 4; ++m) { const int row = row0 + ai * HALF + m * 16; const float rs = rsa[ai][m];
                    const float nrl = -rs * kLog2e, irs = __builtin_amdgcn_rcpf(rs);
                    *(u32x4*)(Z + (size_t)row * 512 + pn * 128 + wc * 32 + fq * 8) = pack8(acc[ai][0][m][0] * ksig4(acc[ai][1][m][0] * nrl, irs), acc[ai][0][m][1] * ksig4(acc[ai][1][m][1] * nrl, irs)); }
        } else if (pn < 8) {
            const bool isk = pn >= 6; const int head = 4 * ((pn - 4) & 1) + wc; const float scale = isk ? 1.0f : 0.125f; bf16_t* dst = Q + (isk ? QK_STRIDE : (size_t)0);
#pragma unroll
            for (int ap = 0; ap < 4; ++ap) {
                const int ai = ap >> 1, mb = (ap & 1) * 2; f32x4 cc[2][2], ss[2][2];
#pragma unroll
                for (int q = 0; q < 2; ++q) { const int pos = (row0 + ai * HALF + (mb + q) * 16) & 8191;
                    cc[q][0] = *(const f32x4*)(ctab + pos * 32 + fq * 8); cc[q][1] = *(const f32x4*)(ctab + pos * 32 + fq * 8 + 4);
                    ss[q][0] = *(const f32x4*)(stab + pos * 32 + fq * 8); ss[q][1] = *(const f32x4*)(stab + pos * 32 + fq * 8 + 4); }
#pragma unroll
                for (int q = 0; q < 2; ++q) { const int m = mb + q; const int row = row0 + ai * HALF + m * 16; const float rs = rsa[ai][m] * scale;
                    const f32x4 t10 = acc[ai][0][m][0] * rs, t11 = acc[ai][0][m][1] * rs, t20 = acc[ai][1][m][0] * rs, t21 = acc[ai][1][m][1] * rs;
                    bf16_t* p = dst + (size_t)row * 512 + head * 64 + fq * 8;
                    *(u32x4*)(p) = pack8(t10 * cc[q][0] - t20 * ss[q][0], t11 * cc[q][1] - t21 * ss[q][1]);
                    *(u32x4*)(p + 32) = pack8(t10 * ss[q][0] + t20 * cc[q][0], t11 * ss[q][1] + t21 * cc[q][1]); }
                asm volatile("" ::: "memory"); }
        } else {
            const int sel = (pn - 8) >> 2, colb = ((pn - 8) & 3) * 256 + wc * 32 + fq * 8; bf16_t* dst = SG + (size_t)sel * G_STRIDE;
#pragma unroll
            for (int ai = 0; ai < 2; ++ai)
#pragma unroll
                for (int m = 0; m < 4; ++m) { const int row = row0 + ai * HALF + m * 16; const float rs = rsa[ai][m];
#pragma unroll
                    for (int bj = 0; bj < 2; ++bj)
                        *(u32x4*)(dst + (size_t)row * 1024 + colb + bj * HALF) = pack8(acc[ai][bj][m][0] * rs, acc[ai][bj][m][1] * rs); }
        }
    }
};
struct EpiKvT {
    static constexpr bool PERM = true, AFTER_DRAIN = false;
    const float* part; const float* ctT; const float* stT;
    bf16_t *KZT, *VT;
    float wsc;
    __device__ __forceinline__ void operator()(const f32x4 (&acc)[2][2][4][2], const Unit& u, int wr, int wc, int fr, int fq) const {
        asm volatile("" : "+v"(fr));
        const int col0 = u.pn * BM + wc * 32 + fq * 8;
        f32x4 rsv[2][2];
        { const int lane = fq * 16 + fr; const float mine = row_rs(part, u.pn * BM + (lane >> 5) * HALF + wc * 32 + (lane & 31)) * wsc;
          asm volatile("" ::: "memory");
#pragma unroll
          for (int bj = 0; bj < 2; ++bj)
#pragma unroll
            for (int n = 0; n < 2; ++n) { const int sl = bj * 32 + fq * 8 + n * 4; rsv[bj][n].x = __shfl(mine, sl); rsv[bj][n].y = __shfl(mine, sl + 1); rsv[bj][n].z = __shfl(mine, sl + 2); rsv[bj][n].w = __shfl(mine, sl + 3); } }
        if (u.pm < 2) {
            const int pos0 = col0 & 8191;
#pragma unroll
            for (int m = 0; m < 4; ++m) { const int head = 4 * u.pm + 2 * wr + (m >> 1), d = 16 * (m & 1) + fr; const float lg = log2g(head);
                f32x4 c4[2][2], s4[2][2];
#pragma unroll
                for (int bj = 0; bj < 2; ++bj)
#pragma unroll
                    for (int n = 0; n < 2; ++n) { const int pos = pos0 + bj * HALF + n * 4; c4[bj][n] = *(const f32x4*)(ctT + d * 8192 + pos); s4[bj][n] = *(const f32x4*)(stT + d * 8192 + pos); }
#pragma unroll
                for (int bj = 0; bj < 2; ++bj) { f32x4 o1[2], o2[2];
#pragma unroll
                    for (int n = 0; n < 2; ++n) { const int pos = pos0 + bj * HALF + n * 4;
                        const float jf = (float)(127 - (pos & 127)); f32x4 z;
                        z.x = __builtin_amdgcn_exp2f(jf * lg); z.y = __builtin_amdgcn_exp2f((jf - 1.0f) * lg); z.z = __builtin_amdgcn_exp2f((jf - 2.0f) * lg); z.w = __builtin_amdgcn_exp2f((jf - 3.0f) * lg);
                        const f32x4 t1 = acc[0][bj][m][n] * rsv[bj][n], t2 = acc[1][bj][m][n] * rsv[bj][n];
                        o1[n] = (t1 * c4[bj][n] - t2 * s4[bj][n]) * z; o2[n] = (t1 * s4[bj][n] + t2 * c4[bj][n]) * z; }
                    *(u32x4*)(KZT + (size_t)(head * 64 + d) * TT + col0 + bj * HALF) = pack8(o1[0], o1[1]);
                    *(u32x4*)(KZT + (size_t)(head * 64 + 32 + d) * TT + col0 + bj * HALF) = pack8(o2[0], o2[1]); }
                asm volatile("" ::: "memory"); }
        } else {
#pragma unroll
            for (int ai = 0; ai < 2; ++ai)
#pragma unroll
                for (int m = 0; m < 4; ++m) { const int r = (u.pm - 2) * BM + ai * HALF + wr * 64 + m * 16 + fr;
#pragma unroll
                    for (int bj = 0; bj < 2; ++bj) *(u32x4*)(VT + (size_t)r * TT + col0 + bj * HALF) = pack8(acc[ai][bj][m][0] * rsv[bj][0], acc[ai][bj][m][1] * rsv[bj][1]); }
        }
    }
};
struct EpiStore {
    static constexpr bool PERM = true, AFTER_DRAIN = false;
    bf16_t* O; int ld; float sc;
    __device__ __forceinline__ void operator()(const f32x4 (&acc)[2][2][4][2], const Unit& u, int wr, int wc, int fr, int fq) const {
        asm volatile("" : "+v"(fr));
        const int row0 = u.pm * BM + wr * 64 + fr, col0 = u.pn * BM + wc * 32 + fq * 8;
#pragma unroll
        for (int ai = 0; ai < 2; ++ai)
#pragma unroll
            for (int m = 0; m < 4; ++m) { bf16_t* rowp = O + (size_t)(row0 + ai * HALF + m * 16) * ld + col0;
#pragma unroll
                for (int bj = 0; bj < 2; ++bj) *(u32x4*)(rowp + bj * HALF) = pack8(acc[ai][bj][m][0] * sc, acc[ai][bj][m][1] * sc); }
    }
};
template <bool ADD> struct EpiGate {
    static constexpr bool PERM = true, AFTER_DRAIN = false;
    const bf16_t* G; bf16_t* O; float sc;
    __device__ __forceinline__ void operator()(const f32x4 (&acc)[2][2][4][2], const Unit& u, int wr, int wc, int fr, int fq) const {
        asm volatile("" : "+v"(fr));
        const int row0 = u.pm * BM + wr * 64 + fr, col0 = u.pn * BM + wc * 32 + fq * 8;
        const float isc = __builtin_amdgcn_rcpf(sc);
#pragma unroll
        for (int ai = 0; ai < 2; ++ai) {
            u32x4 gg[4][2], oo[4][2];
#pragma unroll
            for (int m = 0; m < 4; ++m) { const size_t off = (size_t)(row0 + ai * HALF + m * 16) * 1024 + col0;
#pragma unroll
                for (int bj = 0; bj < 2; ++bj) { gg[m][bj] = *(const u32x4*)(G + off + bj * HALF); if (ADD) oo[m][bj] = *(const u32x4*)(O + off + bj * HALF); } }
#pragma unroll
            for (int m = 0; m < 4; ++m) { const size_t off = (size_t)(row0 + ai * HALF + m * 16) * 1024 + col0;
#pragma unroll
                for (int bj = 0; bj < 2; ++bj) { const u32x4 g = gg[m][bj];
                    f32x4 o0 = acc[ai][bj][m][0] * ksig4(bf_lo4(g.x, g.y) * -kLog2e, isc), o1 = acc[ai][bj][m][1] * ksig4(bf_lo4(g.z, g.w) * -kLog2e, isc);
                    if (ADD) { const u32x4 p = oo[m][bj]; o0 = o0 + bf_lo4(p.x, p.y); o1 = o1 + bf_lo4(p.z, p.w); }
                    *(u32x4*)(O + off + bj * HALF) = pack8(o0, o1); } }
            asm volatile("" ::: "memory"); }
    }
};
template <bool PLE, bool W8 = false, bool A8 = false> struct EpiRes {
    static constexpr bool PERM = true, AFTER_DRAIN = false;
    const bf16_t* XI; bf16_t* XO; float* part_out; const float* part_in; const bf16_t* PP; unsigned char* X8; float sc;
    __device__ __forceinline__ void operator()(const f32x4 (&acc)[2][2][4][2], const Unit& u, int wr, int wc, int fr, int fq) const {
        asm volatile("" : "+v"(fr));
        const int row0 = u.pm * BM + wr * 64 + fr, col0 = u.pn * BM + wc * 32 + fq * 8;
        const float isc = PLE ? __builtin_amdgcn_rcpf(sc) : 1.0f; (void)isc;
#pragma unroll
        for (int ai = 0; ai < 2; ++ai) {
            u32x4 xi[4][2], pp[4][2]; float rs[4];
#pragma unroll
            for (int m = 0; m < 4; ++m) { const size_t off = (size_t)(row0 + ai * HALF + m * 16) * 1024 + col0;
#pragma unroll
                for (int bj = 0; bj < 2; ++bj) { xi[m][bj] = *(const u32x4*)(XI + off + bj * HALF); if (PLE) pp[m][bj] = *(const u32x4*)(PP + off + bj * HALF); }
                rs[m] = 1.0f; if (PLE) rs[m] = row_rs4(part_in, row0 + ai * HALF + m * 16, fq); }
#pragma unroll
            for (int m = 0; m < 4; ++m) { const int row = row0 + ai * HALF + m * 16; const size_t off = (size_t)row * 1024 + col0; float ss = 0.f;
#pragma unroll
                for (int bj = 0; bj < 2; ++bj) { f32x4 x0 = bf_lo4(xi[m][bj].x, xi[m][bj].y), x1 = bf_lo4(xi[m][bj].z, xi[m][bj].w);
                    if (PLE) { const float nrl = -rs[m] * (A8 ? kLog2e / 64.0f : kLog2e); x0 = x0 + ksig4(acc[ai][bj][m][0] * nrl, isc) * bf_lo4(pp[m][bj].x, pp[m][bj].y); x1 = x1 + ksig4(acc[ai][bj][m][1] * nrl, isc) * bf_lo4(pp[m][bj].z, pp[m][bj].w); }
                    else { x0 = x0 + acc[ai][bj][m][0] * sc; x1 = x1 + acc[ai][bj][m][1] * sc; }
                    *(u32x4*)(XO + off + bj * HALF) = pack8(x0, x1);
                    if constexpr (W8) { f32x2 w; w.x = __uint_as_float((unsigned)__builtin_amdgcn_cvt_pk_fp8_f32(x0.z, x0.w, __builtin_amdgcn_cvt_pk_fp8_f32(x0.x, x0.y, 0, false), true));
                        w.y = __uint_as_float((unsigned)__builtin_amdgcn_cvt_pk_fp8_f32(x1.z, x1.w, __builtin_amdgcn_cvt_pk_fp8_f32(x1.x, x1.y, 0, false), true)); *(f32x2*)(X8 + off + bj * HALF) = w; }
                    ss += ((x0.x * x0.x + x0.y * x0.y) + (x0.z * x0.z + x0.w * x0.w)) + ((x1.x * x1.x + x1.y * x1.y) + (x1.z * x1.z + x1.w * x1.w)); }
                ss += __shfl_xor(ss, 16); ss += __shfl_xor(ss, 32);
                if (fq == 0) part_out[(size_t)row * 16 + u.pn * 4 + wc] = ss; }
            asm volatile("" ::: "memory"); }
    }
};
template <bool SLOT, bool F8 = SLOT> struct EpiSwi {
    static constexpr bool PERM = true, AFTER_DRAIN = false;
    const float* part; const float* rsx; bf16_t* O; int ld;
    __device__ __forceinline__ void operator()(const f32x4 (&acc)[2][2][4][2], const Unit& u, int wr, int wc, int fr, int fq) const {
        asm volatile("" : "+v"(fr));
        const int row0 = u.pm * BM + wr * 64 + fr;
        float rsa[2][4];
        if constexpr (SLOT) {
#pragma unroll
            for (int ai = 0; ai < 2; ++ai)
#pragma unroll
                for (int m = 0; m < 4; ++m) rsa[ai][m] = rsx[row0 + ai * HALF + m * 16];
#pragma unroll
            for (int ai = 0; ai < 2; ++ai)
#pragma unroll
                for (int m = 0; m < 4; ++m) rsa[ai][m] *= (1.0f / 64.0f);
        } else { rows_rs8(part, row0, fq, rsa);
            if constexpr (F8) {
#pragma unroll
                for (int ai = 0; ai < 2; ++ai)
#pragma unroll
                    for (int m = 0; m < 4; ++m) rsa[ai][m] *= (1.0f / 64.0f); } }
#pragma unroll
        for (int ai = 0; ai < 2; ++ai)
#pragma unroll
            for (int m = 0; m < 4; ++m) { const int row = row0 + ai * HALF + m * 16; const float rs = rsa[ai][m];
                const float nrl = -rs * kLog2e, ic = __builtin_amdgcn_rcpf(rs * rs * (F8 ? 4.0f : 1.0f));
                const f32x4 ag0 = acc[ai][0][m][0], ag1 = acc[ai][0][m][1];
                const f32x4 t0 = ag0 * nrl, t1 = ag1 * nrl; f32x4 e0, e1;
                e0.x = __builtin_amdgcn_exp2f(t0.x); e0.y = __builtin_amdgcn_exp2f(t0.y); e0.z = __builtin_amdgcn_exp2f(t0.z); e0.w = __builtin_amdgcn_exp2f(t0.w);
                e1.x = __builtin_amdgcn_exp2f(t1.x); e1.y = __builtin_amdgcn_exp2f(t1.y); e1.z = __builtin_amdgcn_exp2f(t1.z); e1.w = __builtin_amdgcn_exp2f(t1.w);
                const f32x4 d0 = e0 * ic + ic, d1 = e1 * ic + ic; f32x4 r0, r1;
                r0.x = __builtin_amdgcn_rcpf(d0.x); r0.y = __builtin_amdgcn_rcpf(d0.y); r0.z = __builtin_amdgcn_rcpf(d0.z); r0.w = __builtin_amdgcn_rcpf(d0.w);
                r1.x = __builtin_amdgcn_rcpf(d1.x); r1.y = __builtin_amdgcn_rcpf(d1.y); r1.z = __builtin_amdgcn_rcpf(d1.z); r1.w = __builtin_amdgcn_rcpf(d1.w);
                const f32x4 q0 = (ag0 * acc[ai][1][m][0]) * r0, q1 = (ag1 * acc[ai][1][m][1]) * r1;
                if constexpr (F8) { const f32x4 h0 = q0, h1 = q1; f32x2 w;
                    w.x = __uint_as_float((unsigned)__builtin_amdgcn_cvt_pk_fp8_f32(h0.z, h0.w, __builtin_amdgcn_cvt_pk_fp8_f32(h0.x, h0.y, 0, false), true));
                    w.y = __uint_as_float((unsigned)__builtin_amdgcn_cvt_pk_fp8_f32(h1.z, h1.w, __builtin_amdgcn_cvt_pk_fp8_f32(h1.x, h1.y, 0, false), true));
                    *(f32x2*)((unsigned char*)O + (size_t)row * ld + u.pn * 128 + wc * 32 + fq * 8) = w; }
                else *(u32x4*)(O + (size_t)row * ld + u.pn * 128 + wc * 32 + fq * 8) = pack8(q0, q1); }
    }
};
struct MoeOrder : StaticOrder {
    const int* blk_e; int ntile;
    __device__ bool next(int i, Unit& u) const { if (!StaticOrder::next(i, u)) return false; u.pb = blk_e[u.pm] * ntile + u.pn; return true; }
};
}

#define GAS __attribute__((address_space(1)))
#define LAS __attribute__((address_space(3)))
typedef unsigned short bf16;
typedef unsigned v4u __attribute__((ext_vector_type(4)));
typedef float f32x4 __attribute__((ext_vector_type(4)));
typedef short bf16x8 __attribute__((ext_vector_type(8)));
typedef GAS unsigned gu32;
typedef GAS unsigned long long gu64;
#define RLX_AGENT __ATOMIC_RELAXED, __HIP_MEMORY_SCOPE_AGENT
#define LDS_WAIT() asm volatile("s_waitcnt lgkmcnt(0)" ::: "memory")
#define VM_WAIT() asm volatile("s_waitcnt vmcnt(0)" ::: "memory")
__device__ __forceinline__ unsigned long long rt() { return __builtin_amdgcn_s_memrealtime(); }
__device__ __forceinline__ unsigned f2bf(float f) { unsigned u = __builtin_bit_cast(unsigned, f); return (u + 0x7fffu + ((u >> 16) & 1u)) >> 16; }
__device__ __forceinline__ unsigned pk2(float lo, float hi) { return f2bf(lo) | (f2bf(hi) << 16); }

#define XB_TMO      128
#define XB_XCNT(j)  (256  + 64 * (j))
#define XB_XSUB(j)  (1280 + 64 * (j))
#define XB_XGEN(j)  (2304 + 64 * (j))
#define XB_TOP      3328
#define XB_TOPGEN   3392
#define XCD_BAR_WORDS 3456
#define XB_SPIN_CAP (1u << 18)

__device__ __forceinline__ unsigned xb_ld(unsigned* p)              { return __hip_atomic_load(p, __ATOMIC_RELAXED, __HIP_MEMORY_SCOPE_AGENT); }
__device__ __forceinline__ unsigned xb_add(unsigned* p, unsigned v) { return __hip_atomic_fetch_add(p, v, __ATOMIC_RELAXED, __HIP_MEMORY_SCOPE_AGENT); }
__device__ __forceinline__ unsigned xb_xcc_id() { return (unsigned)__builtin_amdgcn_s_getreg((3 << 11) | 20) & 0xFu; }
#define XB_SPIN(cond, bar) do { unsigned _sp = 0; while (cond) { __builtin_amdgcn_s_sleep(1); \
    if ((++_sp & 255u) == 0u) { if (xb_ld(&(bar)[XB_TMO])) break; if (_sp > XB_SPIN_CAP) { atomicAdd(&(bar)[XB_TMO], 1u); break; } } } } while (0)

struct XcdBarrier {
    unsigned* bar; unsigned x;
    volatile LAS unsigned* st;
};

__device__ __forceinline__ XcdBarrier xcd_barrier_post(unsigned* bar, volatile LAS unsigned* st) {
    XcdBarrier b; b.bar = bar; b.x = xb_xcc_id(); b.st = st;
    if (threadIdx.x == 0) (void)xb_add(&bar[XB_XCNT(b.x)], 1u);
    return b;
}
__device__ __forceinline__ void xcd_barrier_complete(unsigned* bar, unsigned x, unsigned& nloc, unsigned& nx) {
    const unsigned G = gridDim.x * gridDim.y * gridDim.z;
    unsigned sum, cnt, mine, sp = 0u;
    for (;;) {
        sum = 0u; cnt = 0u; mine = 0u;
#pragma unroll 1
        for (unsigned j = 0; j < 16; ++j) { const unsigned c = xb_ld(&bar[XB_XCNT(j)]); sum += c; cnt += (c > 0u) ? 1u : 0u; mine = (j == x) ? c : mine; }
        if (sum == G) break;
        __builtin_amdgcn_s_sleep(1);
        if ((++sp & 255u) == 0u) { if (xb_ld(&bar[XB_TMO])) break; if (sp > XB_SPIN_CAP) { atomicAdd(&bar[XB_TMO], 1u); break; } }
    }
    nloc = mine > 0u ? mine : 1u; nx = cnt > 0u ? cnt : 1u;
}

__device__ __forceinline__ void xcd_barrier(const XcdBarrier& b) {
    asm volatile("s_waitcnt vmcnt(0)" ::: "memory");
    __syncthreads();
    if (threadIdx.x == 0) {
        unsigned* bar = b.bar;
        __builtin_amdgcn_s_waitcnt(0);
        unsigned nloc = b.st[0], nx = b.st[1];
        if (nloc == 0u) { xcd_barrier_complete(bar, b.x, nloc, nx); b.st[0] = nloc; b.st[1] = nx; }
        const unsigned old = xb_add(&bar[XB_XSUB(b.x)], 1u);
        const unsigned gen = old / nloc;
        if (old + 1u == (gen + 1u) * nloc) {
            __builtin_amdgcn_fence(__ATOMIC_RELEASE, "agent");
            asm volatile("s_waitcnt vmcnt(0)" ::: "memory");
            const unsigned og = xb_add(&bar[XB_TOP], 1u);
            const unsigned tg = og / nx;
            if (og + 1u == (tg + 1u) * nx) xb_add(&bar[XB_TOPGEN], 1u);
            else XB_SPIN(xb_ld(&bar[XB_TOPGEN]) == tg, bar);
            __builtin_amdgcn_fence(__ATOMIC_ACQUIRE, "agent");
            xb_add(&bar[XB_XGEN(b.x)], 1u);
            asm volatile("s_waitcnt vmcnt(0)" ::: "memory");
        } else {
            XB_SPIN(xb_ld(&bar[XB_XGEN(b.x)]) == gen, bar);
            __builtin_amdgcn_fence(__ATOMIC_ACQUIRE, "agent");
            asm volatile("s_waitcnt vmcnt(0)" ::: "memory");
        }
    }
    __syncthreads();
}


constexpr int NWAVES = 8;
constexpr int T = 32768, D = 1024, SEQ = 8192, DEPTH = 4, PLE_DIM = 256, CONV_DIM = 512, CONV_W = 31, RH = 8, RDK = 64, RDV = 128, RC = 128;
constexpr int DFF = 2816, NEXP = 8, EFF = 3584, IN_COLS = 6144;
constexpr int NCH = SEQ / RC;
constexpr int NUNIT = (T / RC) * RH;
constexpr int MOE_ROWS = 67584;
constexpr float EPS = 1e-6f;

constexpr size_t MiB = 1u << 20;
constexpr size_t WS_CTL = 0, CTL_ZERO_BYTES = 1 * MiB;
constexpr size_t WS_COS = 1 * MiB, WS_SIN = 2 * MiB, WS_COST = 3 * MiB, WS_SINT = 4 * MiB;
constexpr size_t WS_PART = 5 * MiB, WS_PARTN = 9 * MiB;
constexpr size_t WS_MOE = 7 * MiB;
constexpr size_t MO_TOKE = 0, MO_TOKG = 256 * 1024, MO_TOKRS = 512 * 1024, MO_SLOT = 640 * 1024, MO_RSX = 896 * 1024, MO_CNT = 1280 * 1024, MO_BLK = 1296 * 1024;
constexpr size_t WS_WIN = 16 * MiB, WS_WKVT = 56 * MiB, WS_WCO = 68 * MiB, WS_WRO = 72 * MiB, WS_WO = 80 * MiB, WS_WDGU = 88 * MiB, WS_WDD = 110 * MiB, WS_WPG = 121 * MiB, WS_WPP = 129 * MiB;
constexpr size_t WS_WEGU = 131 * MiB, WS_WED = 187 * MiB;
constexpr size_t WS_XB = 215 * MiB, WS_PB = 279 * MiB, WS_XBN = 343 * MiB, WS_ACT = 407 * MiB;
constexpr size_t WS_Z = WS_ACT, WS_Q = WS_ACT + 32 * MiB, WS_K = WS_ACT + 64 * MiB, WS_KZT = WS_ACT + 96 * MiB, WS_VT = WS_ACT + 128 * MiB, WS_SG = WS_ACT + 192 * MiB, WS_SGA = WS_ACT + 256 * MiB,
                 WS_SGB = WS_ACT + 320 * MiB, WS_C = WS_ACT + 384 * MiB, WS_KVT = WS_ACT + 416 * MiB, WS_ST = WS_ACT + 480 * MiB, WS_MG = WS_ACT + 512 * MiB;
constexpr size_t WS_FA = WS_ACT, WS_XB8 = WS_ACT + 96 * MiB;
constexpr size_t WS_XG = WS_ACT, WS_EA = WS_ACT + 132 * MiB;
constexpr size_t WS_XBN8 = WS_MG;
constexpr size_t WS_PP = WS_ACT;
constexpr size_t WS_X8F = WS_C;
constexpr size_t WS_WIN8G0 = WS_WIN + 15 * MiB;
static_assert(!A0G8 || INPROJ8_LAYER == 1, "A0G8 layout");
constexpr size_t WS_END = WS_MG + 64 * MiB;
static_assert(WS_EA + 231 * MiB <= WS_END && WS_FA + 176 * MiB <= WS_END && WS_FA + 88 * MiB <= WS_XB8 && WS_XB8 + 32 * MiB <= WS_MG && WS_END == 983 * MiB, "ws map");
constexpr int CW_TMO = 0, CW_BAR = 4096;

constexpr int RING_OFF = 0, RING_BYTES = 131072;
constexpr int LDSCTL_OFF = RING_BYTES, MISC_OFF = LDSCTL_OFF + 320, PTAB_OFF = LDSCTL_OFF + 512, JOB_OFF = LDSCTL_OFF + 1024;
constexpr int LDS_BYTES = 147456;

__device__ __forceinline__ float wave_sum(float v) {
#pragma unroll
    for (int o = 1; o < 64; o <<= 1) v += __shfl_xor(v, o);
    return v;
}
using pg8::sigm; using pg8::log2g; using pg8::kLog2e;

__device__ __forceinline__ void job_map(int map, int b, int& col, bool& second) {
    const int t = b >> 3, jb = b & 7; second = false;
    if (map == 0) { col = 32 * b; }
    else if (map == 1) {
        if (t < 4) col = (jb < 4 ? 0 : 512) + 128 * t + 32 * (jb & 3);
        else if (t < 8) { const int base = 1024 + 512 * ((t - 4) >> 1), head = 4 * ((t - 4) & 1) + (jb & 3); col = base + head * 64 + (jb < 4 ? 0 : 32); }
        else col = 3072 + 256 * (t - 8) + 32 * jb;
    } else if (map == 2) {
        if (t < 2) { const int head = 4 * t + (jb & 3); col = 1536 + head * 64 + (jb < 4 ? 0 : 32); }
        else col = 2048 + 256 * (t - 2) + 32 * jb;
    } else { second = jb >= 4; col = 128 * t + 32 * (jb & 3); }
}
template <bool F8 = false> __device__ __forceinline__ void conv_item(const float* src, const float* src2, const float* gain, bf16* WT, int ldw, int K, int NB64, int map, int r, LAS float* scr, int lane) {
    const int kb = r / NB64, b64 = r % NB64, k0 = 64 * kb, rr = lane >> 4, c4 = lane & 15;
    int col; bool second; job_map(map, 2 * b64 + (c4 >> 3), col, second);
    const float* W = (second ? src2 : src) + col + 4 * (c4 & 7);
    f32x4 v[16];
#pragma unroll
    for (int i = 0; i < 16; ++i) v[i] = *(const GAS f32x4*)(W + (size_t)(k0 + 4 * i + rr) * ldw);
#pragma unroll
    for (int i = 0; i < 16; ++i) { float gsc = F8 ? 64.0f : 1.0f; if (gain) gsc *= gain[k0 + 4 * i + rr]; *(LAS f32x4*)(scr + (4 * i + rr) * 64 + 4 * c4) = v[i] * gsc; }
    LDS_WAIT(); asm volatile("" ::: "memory");
#pragma unroll
    for (int kc = 0; kc < 8; ++kc) { float t[8];
#pragma unroll
        for (int q = 0; q < 8; ++q) t[q] = scr[(8 * kc + q) * 64 + lane];
        if constexpr (F8) { typedef unsigned u2v __attribute__((ext_vector_type(2))); u2v o;
            o.x = (unsigned)__builtin_amdgcn_cvt_pk_fp8_f32(t[2], t[3], __builtin_amdgcn_cvt_pk_fp8_f32(t[0], t[1], 0, false), true);
            o.y = (unsigned)__builtin_amdgcn_cvt_pk_fp8_f32(t[6], t[7], __builtin_amdgcn_cvt_pk_fp8_f32(t[4], t[5], 0, false), true);
            *(GAS u2v*)((unsigned char*)WT + (size_t)(b64 * 64 + lane) * K + k0 + 8 * kc) = o; }
        else { v4u o; o.x = pk2(t[0], t[1]); o.y = pk2(t[2], t[3]); o.z = pk2(t[4], t[5]); o.w = pk2(t[6], t[7]);
            *(GAS v4u*)(WT + (size_t)(b64 * 64 + lane) * K + k0 + 8 * kc) = o; } }
    LDS_WAIT(); asm volatile("" ::: "memory");
}

struct Args { const float* in[23]; float* out; unsigned char* ws; int l_lo, l_hi, ph_lo, ph_hi, fused, pad; };
enum { PH_A = 0, PH_B, PH_C, PH_D, PH_E, PH_F, PH_G, PH_H, PH_G1, PH_G2, PH_CMB, PH_I, PH_N };

__device__ __forceinline__ bool ph_in(int lo, int hi, int k) { asm volatile("" : "+s"(lo), "+s"(hi)); return lo <= k && k < hi; }
__device__ __forceinline__ const float* inp_ptr(LAS unsigned char* lds, int k) {
    const volatile LAS unsigned* pt = (const volatile LAS unsigned*)(lds + PTAB_OFF) + 2 * k;
    const unsigned lo = __builtin_amdgcn_readfirstlane(pt[0]), hi = __builtin_amdgcn_readfirstlane(pt[1]);
    return (const float*)(const GAS float*)(((unsigned long long)hi << 32) | lo);
}
__global__ void __launch_bounds__(NWAVES * 64, 2) hybrid_fwd(Args args) {
    extern __shared__ __attribute__((aligned(16))) unsigned char lds_raw[];
    LAS unsigned char* lds = (LAS unsigned char*)lds_raw;
    volatile LAS unsigned* MISC = (volatile LAS unsigned*)(lds + MISC_OFF);
    const int tid0 = threadIdx.x;
    unsigned char* const ws0 = args.ws; float* const X0 = args.out;
    gu32* ctl = (gu32*)(ws0 + WS_CTL);
#define PHASE_VIEW() GAS unsigned char* wsg_ = (GAS unsigned char*)ws0; GAS float* xg_ = (GAS float*)X0; int tid = threadIdx.x, G = gridDim.x, bx = blockIdx.x; asm volatile("" : "+s"(wsg_), "+s"(xg_), "+v"(tid), "+s"(G), "+s"(bx)); \
    unsigned char* ws = (unsigned char*)wsg_; float* X = (float*)xg_;     \
    const int lane = tid & 63, wave = __builtin_amdgcn_readfirstlane(tid >> 6), gw = bx * NWAVES + wave, NGW = G * NWAVES; (void)lane; (void)wave; (void)gw; (void)NGW; \
    bf16* XB = (bf16*)(ws + WS_XB); bf16* XBN = (bf16*)(ws + WS_XBN); float* PART = (float*)(ws + WS_PART); float* PARTN = (float*)(ws + WS_PARTN); \
    (void)XB; (void)XBN; (void)PART; (void)PARTN; (void)X

    for (int u = tid0; u < (LDS_BYTES - LDSCTL_OFF) / 4; u += NWAVES * 64) ((LAS unsigned*)(lds + LDSCTL_OFF))[u] = 0u;
    __syncthreads();
    if (tid0 == 0) { LAS unsigned long long* pt = (LAS unsigned long long*)(lds + PTAB_OFF);
#pragma unroll
        for (int k = 0; k < 23; ++k) pt[k] = (unsigned long long)args.in[k]; }
    __syncthreads();
#define INP(k) inp_ptr(lds, (k))
    XcdBarrier bar; bar.bar = (unsigned*)(ctl + CW_BAR); bar.x = 0; bar.st = nullptr;
    if (args.fused) bar = xcd_barrier_post((unsigned*)(ctl + CW_BAR), MISC + 8);
#define GRID_BAR() do { if (args.fused) xcd_barrier(bar); } while (0)
    const int l_lo = args.l_lo, l_hi = args.l_hi, ph_lo = args.ph_lo, ph_hi = args.ph_hi;
#define IN(k) ph_in(ph_lo, ph_hi, (k))


    if (l_lo < 0) { PHASE_VIEW();
        {   LAS float* scr = (LAS float*)(lds + RING_OFF + wave * 16384);
            constexpr int I_IN = 16 * 80, I_KV = 16 * 24, I_CO = 8 * 16, I_SQ = 16 * 16, I_PP = 4 * 16, I_DG = 16 * 88, I_DD = 44 * 16;
            constexpr int I_LAYER = I_IN + I_KV + I_CO + 3 * I_SQ + I_PP + I_DG + I_DD;
            constexpr int I_G0 = A0G8 ? 16 * 48 : 0;
            for (int it = gw; it < DEPTH * I_LAYER + I_G0; it += NGW) {
                if (it >= DEPTH * I_LAYER) { const int q = it - DEPTH * I_LAYER, r8 = (q / 48) * 80 + 32 + q % 48;
                    conv_item<true>(INP(3), nullptr, INP(2), (bf16*)(ws + WS_WIN8G0 - (size_t)2048 * D), IN_COLS, D, 80, 1, r8, scr, lane); continue; }
                const int L = it / I_LAYER; int r = it % I_LAYER; const int j = L >> 1;
                if (r < I_IN) { if (L >= INPROJ8_LAYER) conv_item<true>(INP(3) + (size_t)L * D * IN_COLS, nullptr, INP(2) + L * D, (bf16*)(ws + WS_WIN) + (size_t)L * 5120 * D, IN_COLS, D, 80, 1, r, scr, lane);
                    else conv_item(INP(3) + (size_t)L * D * IN_COLS, nullptr, INP(2) + L * D, (bf16*)(ws + WS_WIN) + (size_t)L * 5120 * D, IN_COLS, D, 80, 1, r, scr, lane); continue; } r -= I_IN;
                if (r < I_KV) { if (L >= INPROJ8_LAYER) conv_item<true>(INP(3) + (size_t)L * D * IN_COLS, nullptr, INP(2) + L * D, (bf16*)(ws + WS_WKVT) + (size_t)L * 1536 * D, IN_COLS, D, 24, 2, r, scr, lane);
                    else conv_item(INP(3) + (size_t)L * D * IN_COLS, nullptr, INP(2) + L * D, (bf16*)(ws + WS_WKVT) + (size_t)L * 1536 * D, IN_COLS, D, 24, 2, r, scr, lane); continue; } r -= I_KV;
                if (r < I_CO) { conv_item(INP(8) + (size_t)L * CONV_DIM * D, nullptr, nullptr, (bf16*)(ws + WS_WCO) + (size_t)L * D * CONV_DIM, D, CONV_DIM, 16, 0, r, scr, lane); continue; } r -= I_CO;
                if (r < I_SQ) { conv_item(INP(9) + (size_t)L * D * D, nullptr, nullptr, (bf16*)(ws + WS_WRO) + (size_t)L * D * D, D, D, 16, 0, r, scr, lane); continue; } r -= I_SQ;
                if (r < I_SQ) { conv_item(INP(10) + (size_t)L * D * D, nullptr, nullptr, (bf16*)(ws + WS_WO) + (size_t)L * D * D, D, D, 16, 0, r, scr, lane); continue; } r -= I_SQ;
                if (r < I_SQ) { if (L >= PLE8_LAYER) conv_item<true>(INP(20) + (size_t)L * D * D, nullptr, INP(19) + L * D, (bf16*)(ws + WS_WPG) + (size_t)L * D * D, D, D, 16, 0, r, scr, lane);
                    else conv_item(INP(20) + (size_t)L * D * D, nullptr, INP(19) + L * D, (bf16*)(ws + WS_WPG) + (size_t)L * D * D, D, D, 16, 0, r, scr, lane); continue; } r -= I_SQ;
                if (r < I_PP) { conv_item(INP(21) + (size_t)L * PLE_DIM * D, nullptr, nullptr, (bf16*)(ws + WS_WPP) + (size_t)L * D * PLE_DIM, D, PLE_DIM, 16, 0, r, scr, lane); continue; } r -= I_PP;
                if (L & 1) continue;
                if (r < I_DG) { if (L == 2) conv_item<true>(INP(12) + (size_t)j * D * DFF, INP(13) + (size_t)j * D * DFF, INP(11) + L * D, (bf16*)(ws + WS_WDGU) + (size_t)j * 2 * DFF * D, DFF, D, 88, 3, r, scr, lane);
                    else conv_item(INP(12) + (size_t)j * D * DFF, INP(13) + (size_t)j * D * DFF, INP(11) + L * D, (bf16*)(ws + WS_WDGU) + (size_t)j * 2 * DFF * D, DFF, D, 88, 3, r, scr, lane); continue; } r -= I_DG;
                if (L == 2) conv_item<true>(INP(14) + (size_t)j * DFF * D, nullptr, nullptr, (bf16*)(ws + WS_WDD) + (size_t)j * D * DFF, D, DFF, 16, 0, r, scr, lane);
                else conv_item(INP(14) + (size_t)j * DFF * D, nullptr, nullptr, (bf16*)(ws + WS_WDD) + (size_t)j * D * DFF, D, DFF, 16, 0, r, scr, lane);
            }
        }
        for (int m = gw; m < T; m += NGW) {
            const GAS f32x4* xr = (const GAS f32x4*)(INP(0) + (size_t)m * D) + lane;
            GAS unsigned long long* o8 = (GAS unsigned long long*)(XBN + (size_t)m * D) + lane; float s = 0.f;
#pragma unroll
            for (int j = 0; j < 4; ++j) { const f32x4 v = xr[64 * j]; s += (v.x * v.x + v.y * v.y) + (v.z * v.z + v.w * v.w);
                o8[64 * j] = (unsigned long long)pk2(v.x, v.y) | ((unsigned long long)pk2(v.z, v.w) << 32);
                if (A0G8) ((GAS unsigned*)(ws + WS_XBN8 + (size_t)m * D))[64 * j + lane] = (unsigned)__builtin_amdgcn_cvt_pk_fp8_f32(v.z, v.w, __builtin_amdgcn_cvt_pk_fp8_f32(v.x, v.y, 0, false), true); }
            s = wave_sum(s);
            if (lane < 16) PARTN[(size_t)m * 16 + lane] = lane == 0 ? s : 0.f;
        }
        { const size_t n4 = (size_t)DEPTH * T * PLE_DIM / 4; const GAS f32x4* ps = (const GAS f32x4*)INP(1); GAS unsigned long long* pd = (GAS unsigned long long*)(ws + WS_PB);
          for (size_t i = (size_t)bx * 512 + tid; i < n4; i += (size_t)G * 512) { const f32x4 v = ps[i]; pd[i] = (unsigned long long)pk2(v.x, v.y) | ((unsigned long long)pk2(v.z, v.w) << 32); } }
        for (int i = bx * 512 + tid; i < SEQ * 32; i += G * 512) { const int pos = i >> 5, d = i & 31;
            const float inv = exp2f(-(float)d * 0.41524101186092029f);
            const float ang = (float)pos * inv; const double rev = (double)ang * 0.15915494309189535; const float fr = (float)(rev - rint(rev));
            const float sn = __builtin_amdgcn_sinf(fr), cs = __builtin_amdgcn_cosf(fr);
            ((float*)(ws + WS_COS))[i] = cs; ((float*)(ws + WS_SIN))[i] = sn; ((float*)(ws + WS_COST))[d * SEQ + pos] = cs; ((float*)(ws + WS_SINT))[d * SEQ + pos] = sn; }
        GRID_BAR();
    }

    if (0 >= l_lo && 0 < l_hi) { constexpr int L = 0;
        const bool moe = (L & 1) != 0; const int jl = L >> 1;
        constexpr bool INPROJ8 = (L >= INPROJ8_LAYER);
        constexpr bool PLE8 = (L >= PLE8_LAYER);
        constexpr bool DENSE8 = (L == 2);
#define MOE_VIEW() int* tok_e = (int*)(ws + WS_MOE + MO_TOKE); float* tok_g = (float*)(ws + WS_MOE + MO_TOKG); float* tok_rs = (float*)(ws + WS_MOE + MO_TOKRS); \
            int* tok_slot = (int*)(ws + WS_MOE + MO_SLOT); float* rsx = (float*)(ws + WS_MOE + MO_RSX); int* cnts = (int*)(ws + WS_MOE + MO_CNT); int* blk = (int*)(ws + WS_MOE + MO_BLK); \
            bf16* XG = (bf16*)(ws + WS_XG); bf16* EA = (bf16*)(ws + WS_EA); \
            (void)tok_e; (void)tok_g; (void)tok_rs; (void)tok_slot; (void)rsx; (void)cnts; (void)blk; (void)XG; (void)EA
#define MIX_VIEW() bf16* Zb = (bf16*)(ws + WS_Z); bf16* Qb = (bf16*)(ws + WS_Q); bf16* Kb = (bf16*)(ws + WS_K); bf16* KZT = (bf16*)(ws + WS_KZT); bf16* VT = (bf16*)(ws + WS_VT); \
        bf16* SG = (bf16*)(ws + WS_SG); bf16* SGA = (bf16*)(ws + WS_SGA); bf16* SGB = (bf16*)(ws + WS_SGB); bf16* Cb = (bf16*)(ws + WS_C); \
        float* KVT = (float*)(ws + WS_KVT); bf16* RB = (bf16*)(ws + WS_KVT); bf16* ST = (bf16*)(ws + WS_ST); bf16* MG = (bf16*)(ws + WS_MG); (void)RB; \
        (void)Zb; (void)Qb; (void)Kb; (void)KZT; (void)VT; (void)SG; (void)SGA; (void)SGB; (void)Cb; (void)KVT; (void)ST; (void)MG


        if (IN(PH_A)) { PHASE_VIEW(); MIX_VIEW();
            static_assert(WS_K - WS_Q == 2 * pg8::EpiIn::QK_STRIDE && WS_SGA - WS_SG == 2 * pg8::EpiIn::G_STRIDE && WS_SGB - WS_SGA == 2 * pg8::EpiIn::G_STRIDE, "EpiIn strides");
            if constexpr (L == 0 && A0G8 && !INPROJ8) {
              { pg8::Gemm g{(const bf16*)XBN, (const bf16*)(ws + WS_WIN), T, 2048, D}; pg8::StaticOrder S; S.init(T, 2048, G, bx);
                pg8::EpiIn E{PARTN, (const float*)(ws + WS_COS), (const float*)(ws + WS_SIN), Zb, Qb, SG, 1.0f, 0};
                pg8::gemm_phase<pg8::EpiIn, pg8::StaticOrder, true, true, 0>(lds + RING_OFF, g, S, E); }
              { pg8::Gemm g{(const bf16*)(ws + WS_XBN8), (const bf16*)(ws + WS_WIN8G0), T, 3072, D / 2}; pg8::StaticOrder S; S.init(T, 3072, G, bx);
                pg8::EpiIn E{PARTN, (const float*)(ws + WS_COS), (const float*)(ws + WS_SIN), Zb, Qb, SG, 1.0f / 64.0f, 8};
                pg8::gemm_phase<pg8::EpiIn, pg8::StaticOrder, true, true, 1>(lds + RING_OFF, g, S, E); }
            } else
            { pg8::Gemm g{INPROJ8 ? (const bf16*)(ws + WS_XBN8) : (const bf16*)XBN, (const bf16*)(ws + WS_WIN) + (size_t)L * 5120 * D, T, 5120, INPROJ8 ? D / 2 : D}; pg8::StaticOrder S; S.init(T, 5120, G, bx);
              pg8::EpiIn E{PARTN, (const float*)(ws + WS_COS), (const float*)(ws + WS_SIN), Zb, Qb, SG, INPROJ8 ? 1.0f / 64.0f : 1.0f, 0};
              pg8::gemm_phase<pg8::EpiIn, pg8::StaticOrder, true, true, INPROJ8 ? 1 : 0>(lds + RING_OFF, g, S, E); }

            { pg8::Gemm g{(const bf16*)(ws + WS_WKVT) + (size_t)L * 1536 * D, INPROJ8 ? (const bf16*)(ws + WS_XBN8) : (const bf16*)XBN, 1536, T, INPROJ8 ? D / 2 : D}; pg8::StaticOrder S; S.init(1536, T, G, bx);
              pg8::EpiKvT E{PARTN, (const float*)(ws + WS_COST), (const float*)(ws + WS_SINT), KZT, VT, INPROJ8 ? 1.0f / 64.0f : 1.0f};
              pg8::gemm_phase<pg8::EpiKvT, pg8::StaticOrder, true, true, INPROJ8 ? 1 : 0>(lds + RING_OFF, g, S, E); }
            GRID_BAR();
        }


        if (IN(PH_B)) { PHASE_VIEW(); MIX_VIEW();

            {
                const float* cw = INP(4) + (size_t)L * CONV_W * CONV_DIM; const float* cb = INP(5) + L * CONV_DIM;
                const float* lg = INP(6) + L * CONV_DIM; const float* lb = INP(7) + L * CONV_DIM;
                LAS unsigned* zt = (LAS unsigned*)(lds + RING_OFF);
                LAS float* ot = (LAS float*)(lds + RING_OFF + 65536);
                const int cp = tid & 255, half = tid >> 8;
                float w0[CONV_W], w1[CONV_W];
#pragma unroll
                for (int w = 0; w < CONV_W; ++w) { w0[w] = cw[w * CONV_DIM + 2 * cp]; w1[w] = cw[w * CONV_DIM + 2 * cp + 1]; }
                const float b0 = cb[2 * cp], b1 = cb[2 * cp + 1];
                f32x4 lg0 = *(const f32x4*)(lg + 8 * lane), lg1 = *(const f32x4*)(lg + 8 * lane + 4), lb0 = *(const f32x4*)(lb + 8 * lane), lb1 = *(const f32x4*)(lb + 8 * lane + 4);
                for (int u = bx; u < T / 32; u += G) {
                    const int tok0 = u * 32, pos0 = tok0 & (SEQ - 1);
                    for (int idx = tid; idx < 62 * 64; idx += 512) { const int r = idx >> 6, ch = idx & 63; const int pos = pos0 - 30 + r;
                        v4u v = {0u, 0u, 0u, 0u}; if (pos >= 0) v = *(const GAS v4u*)(Zb + (size_t)(tok0 - 30 + r) * CONV_DIM + ch * 8);
                        *(LAS v4u*)(zt + r * 256 + ch * 4) = v; }
                    __syncthreads();
#pragma unroll 1
                    for (int tg = 0; tg < 2; ++tg) { const int tb = 16 * half + 8 * tg;
                        float a0[8], a1[8];
#pragma unroll
                        for (int q = 0; q < 8; ++q) { a0[q] = b0; a1[q] = b1; }
#pragma unroll
                        for (int r = 0; r < 38; ++r) { const unsigned pv = zt[(tb + r) * 256 + cp]; const float f0 = __uint_as_float(pv << 16), f1 = __uint_as_float(pv & 0xffff0000u);
#pragma unroll
                            for (int q = 0; q < 8; ++q) { const int w = r - q; if (w >= 0 && w < CONV_W) { a0[q] = fmaf(w0[w], f0, a0[q]); a1[q] = fmaf(w1[w], f1, a1[q]); } } }
#pragma unroll
                        for (int q = 0; q < 8; ++q) { typedef float f2 __attribute__((ext_vector_type(2))); *(LAS f2*)(ot + (tb + q) * 512 + 2 * cp) = (f2){a0[q], a1[q]}; } }
                    __syncthreads();
#pragma unroll 1
                    for (int q = 0; q < 4; ++q) { const int tk = 4 * wave + q; const LAS f32x4* op = (const LAS f32x4*)(ot + tk * 512 + 8 * lane); f32x4 v0 = op[0], v1 = op[1];
                        const float mean = wave_sum((v0.x + v0.y) + (v0.z + v0.w) + (v1.x + v1.y) + (v1.z + v1.w)) * (1.0f / 512.0f);
                        v0 = v0 - mean; v1 = v1 - mean;
                        const float var = wave_sum((v0.x * v0.x + v0.y * v0.y) + (v0.z * v0.z + v0.w * v0.w) + (v1.x * v1.x + v1.y * v1.y) + (v1.z * v1.z + v1.w * v1.w)) * (1.0f / 512.0f);
                        const float rstd = __builtin_amdgcn_rsqf(var + EPS);
                        v0 = v0 * rstd * lg0 + lb0; v1 = v1 * rstd * lg1 + lb1;
                        v0 = v0 * pg8::sigm4(v0); v1 = v1 * pg8::sigm4(v1);
                        *(GAS v4u*)(Cb + (size_t)(tok0 + tk) * CONV_DIM + 8 * lane) = pg8::pack8(v0, v1); }
                    __syncthreads();
                }
            }

            {
                const int fr = lane & 15, g4 = lane >> 4;
                for (int u = bx; u < NUNIT; u += G) {
                    const int n = u & 63, bh = u >> 6, h = bh & 7, b = bh >> 3; const size_t tok0 = (size_t)b * SEQ + n * RC;
                    bf16x8 Bv[4], Ak[4][4];
#pragma unroll
                    for (int ks = 0; ks < 4; ++ks) Bv[ks] = *(const GAS bf16x8*)(VT + (size_t)(h * RDV + 16 * wave + fr) * T + tok0 + 32 * ks + 8 * g4);
#pragma unroll
                    for (int dkt = 0; dkt < 4; ++dkt)
#pragma unroll
                        for (int ks = 0; ks < 4; ++ks) Ak[dkt][ks] = *(const GAS bf16x8*)(KZT + (size_t)(h * RDK + 16 * dkt + fr) * T + tok0 + 32 * ks + 8 * g4);
                    f32x4 acc4[4];
#pragma unroll
                    for (int dkt = 0; dkt < 4; ++dkt) { acc4[dkt] = (f32x4){0.f, 0.f, 0.f, 0.f};
#pragma unroll
                        for (int ks = 0; ks < 4; ++ks) acc4[dkt] = __builtin_amdgcn_mfma_f32_16x16x32_bf16(Ak[dkt][ks], Bv[ks], acc4[dkt], 0, 0, 0); }
#pragma unroll
                    for (int dkt = 0; dkt < 4; ++dkt) { typedef unsigned u2 __attribute__((ext_vector_type(2))); u2 o; o.x = pk2(acc4[dkt].x, acc4[dkt].y); o.y = pk2(acc4[dkt].z, acc4[dkt].w);
                        *(GAS u2*)((bf16*)KVT + (size_t)u * (RDV * RDK) + (16 * wave + fr) * RDK + 16 * dkt + 4 * g4) = o; }
                }
            }

            if (moe) {
                __syncthreads();
                LAS float* scr = (LAS float*)(lds + RING_OFF + wave * 16384);
                constexpr int I_GU = 16 * 112, I_DN = 56 * 16, I_EXP = I_GU + I_DN;
                for (int it = gw; it < NEXP * I_EXP; it += NGW) { const int e = it / I_EXP, r = it % I_EXP; const size_t o = ((size_t)jl * NEXP + e) * D * EFF;
                    if (r < I_GU) conv_item<true>(INP(16) + o, INP(17) + o, INP(11) + L * D, (bf16*)(ws + WS_WEGU + (size_t)e * 2 * EFF * D), EFF, D, 112, 3, r, scr, lane);
                    else conv_item<true>(INP(18) + o, nullptr, nullptr, (bf16*)(ws + WS_WED + (size_t)e * D * EFF), D, EFF, 16, 0, r - I_GU, scr, lane); }
            }
            GRID_BAR();
        }


        if (IN(PH_C)) { PHASE_VIEW(); MIX_VIEW();
            {   const int gt = bx * 512 + tid;
                if (gt < 32 * 4096) { const int bh = gt >> 12, e2 = gt & 4095, h = bh & 7; const float gc = __builtin_amdgcn_exp2f(128.0f * log2g(h));
                    float s0 = 0.f, s1 = 0.f; typedef float f2 __attribute__((ext_vector_type(2)));
                    const GAS unsigned* kv = (const GAS unsigned*)((const bf16*)KVT + (size_t)bh * NCH * (RDV * RDK)) + e2; GAS unsigned* st = (GAS unsigned*)(ST + (size_t)bh * NCH * (RDV * RDK)) + e2;
                    unsigned wv[NCH];
#pragma unroll
                    for (int n = 0; n < NCH; ++n) wv[n] = kv[(size_t)n * 4096];
#pragma unroll
                    for (int n = 0; n < NCH; ++n) { const unsigned w = wv[n]; st[(size_t)n * 4096] = pk2(s0, s1); s0 = fmaf(gc, s0, __uint_as_float(w << 16)); s1 = fmaf(gc, s1, __uint_as_float(w & 0xffff0000u)); } }
            }
            GRID_BAR();
        }


        if (IN(PH_D)) { PHASE_VIEW(); MIX_VIEW();
            const int fr = lane & 15, g4 = lane >> 4;
            unsigned offK[2], offS[2], offV[2];
#pragma unroll
            for (int i = 0; i < 2; ++i) { int R, C; pg8::stage_rc(tid * 16 + i * 8192, R, C); const int Rp = (R & ~31) + pg8::perm32(R & 31);
                offK[i] = (unsigned)(Rp * 512 + C) * 2u; offS[i] = (unsigned)(R * 64 + C) * 2u; offV[i] = (unsigned)R * (unsigned)(T * 2) + (unsigned)C * 2u; }
            const unsigned ldsw = (unsigned)wave * 1024u; const int fo = pg8::lds_byte(fr, g4 * 8);
#define RD_STAGE(bufoff, gbase, voff) do { _Pragma("unroll") for (int _i = 0; _i < 2; ++_i) \
                __builtin_amdgcn_global_load_lds((const unsigned*)((const char*)(gbase) + (voff)[_i]), (LAS unsigned*)(lds + (bufoff) + ldsw + _i * 8192), 16, 0, 0); } while (0)
#define RD_ISSUE(uu, buf) do { const int n_ = (uu) & 63, bh_ = (uu) >> 6, h_ = bh_ & 7, b_ = bh_ >> 3; const size_t t0_ = (size_t)b_ * SEQ + n_ * RC; const int so_ = (buf) * 65536; \
                RD_STAGE(so_, Kb + t0_ * 512 + h_ * RDK, offK); RD_STAGE(so_ + 16384, ST + (size_t)(uu) * (RDV * RDK), offS); \
                RD_STAGE(so_ + 32768, VT + (size_t)(h_ * RDV) * T + t0_, offV); RD_STAGE(so_ + 49152, VT + (size_t)(h_ * RDV) * T + t0_ + 64, offV); } while (0)
            int cur = 0;
            typedef unsigned u2 __attribute__((ext_vector_type(2)));
            bf16x8 Bq[2], Bqn[2]; u2 gv[8], gvn[8];
#define RD_QG(uu, BQ, GV) do { const int n_ = (uu) & 63, bh_ = (uu) >> 6, h_ = bh_ & 7, b_ = bh_ >> 3; const size_t tk_ = (size_t)b_ * SEQ + n_ * RC + 16 * wave + fr; \
                _Pragma("unroll") for (int ks = 0; ks < 2; ++ks) BQ[ks] = *(const GAS bf16x8*)(Qb + tk_ * 512 + h_ * RDK + 32 * ks + 8 * g4); \
                _Pragma("unroll") for (int dvt = 0; dvt < 8; ++dvt) GV[dvt] = *(const GAS u2*)(SG + tk_ * 1024 + h_ * RDV + 16 * dvt + 4 * g4); } while (0)
            if (bx < NUNIT) { RD_ISSUE(bx, 0); RD_QG(bx, Bq, gv); }
            for (int u = bx; u < NUNIT; u += G, cur ^= 1) {
                const int n = u & 63, bh = u >> 6, h = bh & 7, b = bh >> 3; const size_t tok0 = (size_t)b * SEQ + n * RC; const float lg = log2g(h);
                const size_t tok = tok0 + 16 * wave + fr;
                const int un = u + G;
                if (un < NUNIT) { RD_ISSUE(un, cur ^ 1); RD_QG(un, Bqn, gvn); asm volatile("s_waitcnt vmcnt(18)" ::: "memory"); } else { asm volatile("s_waitcnt vmcnt(0)" ::: "memory"); }
                __builtin_amdgcn_s_barrier(); asm volatile("" ::: "memory");
                const LAS unsigned char* sb = lds + cur * 65536 + fo;
                f32x4 oT[8], cT[8];
#pragma unroll
                for (int dvt = 0; dvt < 8; ++dvt) { oT[dvt] = (f32x4){0.f, 0.f, 0.f, 0.f}; cT[dvt] = (f32x4){0.f, 0.f, 0.f, 0.f}; }
#pragma unroll
                for (int t2 = 0; t2 < 4; ++t2) {
                    if (2 * t2 <= wave) {
                        unsigned P[2][2];
#pragma unroll
                        for (int nn = 0; nn < 2; ++nn) { f32x4 sv = {0.f, 0.f, 0.f, 0.f};
#pragma unroll
                            for (int ks = 0; ks < 2; ++ks) { const bf16x8 Ak = *(const LAS bf16x8*)(sb + (2 * t2 + nn) * 2048 + ks * 1024);
                                sv = __builtin_amdgcn_mfma_f32_16x16x32_bf16(Ak, Bq[ks], sv, 0, 0, 0); }
                            const int dd = (16 * wave + fr) - (32 * t2 + 8 * g4 + 4 * nn);
                            const float d0 = dd >= 0 ? sv.x * __builtin_amdgcn_exp2f((float)dd * lg) : 0.f, d1 = dd >= 1 ? sv.y * __builtin_amdgcn_exp2f((float)(dd - 1) * lg) : 0.f;
                            const float d2 = dd >= 2 ? sv.z * __builtin_amdgcn_exp2f((float)(dd - 2) * lg) : 0.f, d3 = dd >= 3 ? sv.w * __builtin_amdgcn_exp2f((float)(dd - 3) * lg) : 0.f;
                            P[nn][0] = pg8::cvt_pk_bf16(d0, d1); P[nn][1] = pg8::cvt_pk_bf16(d2, d3); }
                        v4u bp; bp.x = P[0][0]; bp.y = P[0][1]; bp.z = P[1][0]; bp.w = P[1][1];
                        const bf16x8 Bp = __builtin_bit_cast(bf16x8, bp);
                        const LAS unsigned char* vb = sb + 32768 + (t2 >> 1) * 16384 + (t2 & 1) * 1024;
#pragma unroll
                        for (int dvt = 0; dvt < 8; ++dvt) { const bf16x8 Av = *(const LAS bf16x8*)(vb + dvt * 2048);
                            oT[dvt] = __builtin_amdgcn_mfma_f32_16x16x32_bf16(Av, Bp, oT[dvt], 0, 0, 0); }
                    }
                }
#pragma unroll
                for (int dvt = 0; dvt < 8; ++dvt)
#pragma unroll
                    for (int ks = 0; ks < 2; ++ks) { const bf16x8 As = *(const LAS bf16x8*)(sb + 16384 + dvt * 2048 + ks * 1024);
                        cT[dvt] = __builtin_amdgcn_mfma_f32_16x16x32_bf16(As, Bq[ks], cT[dvt], 0, 0, 0); }
                const float xi = __builtin_amdgcn_exp2f((float)(16 * wave + fr + 1) * lg);
                float sm = 0.f;
#pragma unroll
                for (int dvt = 0; dvt < 8; ++dvt) { oT[dvt] = oT[dvt] + cT[dvt] * xi; sm += (oT[dvt].x + oT[dvt].y) + (oT[dvt].z + oT[dvt].w); }
                sm += __shfl_xor(sm, 16); sm += __shfl_xor(sm, 32);
                const float mean = sm * (1.0f / 128.0f); float sq = 0.f;
#pragma unroll
                for (int dvt = 0; dvt < 8; ++dvt) { oT[dvt] = oT[dvt] - mean; sq += (oT[dvt].x * oT[dvt].x + oT[dvt].y * oT[dvt].y) + (oT[dvt].z * oT[dvt].z + oT[dvt].w * oT[dvt].w); }
                sq += __shfl_xor(sq, 16); sq += __shfl_xor(sq, 32);
                const float rstd = __builtin_amdgcn_rsqf(sq * (1.0f / 128.0f) + EPS);
#pragma unroll
                for (int dvt = 0; dvt < 8; ++dvt) { const f32x4 graw = pg8::bf_lo4(gv[dvt].x, gv[dvt].y), gf = graw * pg8::sigm4(graw);
                    const f32x4 r = oT[dvt] * rstd * gf; u2 o; o.x = pg8::cvt_pk_bf16(r.x, r.y); o.y = pg8::cvt_pk_bf16(r.z, r.w); *(GAS u2*)(RB + tok * 1024 + h * RDV + 16 * dvt + 4 * g4) = o; }
                asm volatile("s_waitcnt lgkmcnt(0)" ::: "memory"); __builtin_amdgcn_s_barrier(); asm volatile("" ::: "memory");
#pragma unroll
                for (int ks = 0; ks < 2; ++ks) Bq[ks] = Bqn[ks];
#pragma unroll
                for (int dvt = 0; dvt < 8; ++dvt) gv[dvt] = gvn[dvt];
            }
#undef RD_QG
#undef RD_ISSUE
#undef RD_STAGE
            GRID_BAR();
        }


        if (IN(PH_E)) { PHASE_VIEW(); MIX_VIEW();
            { pg8::Gemm g{Cb, (const bf16*)(ws + WS_WCO) + (size_t)L * D * CONV_DIM, T, D, CONV_DIM}; pg8::StaticOrder S; S.init(T, D, G, bx);
              pg8::EpiGate<false> E{SGA, MG, 1.0f};
              pg8::gemm_phase<pg8::EpiGate<false>, pg8::StaticOrder, true, true>(lds + RING_OFF, g, S, E); }
            { pg8::Gemm g{RB, (const bf16*)(ws + WS_WRO) + (size_t)L * D * D, T, D, D}; pg8::StaticOrder S; S.init(T, D, G, bx);
              pg8::EpiGate<true> E{SGB, MG, SC_E};
              pg8::gemm_phase<pg8::EpiGate<true>, pg8::StaticOrder, true, true>(lds + RING_OFF, g, S, E); }
            GRID_BAR();
        }


        if (IN(PH_F)) { PHASE_VIEW(); MIX_VIEW();
            pg8::Gemm g{MG, (const bf16*)(ws + WS_WO) + (size_t)L * D * D, T, D, D}; pg8::StaticOrder S; S.init(T, D, G, bx);
            pg8::EpiRes<false, DENSE8> E{XBN, XB, PART, nullptr, nullptr, ws + WS_XB8, SC_F};
            pg8::gemm_phase<pg8::EpiRes<false, DENSE8>, pg8::StaticOrder, true, true>(lds + RING_OFF, g, S, E);
            GRID_BAR();
        }

        if (!moe) {

            if (IN(PH_G)) { PHASE_VIEW(); MOE_VIEW();
                pg8::Gemm g{DENSE8 ? (const bf16*)(ws + WS_XB8) : (const bf16*)XB, (const bf16*)(ws + WS_WDGU) + (size_t)jl * 2 * DFF * D, T, 2 * DFF, DENSE8 ? D / 2 : D}; pg8::StaticOrder S; S.init(T, 2 * DFF, G, bx);
                pg8::EpiSwi<false, DENSE8> E{PART, nullptr, (bf16*)(ws + WS_FA), DFF};
                pg8::gemm_phase<pg8::EpiSwi<false, DENSE8>, pg8::StaticOrder, true, true, DENSE8 ? 1 : 0>(lds + RING_OFF, g, S, E);
                GRID_BAR();
            }

            if (IN(PH_H)) { PHASE_VIEW(); MOE_VIEW();
                pg8::Gemm g{(const bf16*)(ws + WS_FA), (const bf16*)(ws + WS_WDD) + (size_t)jl * D * DFF, T, D, DENSE8 ? DFF / 2 : DFF}; pg8::StaticOrder S; S.init(T, D, G, bx, 1);
                pg8::EpiRes<false, PLE8> E{XB, XB, PART, nullptr, nullptr, ws + WS_X8F, SC_Hd * (DENSE8 ? 1.0f / 256.0f : 1.0f)};
                pg8::gemm_phase<pg8::EpiRes<false, PLE8>, pg8::StaticOrder, true, true, DENSE8 ? 1 : 0>(lds + RING_OFF, g, S, E);
                GRID_BAR();
            }
        } else {

            if (IN(PH_G)) { PHASE_VIEW(); MOE_VIEW();
                LAS float* wrT = (LAS float*)(lds + RING_OFF);
                LAS int* lcnt = (LAS int*)(lds + RING_OFF + 32768);
                const float* wr = INP(15) + (size_t)jl * D * NEXP; const float* gf = INP(11) + L * D;
                for (int i = tid; i < D * NEXP; i += 512) { const int k = i >> 3, e = i & 7; wrT[e * 1024 + k] = wr[i] * gf[k]; }
                if (tid < 8) lcnt[tid] = 0;
                __syncthreads();
                f32x4 wreg[8][4];
#pragma unroll
                for (int e = 0; e < 8; ++e)
#pragma unroll
                    for (int j = 0; j < 4; ++j) wreg[e][j] = *(const LAS f32x4*)(wrT + e * 1024 + 256 * j + 4 * lane);
                typedef unsigned u2 __attribute__((ext_vector_type(2)));
                u2 xw[4], xwn[4];
                { const GAS u2* xr = (const GAS u2*)(XB + (size_t)(bx * 128 + wave * 16) * D) + lane;
#pragma unroll
                  for (int j = 0; j < 4; ++j) xw[j] = xr[64 * j]; }
                for (int q = 0; q < 16; ++q) { const int t = bx * 128 + wave * 16 + q;
                    if (q < 15) { const GAS u2* xr = (const GAS u2*)(XB + (size_t)(t + 1) * D) + lane;
#pragma unroll
                        for (int j = 0; j < 4; ++j) xwn[j] = xr[64 * j]; }
                    f32x4 xv[4]; float ss = 0.f;
#pragma unroll
                    for (int j = 0; j < 4; ++j) { xv[j] = pg8::bf_lo4(xw[j].x, xw[j].y); ss += (xv[j].x * xv[j].x + xv[j].y * xv[j].y) + (xv[j].z * xv[j].z + xv[j].w * xv[j].w); }
                    float pa[8];
#pragma unroll
                    for (int e = 0; e < 8; ++e) { float a = 0.f;
#pragma unroll
                        for (int j = 0; j < 4; ++j) { const f32x4 w = wreg[e][j]; a += (xv[j].x * w.x + xv[j].y * w.y) + (xv[j].z * w.z + xv[j].w * w.w); }
                        pa[e] = a; }
                    float r4[4], r2[2], r1;
                    { const bool hi = (lane & 32) != 0;
#pragma unroll
                      for (int i = 0; i < 4; ++i) { const float snd = hi ? pa[i] : pa[i + 4], kp = hi ? pa[i + 4] : pa[i]; r4[i] = kp + __shfl_xor(snd, 32); } }
                    { const bool hi = (lane & 16) != 0;
#pragma unroll
                      for (int i = 0; i < 2; ++i) { const float snd = hi ? r4[i] : r4[i + 2], kp = hi ? r4[i + 2] : r4[i]; r2[i] = kp + __shfl_xor(snd, 16); } }
                    { const bool hi = (lane & 8) != 0; const float snd = hi ? r2[0] : r2[1], kp = hi ? r2[1] : r2[0]; r1 = kp + __shfl_xor(snd, 8); }
                    r1 += __shfl_xor(r1, 4); r1 += __shfl_xor(r1, 2); r1 += __shfl_xor(r1, 1);
                    float lgt[8];
#pragma unroll
                    for (int e = 0; e < 8; ++e) lgt[e] = __int_as_float(__builtin_amdgcn_readlane(__float_as_int(r1), 8 * e));
                    ss = wave_sum(ss); const float rs = __builtin_amdgcn_rsqf(ss * (1.0f / 1024.0f) + EPS);
                    int e1 = 0; float v1 = lgt[0];
#pragma unroll
                    for (int e = 1; e < 8; ++e) if (lgt[e] > v1) { v1 = lgt[e]; e1 = e; }
                    int e2 = -1; float v2 = 0.f;
#pragma unroll
                    for (int e = 0; e < 8; ++e) if (e != e1 && (e2 < 0 || lgt[e] > v2)) { v2 = lgt[e]; e2 = e; }
                    const float ex = __builtin_amdgcn_exp2f((v2 - v1) * rs * kLog2e), g1 = 1.0f / (1.0f + ex), g2 = ex * g1;
                    if (lane == 0) { tok_e[2 * t] = e1; tok_e[2 * t + 1] = e2; tok_g[2 * t] = g1; tok_g[2 * t + 1] = g2; tok_rs[t] = rs; atomicAdd((int*)&lcnt[e1], 1); atomicAdd((int*)&lcnt[e2], 1); }
#pragma unroll
                    for (int j = 0; j < 4; ++j) xw[j] = xwn[j];
                }
                __syncthreads();
                if (tid < 8) cnts[bx * 8 + tid] = lcnt[tid];
                __syncthreads();
                GRID_BAR();
            }

            if (IN(PH_H)) { PHASE_VIEW(); MOE_VIEW();
                LAS int* lc = (LAS int*)(lds + RING_OFF);
                LAS int* base = lc + 2048;
                LAS int* lslot = base + 16;
                LAS int* le = lslot + 256;
                for (int i = tid; i < 2048; i += 512) lc[i] = cnts[i];
                if (tid < 256) le[tid] = tok_e[bx * 256 + tid];
                __syncthreads();
                {
                    int tot = 0, pre = 0;
#pragma unroll
                    for (int k = 0; k < 4; ++k) { const int wg = lane + 64 * k; const int c = lc[wg * 8 + wave]; tot += c; pre += (wg < bx) ? c : 0; }
#pragma unroll
                    for (int o = 1; o < 64; o <<= 1) { tot += __shfl_xor(tot, o); pre += __shfl_xor(pre, o); }
                    if (lane == 0) { base[wave] = pre; base[8 + wave] = tot; }
                }
                __syncthreads();
                if (tid == 0) { int ps = 0; for (int e = 0; e < 8; ++e) { const int tot = base[8 + e]; base[e] += ps; const int nb = (tot + 255) >> 8;
                        if (bx == 0) { for (int q = 0; q < nb; ++q) blk[1 + (ps >> 8) + q] = e; }
                        ps += nb << 8; }
                    if (bx == 0) blk[0] = ps >> 8; }
                __syncthreads();
                {
                    int run = base[wave];
#pragma unroll
                    for (int k = 0; k < 2; ++k) { const int i = lane + 64 * k; const int a = le[2 * i], b2 = le[2 * i + 1]; const bool f = (a == wave) || (b2 == wave);
                        const unsigned long long m = __ballot(f); const int rank = __popcll(m & ((1ull << lane) - 1ull));
                        if (f) lslot[2 * i + (a == wave ? 0 : 1)] = run + rank;
                        run += __popcll(m); }
                }
                __syncthreads();
                if (tid < 256) { const int t = bx * 128 + (tid >> 1); const int s = lslot[tid]; tok_slot[bx * 256 + tid] = s; rsx[s] = tok_rs[t]; }
                for (int p = wave; p < 256; p += 8) { const int t = bx * 128 + (p >> 1), s = lslot[p];
                    const GAS v4u* src = (const GAS v4u*)(XB + (size_t)t * D) + 2 * lane; const v4u a = src[0], b4 = src[1];
                    const f32x4 f0 = pg8::bf_lo4(a.x, a.y), f1 = pg8::bf_lo4(a.z, a.w), f2 = pg8::bf_lo4(b4.x, b4.y), f3 = pg8::bf_lo4(b4.z, b4.w); v4u o;
                    o.x = (unsigned)__builtin_amdgcn_cvt_pk_fp8_f32(f0.z, f0.w, __builtin_amdgcn_cvt_pk_fp8_f32(f0.x, f0.y, 0, false), true);
                    o.y = (unsigned)__builtin_amdgcn_cvt_pk_fp8_f32(f1.z, f1.w, __builtin_amdgcn_cvt_pk_fp8_f32(f1.x, f1.y, 0, false), true);
                    o.z = (unsigned)__builtin_amdgcn_cvt_pk_fp8_f32(f2.z, f2.w, __builtin_amdgcn_cvt_pk_fp8_f32(f2.x, f2.y, 0, false), true);
                    o.w = (unsigned)__builtin_amdgcn_cvt_pk_fp8_f32(f3.z, f3.w, __builtin_amdgcn_cvt_pk_fp8_f32(f3.x, f3.y, 0, false), true);
                    *((GAS v4u*)((unsigned char*)XG + (size_t)s * D) + lane) = o; }
                __syncthreads();
                GRID_BAR();
            }

            if (IN(PH_G1)) { PHASE_VIEW(); MOE_VIEW();
                const int nblk = blk[0];
                pg8::Gemm g{XG, (const bf16*)(ws + WS_WEGU), nblk * 256, 2 * EFF, D / 2}; pg8::MoeOrder S; S.init(nblk * 256, 2 * EFF, G, bx); S.blk_e = blk + 1; S.ntile = 2 * EFF / 256;
                pg8::EpiSwi<true> E{nullptr, rsx, EA, EFF};
                pg8::gemm_phase<pg8::EpiSwi<true>, pg8::MoeOrder, true, true, 1>(lds + RING_OFF, g, S, E);
                GRID_BAR();
            }

            if (IN(PH_G2)) { PHASE_VIEW(); MOE_VIEW();
                const int nblk = blk[0];
                pg8::Gemm g{EA, (const bf16*)(ws + WS_WED), nblk * 256, D, EFF / 2}; pg8::MoeOrder S; S.init(nblk * 256, D, G, bx, 1); S.blk_e = blk + 1; S.ntile = D / 256;
                pg8::EpiStore E{XG, D, 1.0f / 256.0f};
                pg8::gemm_phase<pg8::EpiStore, pg8::MoeOrder, true, true, 1>(lds + RING_OFF, g, S, E);
                GRID_BAR();
            }

            if (IN(PH_CMB)) { PHASE_VIEW(); MOE_VIEW();
                for (int t = gw; t < T; t += NGW) {
                    const int s1 = tok_slot[2 * t], s2 = tok_slot[2 * t + 1]; const float g1 = tok_g[2 * t], g2 = tok_g[2 * t + 1];
                    typedef unsigned u2 __attribute__((ext_vector_type(2))); GAS u2* xr = (GAS u2*)(XB + (size_t)t * D) + lane;
                    const GAS u2* y1 = (const GAS u2*)(XG + (size_t)s1 * D) + lane; const GAS u2* y2 = (const GAS u2*)(XG + (size_t)s2 * D) + lane;
                    float s = 0.f;
#pragma unroll
                    for (int j = 0; j < 4; ++j) { const u2 xw = xr[64 * j]; f32x4 v = pg8::bf_lo4(xw.x, xw.y); const u2 a = y1[64 * j], b2 = y2[64 * j];
                        v = v + (pg8::bf_lo4(a.x, a.y) * g1 + pg8::bf_lo4(b2.x, b2.y) * g2) * SC_CMB; s += (v.x * v.x + v.y * v.y) + (v.z * v.z + v.w * v.w);
                        u2 o; o.x = pk2(v.x, v.y); o.y = pk2(v.z, v.w); xr[64 * j] = o;
                        if (PLE8) ((GAS unsigned*)(ws + WS_X8F + (size_t)t * D))[64 * j + lane] = (unsigned)__builtin_amdgcn_cvt_pk_fp8_f32(v.z, v.w, __builtin_amdgcn_cvt_pk_fp8_f32(v.x, v.y, 0, false), true); }
                    s = wave_sum(s);
                    if (lane < 16) PART[(size_t)t * 16 + lane] = lane == 0 ? s : 0.f;
                }
                GRID_BAR();
            }
        }


        if (IN(PH_I)) { PHASE_VIEW(); MIX_VIEW();
            bf16* PP = (bf16*)(ws + WS_PP);
            { pg8::Gemm g{(const bf16*)(ws + WS_PB) + (size_t)L * T * PLE_DIM, (const bf16*)(ws + WS_WPP) + (size_t)L * D * PLE_DIM, T, D, PLE_DIM}; pg8::StaticOrder S; S.init(T, D, G, bx);
              pg8::EpiStore E{PP, D, 1.0f};
              pg8::gemm_phase<pg8::EpiStore, pg8::StaticOrder, true, true>(lds + RING_OFF, g, S, E); }
            { pg8::Gemm g{PLE8 ? (const bf16*)(ws + WS_X8F) : (const bf16*)XB, (const bf16*)(ws + WS_WPG) + (size_t)L * D * D, T, D, PLE8 ? D / 2 : D}; pg8::StaticOrder S; S.init(T, D, G, bx);
              pg8::EpiRes<true, (L + 1 >= INPROJ8_LAYER && L + 1 < DEPTH), PLE8> E{XB, XBN, PARTN, PART, PP, ws + WS_XBN8, SC_I};
              pg8::gemm_phase<pg8::EpiRes<true, (L + 1 >= INPROJ8_LAYER && L + 1 < DEPTH), PLE8>, pg8::StaticOrder, true, true, PLE8 ? 1 : 0>(lds + RING_OFF, g, S, E); }
            GRID_BAR();
        }
    }
    if (1 >= l_lo && 1 < l_hi) { constexpr int L = 1;
        const bool moe = (L & 1) != 0; const int jl = L >> 1;
        constexpr bool INPROJ8 = (L >= INPROJ8_LAYER);
        constexpr bool PLE8 = (L >= PLE8_LAYER);
        constexpr bool DENSE8 = (L == 2);
#define MOE_VIEW() int* tok_e = (int*)(ws + WS_MOE + MO_TOKE); float* tok_g = (float*)(ws + WS_MOE + MO_TOKG); float* tok_rs = (float*)(ws + WS_MOE + MO_TOKRS); \
            int* tok_slot = (int*)(ws + WS_MOE + MO_SLOT); float* rsx = (float*)(ws + WS_MOE + MO_RSX); int* cnts = (int*)(ws + WS_MOE + MO_CNT); int* blk = (int*)(ws + WS_MOE + MO_BLK); \
            bf16* XG = (bf16*)(ws + WS_XG); bf16* EA = (bf16*)(ws + WS_EA); \
            (void)tok_e; (void)tok_g; (void)tok_rs; (void)tok_slot; (void)rsx; (void)cnts; (void)blk; (void)XG; (void)EA
#define MIX_VIEW() bf16* Zb = (bf16*)(ws + WS_Z); bf16* Qb = (bf16*)(ws + WS_Q); bf16* Kb = (bf16*)(ws + WS_K); bf16* KZT = (bf16*)(ws + WS_KZT); bf16* VT = (bf16*)(ws + WS_VT); \
        bf16* SG = (bf16*)(ws + WS_SG); bf16* SGA = (bf16*)(ws + WS_SGA); bf16* SGB = (bf16*)(ws + WS_SGB); bf16* Cb = (bf16*)(ws + WS_C); \
        float* KVT = (float*)(ws + WS_KVT); bf16* RB = (bf16*)(ws + WS_KVT); bf16* ST = (bf16*)(ws + WS_ST); bf16* MG = (bf16*)(ws + WS_MG); (void)RB; \
        (void)Zb; (void)Qb; (void)Kb; (void)KZT; (void)VT; (void)SG; (void)SGA; (void)SGB; (void)Cb; (void)KVT; (void)ST; (void)MG


        if (IN(PH_A)) { PHASE_VIEW(); MIX_VIEW();
            static_assert(WS_K - WS_Q == 2 * pg8::EpiIn::QK_STRIDE && WS_SGA - WS_SG == 2 * pg8::EpiIn::G_STRIDE && WS_SGB - WS_SGA == 2 * pg8::EpiIn::G_STRIDE, "EpiIn strides");
            if constexpr (L == 0 && A0G8 && !INPROJ8) {
              { pg8::Gemm g{(const bf16*)XBN, (const bf16*)(ws + WS_WIN), T, 2048, D}; pg8::StaticOrder S; S.init(T, 2048, G, bx);
                pg8::EpiIn E{PARTN, (const float*)(ws + WS_COS), (const float*)(ws + WS_SIN), Zb, Qb, SG, 1.0f, 0};
                pg8::gemm_phase<pg8::EpiIn, pg8::StaticOrder, true, true, 0>(lds + RING_OFF, g, S, E); }
              { pg8::Gemm g{(const bf16*)(ws + WS_XBN8), (const bf16*)(ws + WS_WIN8G0), T, 3072, D / 2}; pg8::StaticOrder S; S.init(T, 3072, G, bx);
                pg8::EpiIn E{PARTN, (const float*)(ws + WS_COS), (const float*)(ws + WS_SIN), Zb, Qb, SG, 1.0f / 64.0f, 8};
                pg8::gemm_phase<pg8::EpiIn, pg8::StaticOrder, true, true, 1>(lds + RING_OFF, g, S, E); }
            } else
            { pg8::Gemm g{INPROJ8 ? (const bf16*)(ws + WS_XBN8) : (const bf16*)XBN, (const bf16*)(ws + WS_WIN) + (size_t)L * 5120 * D, T, 5120, INPROJ8 ? D / 2 : D}; pg8::StaticOrder S; S.init(T, 5120, G, bx);
              pg8::EpiIn E{PARTN, (const float*)(ws + WS_COS), (const float*)(ws + WS_SIN), Zb, Qb, SG, INPROJ8 ? 1.0f / 64.0f : 1.0f, 0};
              pg8::gemm_phase<pg8::EpiIn, pg8::StaticOrder, true, true, INPROJ8 ? 1 : 0>(lds + RING_OFF, g, S, E); }

            { pg8::Gemm g{(const bf16*)(ws + WS_WKVT) + (size_t)L * 1536 * D, INPROJ8 ? (const bf16*)(ws + WS_XBN8) : (const bf16*)XBN, 1536, T, INPROJ8 ? D / 2 : D}; pg8::StaticOrder S; S.init(1536, T, G, bx);
              pg8::EpiKvT E{PARTN, (const float*)(ws + WS_COST), (const float*)(ws + WS_SINT), KZT, VT, INPROJ8 ? 1.0f / 64.0f : 1.0f};
              pg8::gemm_phase<pg8::EpiKvT, pg8::StaticOrder, true, true, INPROJ8 ? 1 : 0>(lds + RING_OFF, g, S, E); }
            GRID_BAR();
        }


        if (IN(PH_B)) { PHASE_VIEW(); MIX_VIEW();

            {
                const float* cw = INP(4) + (size_t)L * CONV_W * CONV_DIM; const float* cb = INP(5) + L * CONV_DIM;
                const float* lg = INP(6) + L * CONV_DIM; const float* lb = INP(7) + L * CONV_DIM;
                LAS unsigned* zt = (LAS unsigned*)(lds + RING_OFF);
                LAS float* ot = (LAS float*)(lds + RING_OFF + 65536);
                const int cp = tid & 255, half = tid >> 8;
                float w0[CONV_W], w1[CONV_W];
#pragma unroll
                for (int w = 0; w < CONV_W; ++w) { w0[w] = cw[w * CONV_DIM + 2 * cp]; w1[w] = cw[w * CONV_DIM + 2 * cp + 1]; }
                const float b0 = cb[2 * cp], b1 = cb[2 * cp + 1];
                f32x4 lg0 = *(const f32x4*)(lg + 8 * lane), lg1 = *(const f32x4*)(lg + 8 * lane + 4), lb0 = *(const f32x4*)(lb + 8 * lane), lb1 = *(const f32x4*)(lb + 8 * lane + 4);
                for (int u = bx; u < T / 32; u += G) {
                    const int tok0 = u * 32, pos0 = tok0 & (SEQ - 1);
                    for (int idx = tid; idx < 62 * 64; idx += 512) { const int r = idx >> 6, ch = idx & 63; const int pos = pos0 - 30 + r;
                        v4u v = {0u, 0u, 0u, 0u}; if (pos >= 0) v = *(const GAS v4u*)(Zb + (size_t)(tok0 - 30 + r) * CONV_DIM + ch * 8);
                        *(LAS v4u*)(zt + r * 256 + ch * 4) = v; }
                    __syncthreads();
#pragma unroll 1
                    for (int tg = 0; tg < 2; ++tg) { const int tb = 16 * half + 8 * tg;
                        float a0[8], a1[8];
#pragma unroll
                        for (int q = 0; q < 8; ++q) { a0[q] = b0; a1[q] = b1; }
#pragma unroll
                        for (int r = 0; r < 38; ++r) { const unsigned pv = zt[(tb + r) * 256 + cp]; const float f0 = __uint_as_float(pv << 16), f1 = __uint_as_float(pv & 0xffff0000u);
#pragma unroll
                            for (int q = 0; q < 8; ++q) { const int w = r - q; if (w >= 0 && w < CONV_W) { a0[q] = fmaf(w0[w], f0, a0[q]); a1[q] = fmaf(w1[w], f1, a1[q]); } } }
#pragma unroll
                        for (int q = 0; q < 8; ++q) { typedef float f2 __attribute__((ext_vector_type(2))); *(LAS f2*)(ot + (tb + q) * 512 + 2 * cp) = (f2){a0[q], a1[q]}; } }
                    __syncthreads();
#pragma unroll 1
                    for (int q = 0; q < 4; ++q) { const int tk = 4 * wave + q; const LAS f32x4* op = (const LAS f32x4*)(ot + tk * 512 + 8 * lane); f32x4 v0 = op[0], v1 = op[1];
                        const float mean = wave_sum((v0.x + v0.y) + (v0.z + v0.w) + (v1.x + v1.y) + (v1.z + v1.w)) * (1.0f / 512.0f);
                        v0 = v0 - mean; v1 = v1 - mean;
                        const float var = wave_sum((v0.x * v0.x + v0.y * v0.y) + (v0.z * v0.z + v0.w * v0.w) + (v1.x * v1.x + v1.y * v1.y) + (v1.z * v1.z + v1.w * v1.w)) * (1.0f / 512.0f);
                        const float rstd = __builtin_amdgcn_rsqf(var + EPS);
                        v0 = v0 * rstd * lg0 + lb0; v1 = v1 * rstd * lg1 + lb1;
                        v0 = v0 * pg8::sigm4(v0); v1 = v1 * pg8::sigm4(v1);
                        *(GAS v4u*)(Cb + (size_t)(tok0 + tk) * CONV_DIM + 8 * lane) = pg8::pack8(v0, v1); }
                    __syncthreads();
                }
            }

            {
                const int fr = lane & 15, g4 = lane >> 4;
                for (int u = bx; u < NUNIT; u += G) {
                    const int n = u & 63, bh = u >> 6, h = bh & 7, b = bh >> 3; const size_t tok0 = (size_t)b * SEQ + n * RC;
                    bf16x8 Bv[4], Ak[4][4];
#pragma unroll
                    for (int ks = 0; ks < 4; ++ks) Bv[ks] = *(const GAS bf16x8*)(VT + (size_t)(h * RDV + 16 * wave + fr) * T + tok0 + 32 * ks + 8 * g4);
#pragma unroll
                    for (int dkt = 0; dkt < 4; ++dkt)
#pragma unroll
                        for (int ks = 0; ks < 4; ++ks) Ak[dkt][ks] = *(const GAS bf16x8*)(KZT + (size_t)(h * RDK + 16 * dkt + fr) * T + tok0 + 32 * ks + 8 * g4);
                    f32x4 acc4[4];
#pragma unroll
                    for (int dkt = 0; dkt < 4; ++dkt) { acc4[dkt] = (f32x4){0.f, 0.f, 0.f, 0.f};
#pragma unroll
                        for (int ks = 0; ks < 4; ++ks) acc4[dkt] = __builtin_amdgcn_mfma_f32_16x16x32_bf16(Ak[dkt][ks], Bv[ks], acc4[dkt], 0, 0, 0); }
#pragma unroll
                    for (int dkt = 0; dkt < 4; ++dkt) { typedef unsigned u2 __attribute__((ext_vector_type(2))); u2 o; o.x = pk2(acc4[dkt].x, acc4[dkt].y); o.y = pk2(acc4[dkt].z, acc4[dkt].w);
                        *(GAS u2*)((bf16*)KVT + (size_t)u * (RDV * RDK) + (16 * wave + fr) * RDK + 16 * dkt + 4 * g4) = o; }
                }
            }

            if (moe) {
                __syncthreads();
                LAS float* scr = (LAS float*)(lds + RING_OFF + wave * 16384);
                constexpr int I_GU = 16 * 112, I_DN = 56 * 16, I_EXP = I_GU + I_DN;
                for (int it = gw; it < NEXP * I_EXP; it += NGW) { const int e = it / I_EXP, r = it % I_EXP; const size_t o = ((size_t)jl * NEXP + e) * D * EFF;
                    if (r < I_GU) conv_item<true>(INP(16) + o, INP(17) + o, INP(11) + L * D, (bf16*)(ws + WS_WEGU + (size_t)e * 2 * EFF * D), EFF, D, 112, 3, r, scr, lane);
                    else conv_item<true>(INP(18) + o, nullptr, nullptr, (bf16*)(ws + WS_WED + (size_t)e * D * EFF), D, EFF, 16, 0, r - I_GU, scr, lane); }
            }
            GRID_BAR();
        }


        if (IN(PH_C)) { PHASE_VIEW(); MIX_VIEW();
            {   const int gt = bx * 512 + tid;
                if (gt < 32 * 4096) { const int bh = gt >> 12, e2 = gt & 4095, h = bh & 7; const float gc = __builtin_amdgcn_exp2f(128.0f * log2g(h));
                    float s0 = 0.f, s1 = 0.f; typedef float f2 __attribute__((ext_vector_type(2)));
                    const GAS unsigned* kv = (const GAS unsigned*)((const bf16*)KVT + (size_t)bh * NCH * (RDV * RDK)) + e2; GAS unsigned* st = (GAS unsigned*)(ST + (size_t)bh * NCH * (RDV * RDK)) + e2;
                    unsigned wv[NCH];
#pragma unroll
                    for (int n = 0; n < NCH; ++n) wv[n] = kv[(size_t)n * 4096];
#pragma unroll
                    for (int n = 0; n < NCH; ++n) { const unsigned w = wv[n]; st[(size_t)n * 4096] = pk2(s0, s1); s0 = fmaf(gc, s0, __uint_as_float(w << 16)); s1 = fmaf(gc, s1, __uint_as_float(w & 0xffff0000u)); } }
            }
            GRID_BAR();
        }


        if (IN(PH_D)) { PHASE_VIEW(); MIX_VIEW();
            const int fr = lane & 15, g4 = lane >> 4;
            unsigned offK[2], offS[2], offV[2];
#pragma unroll
            for (int i = 0; i < 2; ++i) { int R, C; pg8::stage_rc(tid * 16 + i * 8192, R, C); const int Rp = (R & ~31) + pg8::perm32(R & 31);
                offK[i] = (unsigned)(Rp * 512 + C) * 2u; offS[i] = (unsigned)(R * 64 + C) * 2u; offV[i] = (unsigned)R * (unsigned)(T * 2) + (unsigned)C * 2u; }
            const unsigned ldsw = (unsigned)wave * 1024u; const int fo = pg8::lds_byte(fr, g4 * 8);
#define RD_STAGE(bufoff, gbase, voff) do { _Pragma("unroll") for (int _i = 0; _i < 2; ++_i) \
                __builtin_amdgcn_global_load_lds((const unsigned*)((const char*)(gbase) + (voff)[_i]), (LAS unsigned*)(lds + (bufoff) + ldsw + _i * 8192), 16, 0, 0); } while (0)
#define RD_ISSUE(uu, buf) do { const int n_ = (uu) & 63, bh_ = (uu) >> 6, h_ = bh_ & 7, b_ = bh_ >> 3; const size_t t0_ = (size_t)b_ * SEQ + n_ * RC; const int so_ = (buf) * 65536; \
                RD_STAGE(so_, Kb + t0_ * 512 + h_ * RDK, offK); RD_STAGE(so_ + 16384, ST + (size_t)(uu) * (RDV * RDK), offS); \
                RD_STAGE(so_ + 32768, VT + (size_t)(h_ * RDV) * T + t0_, offV); RD_STAGE(so_ + 49152, VT + (size_t)(h_ * RDV) * T + t0_ + 64, offV); } while (0)
            int cur = 0;
            typedef unsigned u2 __attribute__((ext_vector_type(2)));
            bf16x8 Bq[2], Bqn[2]; u2 gv[8], gvn[8];
#define RD_QG(uu, BQ, GV) do { const int n_ = (uu) & 63, bh_ = (uu) >> 6, h_ = bh_ & 7, b_ = bh_ >> 3; const size_t tk_ = (size_t)b_ * SEQ + n_ * RC + 16 * wave + fr; \
                _Pragma("unroll") for (int ks = 0; ks < 2; ++ks) BQ[ks] = *(const GAS bf16x8*)(Qb + tk_ * 512 + h_ * RDK + 32 * ks + 8 * g4); \
                _Pragma("unroll") for (int dvt = 0; dvt < 8; ++dvt) GV[dvt] = *(const GAS u2*)(SG + tk_ * 1024 + h_ * RDV + 16 * dvt + 4 * g4); } while (0)
            if (bx < NUNIT) { RD_ISSUE(bx, 0); RD_QG(bx, Bq, gv); }
            for (int u = bx; u < NUNIT; u += G, cur ^= 1) {
                const int n = u & 63, bh = u >> 6, h = bh & 7, b = bh >> 3; const size_t tok0 = (size_t)b * SEQ + n * RC; const float lg = log2g(h);
                const size_t tok = tok0 + 16 * wave + fr;
                const int un = u + G;
                if (un < NUNIT) { RD_ISSUE(un, cur ^ 1); RD_QG(un, Bqn, gvn); asm volatile("s_waitcnt vmcnt(18)" ::: "memory"); } else { asm volatile("s_waitcnt vmcnt(0)" ::: "memory"); }
                __builtin_amdgcn_s_barrier(); asm volatile("" ::: "memory");
                const LAS unsigned char* sb = lds + cur * 65536 + fo;
                f32x4 oT[8], cT[8];
#pragma unroll
                for (int dvt = 0; dvt < 8; ++dvt) { oT[dvt] = (f32x4){0.f, 0.f, 0.f, 0.f}; cT[dvt] = (f32x4){0.f, 0.f, 0.f, 0.f}; }
#pragma unroll
                for (int t2 = 0; t2 < 4; ++t2) {
                    if (2 * t2 <= wave) {
                        unsigned P[2][2];
#pragma unroll
                        for (int nn = 0; nn < 2; ++nn) { f32x4 sv = {0.f, 0.f, 0.f, 0.f};
#pragma unroll
                            for (int ks = 0; ks < 2; ++ks) { const bf16x8 Ak = *(const LAS bf16x8*)(sb + (2 * t2 + nn) * 2048 + ks * 1024);
                                sv = __builtin_amdgcn_mfma_f32_16x16x32_bf16(Ak, Bq[ks], sv, 0, 0, 0); }
                            const int dd = (16 * wave + fr) - (32 * t2 + 8 * g4 + 4 * nn);
                            const float d0 = dd >= 0 ? sv.x * __builtin_amdgcn_exp2f((float)dd * lg) : 0.f, d1 = dd >= 1 ? sv.y * __builtin_amdgcn_exp2f((float)(dd - 1) * lg) : 0.f;
                            const float d2 = dd >= 2 ? sv.z * __builtin_amdgcn_exp2f((float)(dd - 2) * lg) : 0.f, d3 = dd >= 3 ? sv.w * __builtin_amdgcn_exp2f((float)(dd - 3) * lg) : 0.f;
                            P[nn][0] = pg8::cvt_pk_bf16(d0, d1); P[nn][1] = pg8::cvt_pk_bf16(d2, d3); }
                        v4u bp; bp.x = P[0][0]; bp.y = P[0][1]; bp.z = P[1][0]; bp.w = P[1][1];
                        const bf16x8 Bp = __builtin_bit_cast(bf16x8, bp);
                        const LAS unsigned char* vb = sb + 32768 + (t2 >> 1) * 16384 + (t2 & 1) * 1024;
#pragma unroll
                        for (int dvt = 0; dvt < 8; ++dvt) { const bf16x8 Av = *(const LAS bf16x8*)(vb + dvt * 2048);
                            oT[dvt] = __builtin_amdgcn_mfma_f32_16x16x32_bf16(Av, Bp, oT[dvt], 0, 0, 0); }
                    }
                }
#pragma unroll
                for (int dvt = 0; dvt < 8; ++dvt)
#pragma unroll
                    for (int ks = 0; ks < 2; ++ks) { const bf16x8 As = *(const LAS bf16x8*)(sb + 16384 + dvt * 2048 + ks * 1024);
                        cT[dvt] = __builtin_amdgcn_mfma_f32_16x16x32_bf16(As, Bq[ks], cT[dvt], 0, 0, 0); }
                const float xi = __builtin_amdgcn_exp2f((float)(16 * wave + fr + 1) * lg);
                float sm = 0.f;
#pragma unroll
                for (int dvt = 0; dvt < 8; ++dvt) { oT[dvt] = oT[dvt] + cT[dvt] * xi; sm += (oT[dvt].x + oT[dvt].y) + (oT[dvt].z + oT[dvt].w); }
                sm += __shfl_xor(sm, 16); sm += __shfl_xor(sm, 32);
                const float mean = sm * (1.0f / 128.0f); float sq = 0.f;
#pragma unroll
                for (int dvt = 0; dvt < 8; ++dvt) { oT[dvt] = oT[dvt] - mean; sq += (oT[dvt].x * oT[dvt].x + oT[dvt].y * oT[dvt].y) + (oT[dvt].z * oT[dvt].z + oT[dvt].w * oT[dvt].w); }
                sq += __shfl_xor(sq, 16); sq += __shfl_xor(sq, 32);
                const float rstd = __builtin_amdgcn_rsqf(sq * (1.0f / 128.0f) + EPS);
#pragma unroll
                for (int dvt = 0; dvt < 8; ++dvt) { const f32x4 graw = pg8::bf_lo4(gv[dvt].x, gv[dvt].y), gf = graw * pg8::sigm4(graw);
                    const f32x4 r = oT[dvt] * rstd * gf; u2 o; o.x = pg8::cvt_pk_bf16(r.x, r.y); o.y = pg8::cvt_pk_bf16(r.z, r.w); *(GAS u2*)(RB + tok * 1024 + h * RDV + 16 * dvt + 4 * g4) = o; }
                asm volatile("s_waitcnt lgkmcnt(0)" ::: "memory"); __builtin_amdgcn_s_barrier(); asm volatile("" ::: "memory");
#pragma unroll
                for (int ks = 0; ks < 2; ++ks) Bq[ks] = Bqn[ks];
#pragma unroll
                for (int dvt = 0; dvt < 8; ++dvt) gv[dvt] = gvn[dvt];
            }
#undef RD_QG
#undef RD_ISSUE
#undef RD_STAGE
            GRID_BAR();
        }


        if (IN(PH_E)) { PHASE_VIEW(); MIX_VIEW();
            { pg8::Gemm g{Cb, (const bf16*)(ws + WS_WCO) + (size_t)L * D * CONV_DIM, T, D, CONV_DIM}; pg8::StaticOrder S; S.init(T, D, G, bx);
              pg8::EpiGate<false> E{SGA, MG, 1.0f};
              pg8::gemm_phase<pg8::EpiGate<false>, pg8::StaticOrder, true, true>(lds + RING_OFF, g, S, E); }
            { pg8::Gemm g{RB, (const bf16*)(ws + WS_WRO) + (size_t)L * D * D, T, D, D}; pg8::StaticOrder S; S.init(T, D, G, bx);
              pg8::EpiGate<true> E{SGB, MG, SC_E};
              pg8::gemm_phase<pg8::EpiGate<true>, pg8::StaticOrder, true, true>(lds + RING_OFF, g, S, E); }
            GRID_BAR();
        }


        if (IN(PH_F)) { PHASE_VIEW(); MIX_VIEW();
            pg8::Gemm g{MG, (const bf16*)(ws + WS_WO) + (size_t)L * D * D, T, D, D}; pg8::StaticOrder S; S.init(T, D, G, bx);
            pg8::EpiRes<false, DENSE8> E{XBN, XB, PART, nullptr, nullptr, ws + WS_XB8, SC_F};
            pg8::gemm_phase<pg8::EpiRes<false, DENSE8>, pg8::StaticOrder, true, true>(lds + RING_OFF, g, S, E);
            GRID_BAR();
        }

        if (!moe) {

            if (IN(PH_G)) { PHASE_VIEW(); MOE_VIEW();
                pg8::Gemm g{DENSE8 ? (const bf16*)(ws + WS_XB8) : (const bf16*)XB, (const bf16*)(ws + WS_WDGU) + (size_t)jl * 2 * DFF * D, T, 2 * DFF, DENSE8 ? D / 2 : D}; pg8::StaticOrder S; S.init(T, 2 * DFF, G, bx);
                pg8::EpiSwi<false, DENSE8> E{PART, nullptr, (bf16*)(ws + WS_FA), DFF};
                pg8::gemm_phase<pg8::EpiSwi<false, DENSE8>, pg8::StaticOrder, true, true, DENSE8 ? 1 : 0>(lds + RING_OFF, g, S, E);
                GRID_BAR();
            }

            if (IN(PH_H)) { PHASE_VIEW(); MOE_VIEW();
                pg8::Gemm g{(const bf16*)(ws + WS_FA), (const bf16*)(ws + WS_WDD) + (size_t)jl * D * DFF, T, D, DENSE8 ? DFF / 2 : DFF}; pg8::StaticOrder S; S.init(T, D, G, bx, 1);
                pg8::EpiRes<false, PLE8> E{XB, XB, PART, nullptr, nullptr, ws + WS_X8F, SC_Hd * (DENSE8 ? 1.0f / 256.0f : 1.0f)};
                pg8::gemm_phase<pg8::EpiRes<false, PLE8>, pg8::StaticOrder, true, true, DENSE8 ? 1 : 0>(lds + RING_OFF, g, S, E);
                GRID_BAR();
            }
        } else {

            if (IN(PH_G)) { PHASE_VIEW(); MOE_VIEW();
                LAS float* wrT = (LAS float*)(lds + RING_OFF);
                LAS int* lcnt = (LAS int*)(lds + RING_OFF + 32768);
                const float* wr = INP(15) + (size_t)jl * D * NEXP; const float* gf = INP(11) + L * D;
                for (int i = tid; i < D * NEXP; i += 512) { const int k = i >> 3, e = i & 7; wrT[e * 1024 + k] = wr[i] * gf[k]; }
                if (tid < 8) lcnt[tid] = 0;
                __syncthreads();
                f32x4 wreg[8][4];
#pragma unroll
                for (int e = 0; e < 8; ++e)
#pragma unroll
                    for (int j = 0; j < 4; ++j) wreg[e][j] = *(const LAS f32x4*)(wrT + e * 1024 + 256 * j + 4 * lane);
                typedef unsigned u2 __attribute__((ext_vector_type(2)));
                u2 xw[4], xwn[4];
                { const GAS u2* xr = (const GAS u2*)(XB + (size_t)(bx * 128 + wave * 16) * D) + lane;
#pragma unroll
                  for (int j = 0; j < 4; ++j) xw[j] = xr[64 * j]; }
                for (int q = 0; q < 16; ++q) { const int t = bx * 128 + wave * 16 + q;
                    if (q < 15) { const GAS u2* xr = (const GAS u2*)(XB + (size_t)(t + 1) * D) + lane;
#pragma unroll
                        for (int j = 0; j < 4; ++j) xwn[j] = xr[64 * j]; }
                    f32x4 xv[4]; float ss = 0.f;
#pragma unroll
                    for (int j = 0; j < 4; ++j) { xv[j] = pg8::bf_lo4(xw[j].x, xw[j].y); ss += (xv[j].x * xv[j].x + xv[j].y * xv[j].y) + (xv[j].z * xv[j].z + xv[j].w * xv[j].w); }
                    float pa[8];
#pragma unroll
                    for (int e = 0; e < 8; ++e) { float a = 0.f;
#pragma unroll
                        for (int j = 0; j < 4; ++j) { const f32x4 w = wreg[e][j]; a += (xv[j].x * w.x + xv[j].y * w.y) + (xv[j].z * w.z + xv[j].w * w.w); }
                        pa[e] = a; }
                    float r4[4], r2[2], r1;
                    { const bool hi = (lane & 32) != 0;
#pragma unroll
                      for (int i = 0; i < 4; ++i) { const float snd = hi ? pa[i] : pa[i + 4], kp = hi ? pa[i + 4] : pa[i]; r4[i] = kp + __shfl_xor(snd, 32); } }
                    { const bool hi = (lane & 16) != 0;
#pragma unroll
                      for (int i = 0; i < 2; ++i) { const float snd = hi ? r4[i] : r4[i + 2], kp = hi ? r4[i + 2] : r4[i]; r2[i] = kp + __shfl_xor(snd, 16); } }
                    { const bool hi = (lane & 8) != 0; const float snd = hi ? r2[0] : r2[1], kp = hi ? r2[1] : r2[0]; r1 = kp + __shfl_xor(snd, 8); }
                    r1 += __shfl_xor(r1, 4); r1 += __shfl_xor(r1, 2); r1 += __shfl_xor(r1, 1);
                    float lgt[8];
#pragma unroll
                    for (int e = 0; e < 8; ++e) lgt[e] = __int_as_float(__builtin_amdgcn_readlane(__float_as_int(r1), 8 * e));
                    ss = wave_sum(ss); const float rs = __builtin_amdgcn_rsqf(ss * (1.0f / 1024.0f) + EPS);
                    int e1 = 0; float v1 = lgt[0];
#pragma unroll
                    for (int e = 1; e < 8; ++e) if (lgt[e] > v1) { v1 = lgt[e]; e1 = e; }
                    int e2 = -1; float v2 = 0.f;
#pragma unroll
                    for (int e = 0; e < 8; ++e) if (e != e1 && (e2 < 0 || lgt[e] > v2)) { v2 = lgt[e]; e2 = e; }
                    const float ex = __builtin_amdgcn_exp2f((v2 - v1) * rs * kLog2e), g1 = 1.0f / (1.0f + ex), g2 = ex * g1;
                    if (lane == 0) { tok_e[2 * t] = e1; tok_e[2 * t + 1] = e2; tok_g[2 * t] = g1; tok_g[2 * t + 1] = g2; tok_rs[t] = rs; atomicAdd((int*)&lcnt[e1], 1); atomicAdd((int*)&lcnt[e2], 1); }
#pragma unroll
                    for (int j = 0; j < 4; ++j) xw[j] = xwn[j];
                }
                __syncthreads();
                if (tid < 8) cnts[bx * 8 + tid] = lcnt[tid];
                __syncthreads();
                GRID_BAR();
            }

            if (IN(PH_H)) { PHASE_VIEW(); MOE_VIEW();
                LAS int* lc = (LAS int*)(lds + RING_OFF);
                LAS int* base = lc + 2048;
                LAS int* lslot = base + 16;
                LAS int* le = lslot + 256;
                for (int i = tid; i < 2048; i += 512) lc[i] = cnts[i];
                if (tid < 256) le[tid] = tok_e[bx * 256 + tid];
                __syncthreads();
                {
                    int tot = 0, pre = 0;
#pragma unroll
                    for (int k = 0; k < 4; ++k) { const int wg = lane + 64 * k; const int c = lc[wg * 8 + wave]; tot += c; pre += (wg < bx) ? c : 0; }
#pragma unroll
                    for (int o = 1; o < 64; o <<= 1) { tot += __shfl_xor(tot, o); pre += __shfl_xor(pre, o); }
                    if (lane == 0) { base[wave] = pre; base[8 + wave] = tot; }
                }
                __syncthreads();
                if (tid == 0) { int ps = 0; for (int e = 0; e < 8; ++e) { const int tot = base[8 + e]; base[e] += ps; const int nb = (tot + 255) >> 8;
                        if (bx == 0) { for (int q = 0; q < nb; ++q) blk[1 + (ps >> 8) + q] = e; }
                        ps += nb << 8; }
                    if (bx == 0) blk[0] = ps >> 8; }
                __syncthreads();
                {
                    int run = base[wave];
#pragma unroll
                    for (int k = 0; k < 2; ++k) { const int i = lane + 64 * k; const int a = le[2 * i], b2 = le[2 * i + 1]; const bool f = (a == wave) || (b2 == wave);
                        const unsigned long long m = __ballot(f); const int rank = __popcll(m & ((1ull << lane) - 1ull));
                        if (f) lslot[2 * i + (a == wave ? 0 : 1)] = run + rank;
                        run += __popcll(m); }
                }
                __syncthreads();
                if (tid < 256) { const int t = bx * 128 + (tid >> 1); const int s = lslot[tid]; tok_slot[bx * 256 + tid] = s; rsx[s] = tok_rs[t]; }
                for (int p = wave; p < 256; p += 8) { const int t = bx * 128 + (p >> 1), s = lslot[p];
                    const GAS v4u* src = (const GAS v4u*)(XB + (size_t)t * D) + 2 * lane; const v4u a = src[0], b4 = src[1];
                    const f32x4 f0 = pg8::bf_lo4(a.x, a.y), f1 = pg8::bf_lo4(a.z, a.w), f2 = pg8::bf_lo4(b4.x, b4.y), f3 = pg8::bf_lo4(b4.z, b4.w); v4u o;
                    o.x = (unsigned)__builtin_amdgcn_cvt_pk_fp8_f32(f0.z, f0.w, __builtin_amdgcn_cvt_pk_fp8_f32(f0.x, f0.y, 0, false), true);
                    o.y = (unsigned)__builtin_amdgcn_cvt_pk_fp8_f32(f1.z, f1.w, __builtin_amdgcn_cvt_pk_fp8_f32(f1.x, f1.y, 0, false), true);
                    o.z = (unsigned)__builtin_amdgcn_cvt_pk_fp8_f32(f2.z, f2.w, __builtin_amdgcn_cvt_pk_fp8_f32(f2.x, f2.y, 0, false), true);
                    o.w = (unsigned)__builtin_amdgcn_cvt_pk_fp8_f32(f3.z, f3.w, __builtin_amdgcn_cvt_pk_fp8_f32(f3.x, f3.y, 0, false), true);
                    *((GAS v4u*)((unsigned char*)XG + (size_t)s * D) + lane) = o; }
                __syncthreads();
                GRID_BAR();
            }

            if (IN(PH_G1)) { PHASE_VIEW(); MOE_VIEW();
                const int nblk = blk[0];
                pg8::Gemm g{XG, (const bf16*)(ws + WS_WEGU), nblk * 256, 2 * EFF, D / 2}; pg8::MoeOrder S; S.init(nblk * 256, 2 * EFF, G, bx); S.blk_e = blk + 1; S.ntile = 2 * EFF / 256;
                pg8::EpiSwi<true> E{nullptr, rsx, EA, EFF};
                pg8::gemm_phase<pg8::EpiSwi<true>, pg8::MoeOrder, true, true, 1>(lds + RING_OFF, g, S, E);
                GRID_BAR();
            }

            if (IN(PH_G2)) { PHASE_VIEW(); MOE_VIEW();
                const int nblk = blk[0];
                pg8::Gemm g{EA, (const bf16*)(ws + WS_WED), nblk * 256, D, EFF / 2}; pg8::MoeOrder S; S.init(nblk * 256, D, G, bx, 1); S.blk_e = blk + 1; S.ntile = D / 256;
                pg8::EpiStore E{XG, D, 1.0f / 256.0f};
                pg8::gemm_phase<pg8::EpiStore, pg8::MoeOrder, true, true, 1>(lds + RING_OFF, g, S, E);
                GRID_BAR();
            }

            if (IN(PH_CMB)) { PHASE_VIEW(); MOE_VIEW();
                for (int t = gw; t < T; t += NGW) {
                    const int s1 = tok_slot[2 * t], s2 = tok_slot[2 * t + 1]; const float g1 = tok_g[2 * t], g2 = tok_g[2 * t + 1];
                    typedef unsigned u2 __attribute__((ext_vector_type(2))); GAS u2* xr = (GAS u2*)(XB + (size_t)t * D) + lane;
                    const GAS u2* y1 = (const GAS u2*)(XG + (size_t)s1 * D) + lane; const GAS u2* y2 = (const GAS u2*)(XG + (size_t)s2 * D) + lane;
                    float s = 0.f;
#pragma unroll
                    for (int j = 0; j < 4; ++j) { const u2 xw = xr[64 * j]; f32x4 v = pg8::bf_lo4(xw.x, xw.y); const u2 a = y1[64 * j], b2 = y2[64 * j];
                        v = v + (pg8::bf_lo4(a.x, a.y) * g1 + pg8::bf_lo4(b2.x, b2.y) * g2) * SC_CMB; s += (v.x * v.x + v.y * v.y) + (v.z * v.z + v.w * v.w);
                        u2 o; o.x = pk2(v.x, v.y); o.y = pk2(v.z, v.w); xr[64 * j] = o;
                        if (PLE8) ((GAS unsigned*)(ws + WS_X8F + (size_t)t * D))[64 * j + lane] = (unsigned)__builtin_amdgcn_cvt_pk_fp8_f32(v.z, v.w, __builtin_amdgcn_cvt_pk_fp8_f32(v.x, v.y, 0, false), true); }
                    s = wave_sum(s);
                    if (lane < 16) PART[(size_t)t * 16 + lane] = lane == 0 ? s : 0.f;
                }
                GRID_BAR();
            }
        }


        if (IN(PH_I)) { PHASE_VIEW(); MIX_VIEW();
            bf16* PP = (bf16*)(ws + WS_PP);
            { pg8::Gemm g{(const bf16*)(ws + WS_PB) + (size_t)L * T * PLE_DIM, (const bf16*)(ws + WS_WPP) + (size_t)L * D * PLE_DIM, T, D, PLE_DIM}; pg8::StaticOrder S; S.init(T, D, G, bx);
              pg8::EpiStore E{PP, D, 1.0f};
              pg8::gemm_phase<pg8::EpiStore, pg8::StaticOrder, true, true>(lds + RING_OFF, g, S, E); }
            { pg8::Gemm g{PLE8 ? (const bf16*)(ws + WS_X8F) : (const bf16*)XB, (const bf16*)(ws + WS_WPG) + (size_t)L * D * D, T, D, PLE8 ? D / 2 : D}; pg8::StaticOrder S; S.init(T, D, G, bx);
              pg8::EpiRes<true, (L + 1 >= INPROJ8_LAYER && L + 1 < DEPTH), PLE8> E{XB, XBN, PARTN, PART, PP, ws + WS_XBN8, SC_I};
              pg8::gemm_phase<pg8::EpiRes<true, (L + 1 >= INPROJ8_LAYER && L + 1 < DEPTH), PLE8>, pg8::StaticOrder, true, true, PLE8 ? 1 : 0>(lds + RING_OFF, g, S, E); }
            GRID_BAR();
        }
    }
    if (2 >= l_lo && 2 < l_hi) { constexpr int L = 2;
        const bool moe = (L & 1) != 0; const int jl = L >> 1;
        constexpr bool INPROJ8 = (L >= INPROJ8_LAYER);
        constexpr bool PLE8 = (L >= PLE8_LAYER);
        constexpr bool DENSE8 = (L == 2);
#define MOE_VIEW() int* tok_e = (int*)(ws + WS_MOE + MO_TOKE); float* tok_g = (float*)(ws + WS_MOE + MO_TOKG); float* tok_rs = (float*)(ws + WS_MOE + MO_TOKRS); \
            int* tok_slot = (int*)(ws + WS_MOE + MO_SLOT); float* rsx = (float*)(ws + WS_MOE + MO_RSX); int* cnts = (int*)(ws + WS_MOE + MO_CNT); int* blk = (int*)(ws + WS_MOE + MO_BLK); \
            bf16* XG = (bf16*)(ws + WS_XG); bf16* EA = (bf16*)(ws + WS_EA); \
            (void)tok_e; (void)tok_g; (void)tok_rs; (void)tok_slot; (void)rsx; (void)cnts; (void)blk; (void)XG; (void)EA
#define MIX_VIEW() bf16* Zb = (bf16*)(ws + WS_Z); bf16* Qb = (bf16*)(ws + WS_Q); bf16* Kb = (bf16*)(ws + WS_K); bf16* KZT = (bf16*)(ws + WS_KZT); bf16* VT = (bf16*)(ws + WS_VT); \
        bf16* SG = (bf16*)(ws + WS_SG); bf16* SGA = (bf16*)(ws + WS_SGA); bf16* SGB = (bf16*)(ws + WS_SGB); bf16* Cb = (bf16*)(ws + WS_C); \
        float* KVT = (float*)(ws + WS_KVT); bf16* RB = (bf16*)(ws + WS_KVT); bf16* ST = (bf16*)(ws + WS_ST); bf16* MG = (bf16*)(ws + WS_MG); (void)RB; \
        (void)Zb; (void)Qb; (void)Kb; (void)KZT; (void)VT; (void)SG; (void)SGA; (void)SGB; (void)Cb; (void)KVT; (void)ST; (void)MG


        if (IN(PH_A)) { PHASE_VIEW(); MIX_VIEW();
            static_assert(WS_K - WS_Q == 2 * pg8::EpiIn::QK_STRIDE && WS_SGA - WS_SG == 2 * pg8::EpiIn::G_STRIDE && WS_SGB - WS_SGA == 2 * pg8::EpiIn::G_STRIDE, "EpiIn strides");
            if constexpr (L == 0 && A0G8 && !INPROJ8) {
              { pg8::Gemm g{(const bf16*)XBN, (const bf16*)(ws + WS_WIN), T, 2048, D}; pg8::StaticOrder S; S.init(T, 2048, G, bx);
                pg8::EpiIn E{PARTN, (const float*)(ws + WS_COS), (const float*)(ws + WS_SIN), Zb, Qb, SG, 1.0f, 0};
                pg8::gemm_phase<pg8::EpiIn, pg8::StaticOrder, true, true, 0>(lds + RING_OFF, g, S, E); }
              { pg8::Gemm g{(const bf16*)(ws + WS_XBN8), (const bf16*)(ws + WS_WIN8G0), T, 3072, D / 2}; pg8::StaticOrder S; S.init(T, 3072, G, bx);
                pg8::EpiIn E{PARTN, (const float*)(ws + WS_COS), (const float*)(ws + WS_SIN), Zb, Qb, SG, 1.0f / 64.0f, 8};
                pg8::gemm_phase<pg8::EpiIn, pg8::StaticOrder, true, true, 1>(lds + RING_OFF, g, S, E); }
            } else
            { pg8::Gemm g{INPROJ8 ? (const bf16*)(ws + WS_XBN8) : (const bf16*)XBN, (const bf16*)(ws + WS_WIN) + (size_t)L * 5120 * D, T, 5120, INPROJ8 ? D / 2 : D}; pg8::StaticOrder S; S.init(T, 5120, G, bx);
              pg8::EpiIn E{PARTN, (const float*)(ws + WS_COS), (const float*)(ws + WS_SIN), Zb, Qb, SG, INPROJ8 ? 1.0f / 64.0f : 1.0f, 0};
              pg8::gemm_phase<pg8::EpiIn, pg8::StaticOrder, true, true, INPROJ8 ? 1 : 0>(lds + RING_OFF, g, S, E); }

            { pg8::Gemm g{(const bf16*)(ws + WS_WKVT) + (size_t)L * 1536 * D, INPROJ8 ? (const bf16*)(ws + WS_XBN8) : (const bf16*)XBN, 1536, T, INPROJ8 ? D / 2 : D}; pg8::StaticOrder S; S.init(1536, T, G, bx);
              pg8::EpiKvT E{PARTN, (const float*)(ws + WS_COST), (const float*)(ws + WS_SINT), KZT, VT, INPROJ8 ? 1.0f / 64.0f : 1.0f};
              pg8::gemm_phase<pg8::EpiKvT, pg8::StaticOrder, true, true, INPROJ8 ? 1 : 0>(lds + RING_OFF, g, S, E); }
            GRID_BAR();
        }


        if (IN(PH_B)) { PHASE_VIEW(); MIX_VIEW();

            {
                const float* cw = INP(4) + (size_t)L * CONV_W * CONV_DIM; const float* cb = INP(5) + L * CONV_DIM;
                const float* lg = INP(6) + L * CONV_DIM; const float* lb = INP(7) + L * CONV_DIM;
                LAS unsigned* zt = (LAS unsigned*)(lds + RING_OFF);
                LAS float* ot = (LAS float*)(lds + RING_OFF + 65536);
                const int cp = tid & 255, half = tid >> 8;
                float w0[CONV_W], w1[CONV_W];
#pragma unroll
                for (int w = 0; w < CONV_W; ++w) { w0[w] = cw[w * CONV_DIM + 2 * cp]; w1[w] = cw[w * CONV_DIM + 2 * cp + 1]; }
                const float b0 = cb[2 * cp], b1 = cb[2 * cp + 1];
                f32x4 lg0 = *(const f32x4*)(lg + 8 * lane), lg1 = *(const f32x4*)(lg + 8 * lane + 4), lb0 = *(const f32x4*)(lb + 8 * lane), lb1 = *(const f32x4*)(lb + 8 * lane + 4);
                for (int u = bx; u < T / 32; u += G) {
                    const int tok0 = u * 32, pos0 = tok0 & (SEQ - 1);
                    for (int idx = tid; idx < 62 * 64; idx += 512) { const int r = idx >> 6, ch = idx & 63; const int pos = pos0 - 30 + r;
                        v4u v = {0u, 0u, 0u, 0u}; if (pos >= 0) v = *(const GAS v4u*)(Zb + (size_t)(tok0 - 30 + r) * CONV_DIM + ch * 8);
                        *(LAS v4u*)(zt + r * 256 + ch * 4) = v; }
                    __syncthreads();
#pragma unroll 1
                    for (int tg = 0; tg < 2; ++tg) { const int tb = 16 * half + 8 * tg;
                        float a0[8], a1[8];
#pragma unroll
                        for (int q = 0; q < 8; ++q) { a0[q] = b0; a1[q] = b1; }
#pragma unroll
                        for (int r = 0; r < 38; ++r) { const unsigned pv = zt[(tb + r) * 256 + cp]; const float f0 = __uint_as_float(pv << 16), f1 = __uint_as_float(pv & 0xffff0000u);
#pragma unroll
                            for (int q = 0; q < 8; ++q) { const int w = r - q; if (w >= 0 && w < CONV_W) { a0[q] = fmaf(w0[w], f0, a0[q]); a1[q] = fmaf(w1[w], f1, a1[q]); } } }
#pragma unroll
                        for (int q = 0; q < 8; ++q) { typedef float f2 __attribute__((ext_vector_type(2))); *(LAS f2*)(ot + (tb + q) * 512 + 2 * cp) = (f2){a0[q], a1[q]}; } }
                    __syncthreads();
#pragma unroll 1
                    for (int q = 0; q < 4; ++q) { const int tk = 4 * wave + q; const LAS f32x4* op = (const LAS f32x4*)(ot + tk * 512 + 8 * lane); f32x4 v0 = op[0], v1 = op[1];
                        const float mean = wave_sum((v0.x + v0.y) + (v0.z + v0.w) + (v1.x + v1.y) + (v1.z + v1.w)) * (1.0f / 512.0f);
                        v0 = v0 - mean; v1 = v1 - mean;
                        const float var = wave_sum((v0.x * v0.x + v0.y * v0.y) + (v0.z * v0.z + v0.w * v0.w) + (v1.x * v1.x + v1.y * v1.y) + (v1.z * v1.z + v1.w * v1.w)) * (1.0f / 512.0f);
                        const float rstd = __builtin_amdgcn_rsqf(var + EPS);
                        v0 = v0 * rstd * lg0 + lb0; v1 = v1 * rstd * lg1 + lb1;
                        v0 = v0 * pg8::sigm4(v0); v1 = v1 * pg8::sigm4(v1);
                        *(GAS v4u*)(Cb + (size_t)(tok0 + tk) * CONV_DIM + 8 * lane) = pg8::pack8(v0, v1); }
                    __syncthreads();
                }
            }

            {
                const int fr = lane & 15, g4 = lane >> 4;
                for (int u = bx; u < NUNIT; u += G) {
                    const int n = u & 63, bh = u >> 6, h = bh & 7, b = bh >> 3; const size_t tok0 = (size_t)b * SEQ + n * RC;
                    bf16x8 Bv[4], Ak[4][4];
#pragma unroll
                    for (int ks = 0; ks < 4; ++ks) Bv[ks] = *(const GAS bf16x8*)(VT + (size_t)(h * RDV + 16 * wave + fr) * T + tok0 + 32 * ks + 8 * g4);
#pragma unroll
                    for (int dkt = 0; dkt < 4; ++dkt)
#pragma unroll
                        for (int ks = 0; ks < 4; ++ks) Ak[dkt][ks] = *(const GAS bf16x8*)(KZT + (size_t)(h * RDK + 16 * dkt + fr) * T + tok0 + 32 * ks + 8 * g4);
                    f32x4 acc4[4];
#pragma unroll
                    for (int dkt = 0; dkt < 4; ++dkt) { acc4[dkt] = (f32x4){0.f, 0.f, 0.f, 0.f};
#pragma unroll
                        for (int ks = 0; ks < 4; ++ks) acc4[dkt] = __builtin_amdgcn_mfma_f32_16x16x32_bf16(Ak[dkt][ks], Bv[ks], acc4[dkt], 0, 0, 0); }
#pragma unroll
                    for (int dkt = 0; dkt < 4; ++dkt) { typedef unsigned u2 __attribute__((ext_vector_type(2))); u2 o; o.x = pk2(acc4[dkt].x, acc4[dkt].y); o.y = pk2(acc4[dkt].z, acc4[dkt].w);
                        *(GAS u2*)((bf16*)KVT + (size_t)u * (RDV * RDK) + (16 * wave + fr) * RDK + 16 * dkt + 4 * g4) = o; }
                }
            }

            if (moe) {
                __syncthreads();
                LAS float* scr = (LAS float*)(lds + RING_OFF + wave * 16384);
                constexpr int I_GU = 16 * 112, I_DN = 56 * 16, I_EXP = I_GU + I_DN;
                for (int it = gw; it < NEXP * I_EXP; it += NGW) { const int e = it / I_EXP, r = it % I_EXP; const size_t o = ((size_t)jl * NEXP + e) * D * EFF;
                    if (r < I_GU) conv_item<true>(INP(16) + o, INP(17) + o, INP(11) + L * D, (bf16*)(ws + WS_WEGU + (size_t)e * 2 * EFF * D), EFF, D, 112, 3, r, scr, lane);
                    else conv_item<true>(INP(18) + o, nullptr, nullptr, (bf16*)(ws + WS_WED + (size_t)e * D * EFF), D, EFF, 16, 0, r - I_GU, scr, lane); }
            }
            GRID_BAR();
        }


        if (IN(PH_C)) { PHASE_VIEW(); MIX_VIEW();
            {   const int gt = bx * 512 + tid;
                if (gt < 32 * 4096) { const int bh = gt >> 12, e2 = gt & 4095, h = bh & 7; const float gc = __builtin_amdgcn_exp2f(128.0f * log2g(h));
                    float s0 = 0.f, s1 = 0.f; typedef float f2 __attribute__((ext_vector_type(2)));
                    const GAS unsigned* kv = (const GAS unsigned*)((const bf16*)KVT + (size_t)bh * NCH * (RDV * RDK)) + e2; GAS unsigned* st = (GAS unsigned*)(ST + (size_t)bh * NCH * (RDV * RDK)) + e2;
                    unsigned wv[NCH];
#pragma unroll
                    for (int n = 0; n < NCH; ++n) wv[n] = kv[(size_t)n * 4096];
#pragma unroll
                    for (int n = 0; n < NCH; ++n) { const unsigned w = wv[n]; st[(size_t)n * 4096] = pk2(s0, s1); s0 = fmaf(gc, s0, __uint_as_float(w << 16)); s1 = fmaf(gc, s1, __uint_as_float(w & 0xffff0000u)); } }
            }
            GRID_BAR();
        }


        if (IN(PH_D)) { PHASE_VIEW(); MIX_VIEW();
            const int fr = lane & 15, g4 = lane >> 4;
            unsigned offK[2], offS[2], offV[2];
#pragma unroll
            for (int i = 0; i < 2; ++i) { int R, C; pg8::stage_rc(tid * 16 + i * 8192, R, C); const int Rp = (R & ~31) + pg8::perm32(R & 31);
                offK[i] = (unsigned)(Rp * 512 + C) * 2u; offS[i] = (unsigned)(R * 64 + C) * 2u; offV[i] = (unsigned)R * (unsigned)(T * 2) + (unsigned)C * 2u; }
            const unsigned ldsw = (unsigned)wave * 1024u; const int fo = pg8::lds_byte(fr, g4 * 8);
#define RD_STAGE(bufoff, gbase, voff) do { _Pragma("unroll") for (int _i = 0; _i < 2; ++_i) \
                __builtin_amdgcn_global_load_lds((const unsigned*)((const char*)(gbase) + (voff)[_i]), (LAS unsigned*)(lds + (bufoff) + ldsw + _i * 8192), 16, 0, 0); } while (0)
#define RD_ISSUE(uu, buf) do { const int n_ = (uu) & 63, bh_ = (uu) >> 6, h_ = bh_ & 7, b_ = bh_ >> 3; const size_t t0_ = (size_t)b_ * SEQ + n_ * RC; const int so_ = (buf) * 65536; \
                RD_STAGE(so_, Kb + t0_ * 512 + h_ * RDK, offK); RD_STAGE(so_ + 16384, ST + (size_t)(uu) * (RDV * RDK), offS); \
                RD_STAGE(so_ + 32768, VT + (size_t)(h_ * RDV) * T + t0_, offV); RD_STAGE(so_ + 49152, VT + (size_t)(h_ * RDV) * T + t0_ + 64, offV); } while (0)
            int cur = 0;
            typedef unsigned u2 __attribute__((ext_vector_type(2)));
            bf16x8 Bq[2], Bqn[2]; u2 gv[8], gvn[8];
#define RD_QG(uu, BQ, GV) do { const int n_ = (uu) & 63, bh_ = (uu) >> 6, h_ = bh_ & 7, b_ = bh_ >> 3; const size_t tk_ = (size_t)b_ * SEQ + n_ * RC + 16 * wave + fr; \
                _Pragma("unroll") for (int ks = 0; ks < 2; ++ks) BQ[ks] = *(const GAS bf16x8*)(Qb + tk_ * 512 + h_ * RDK + 32 * ks + 8 * g4); \
                _Pragma("unroll") for (int dvt = 0; dvt < 8; ++dvt) GV[dvt] = *(const GAS u2*)(SG + tk_ * 1024 + h_ * RDV + 16 * dvt + 4 * g4); } while (0)
            if (bx < NUNIT) { RD_ISSUE(bx, 0); RD_QG(bx, Bq, gv); }
            for (int u = bx; u < NUNIT; u += G, cur ^= 1) {
                const int n = u & 63, bh = u >> 6, h = bh & 7, b = bh >> 3; const size_t tok0 = (size_t)b * SEQ + n * RC; const float lg = log2g(h);
                const size_t tok = tok0 + 16 * wave + fr;
                const int un = u + G;
                if (un < NUNIT) { RD_ISSUE(un, cur ^ 1); RD_QG(un, Bqn, gvn); asm volatile("s_waitcnt vmcnt(18)" ::: "memory"); } else { asm volatile("s_waitcnt vmcnt(0)" ::: "memory"); }
                __builtin_amdgcn_s_barrier(); asm volatile("" ::: "memory");
                const LAS unsigned char* sb = lds + cur * 65536 + fo;
                f32x4 oT[8], cT[8];
#pragma unroll
                for (int dvt = 0; dvt < 8; ++dvt) { oT[dvt] = (f32x4){0.f, 0.f, 0.f, 0.f}; cT[dvt] = (f32x4){0.f, 0.f, 0.f, 0.f}; }
#pragma unroll
                for (int t2 = 0; t2 < 4; ++t2) {
                    if (2 * t2 <= wave) {
                        unsigned P[2][2];
#pragma unroll
                        for (int nn = 0; nn < 2; ++nn) { f32x4 sv = {0.f, 0.f, 0.f, 0.f};
#pragma unroll
                            for (int ks = 0; ks < 2; ++ks) { const bf16x8 Ak = *(const LAS bf16x8*)(sb + (2 * t2 + nn) * 2048 + ks * 1024);
                                sv = __builtin_amdgcn_mfma_f32_16x16x32_bf16(Ak, Bq[ks], sv, 0, 0, 0); }
                            const int dd = (16 * wave + fr) - (32 * t2 + 8 * g4 + 4 * nn);
                            const float d0 = dd >= 0 ? sv.x * __builtin_amdgcn_exp2f((float)dd * lg) : 0.f, d1 = dd >= 1 ? sv.y * __builtin_amdgcn_exp2f((float)(dd - 1) * lg) : 0.f;
                            const float d2 = dd >= 2 ? sv.z * __builtin_amdgcn_exp2f((float)(dd - 2) * lg) : 0.f, d3 = dd >= 3 ? sv.w * __builtin_amdgcn_exp2f((float)(dd - 3) * lg) : 0.f;
                            P[nn][0] = pg8::cvt_pk_bf16(d0, d1); P[nn][1] = pg8::cvt_pk_bf16(d2, d3); }
                        v4u bp; bp.x = P[0][0]; bp.y = P[0][1]; bp.z = P[1][0]; bp.w = P[1][1];
                        const bf16x8 Bp = __builtin_bit_cast(bf16x8, bp);
                        const LAS unsigned char* vb = sb + 32768 + (t2 >> 1) * 16384 + (t2 & 1) * 1024;
#pragma unroll
                        for (int dvt = 0; dvt < 8; ++dvt) { const bf16x8 Av = *(const LAS bf16x8*)(vb + dvt * 2048);
                            oT[dvt] = __builtin_amdgcn_mfma_f32_16x16x32_bf16(Av, Bp, oT[dvt], 0, 0, 0); }
                    }
                }
#pragma unroll
                for (int dvt = 0; dvt < 8; ++dvt)
#pragma unroll
                    for (int ks = 0; ks < 2; ++ks) { const bf16x8 As = *(const LAS bf16x8*)(sb + 16384 + dvt * 2048 + ks * 1024);
                        cT[dvt] = __builtin_amdgcn_mfma_f32_16x16x32_bf16(As, Bq[ks], cT[dvt], 0, 0, 0); }
                const float xi = __builtin_amdgcn_exp2f((float)(16 * wave + fr + 1) * lg);
                float sm = 0.f;
#pragma unroll
                for (int dvt = 0; dvt < 8; ++dvt) { oT[dvt] = oT[dvt] + cT[dvt] * xi; sm += (oT[dvt].x + oT[dvt].y) + (oT[dvt].z + oT[dvt].w); }
                sm += __shfl_xor(sm, 16); sm += __shfl_xor(sm, 32);
                const float mean = sm * (1.0f / 128.0f); float sq = 0.f;
#pragma unroll
                for (int dvt = 0; dvt < 8; ++dvt) { oT[dvt] = oT[dvt] - mean; sq += (oT[dvt].x * oT[dvt].x + oT[dvt].y * oT[dvt].y) + (oT[dvt].z * oT[dvt].z + oT[dvt].w * oT[dvt].w); }
                sq += __shfl_xor(sq, 16); sq += __shfl_xor(sq, 32);
                const float rstd = __builtin_amdgcn_rsqf(sq * (1.0f / 128.0f) + EPS);
#pragma unroll
                for (int dvt = 0; dvt < 8; ++dvt) { const f32x4 graw = pg8::bf_lo4(gv[dvt].x, gv[dvt].y), gf = graw * pg8::sigm4(graw);
                    const f32x4 r = oT[dvt] * rstd * gf; u2 o; o.x = pg8::cvt_pk_bf16(r.x, r.y); o.y = pg8::cvt_pk_bf16(r.z, r.w); *(GAS u2*)(RB + tok * 1024 + h * RDV + 16 * dvt + 4 * g4) = o; }
                asm volatile("s_waitcnt lgkmcnt(0)" ::: "memory"); __builtin_amdgcn_s_barrier(); asm volatile("" ::: "memory");
#pragma unroll
                for (int ks = 0; ks < 2; ++ks) Bq[ks] = Bqn[ks];
#pragma unroll
                for (int dvt = 0; dvt < 8; ++dvt) gv[dvt] = gvn[dvt];
            }
#undef RD_QG
#undef RD_ISSUE
#undef RD_STAGE
            GRID_BAR();
        }


        if (IN(PH_E)) { PHASE_VIEW(); MIX_VIEW();
            { pg8::Gemm g{Cb, (const bf16*)(ws + WS_WCO) + (size_t)L * D * CONV_DIM, T, D, CONV_DIM}; pg8::StaticOrder S; S.init(T, D, G, bx);
              pg8::EpiGate<false> E{SGA, MG, 1.0f};
              pg8::gemm_phase<pg8::EpiGate<false>, pg8::StaticOrder, true, true>(lds + RING_OFF, g, S, E); }
            { pg8::Gemm g{RB, (const bf16*)(ws + WS_WRO) + (size_t)L * D * D, T, D, D}; pg8::StaticOrder S; S.init(T, D, G, bx);
              pg8::EpiGate<true> E{SGB, MG, SC_E};
              pg8::gemm_phase<pg8::EpiGate<true>, pg8::StaticOrder, true, true>(lds + RING_OFF, g, S, E); }
            GRID_BAR();
        }


        if (IN(PH_F)) { PHASE_VIEW(); MIX_VIEW();
            pg8::Gemm g{MG, (const bf16*)(ws + WS_WO) + (size_t)L * D * D, T, D, D}; pg8::StaticOrder S; S.init(T, D, G, bx);
            pg8::EpiRes<false, DENSE8> E{XBN, XB, PART, nullptr, nullptr, ws + WS_XB8, SC_F};
            pg8::gemm_phase<pg8::EpiRes<false, DENSE8>, pg8::StaticOrder, true, true>(lds + RING_OFF, g, S, E);
            GRID_BAR();
        }

        if (!moe) {

            if (IN(PH_G)) { PHASE_VIEW(); MOE_VIEW();
                pg8::Gemm g{DENSE8 ? (const bf16*)(ws + WS_XB8) : (const bf16*)XB, (const bf16*)(ws + WS_WDGU) + (size_t)jl * 2 * DFF * D, T, 2 * DFF, DENSE8 ? D / 2 : D}; pg8::StaticOrder S; S.init(T, 2 * DFF, G, bx);
                pg8::EpiSwi<false, DENSE8> E{PART, nullptr, (bf16*)(ws + WS_FA), DFF};
                pg8::gemm_phase<pg8::EpiSwi<false, DENSE8>, pg8::StaticOrder, true, true, DENSE8 ? 1 : 0>(lds + RING_OFF, g, S, E);
                GRID_BAR();
            }

            if (IN(PH_H)) { PHASE_VIEW(); MOE_VIEW();
                pg8::Gemm g{(const bf16*)(ws + WS_FA), (const bf16*)(ws + WS_WDD) + (size_t)jl * D * DFF, T, D, DENSE8 ? DFF / 2 : DFF}; pg8::StaticOrder S; S.init(T, D, G, bx, 1);
                pg8::EpiRes<false, PLE8> E{XB, XB, PART, nullptr, nullptr, ws + WS_X8F, SC_Hd * (DENSE8 ? 1.0f / 256.0f : 1.0f)};
                pg8::gemm_phase<pg8::EpiRes<false, PLE8>, pg8::StaticOrder, true, true, DENSE8 ? 1 : 0>(lds + RING_OFF, g, S, E);
                GRID_BAR();
            }
        } else {

            if (IN(PH_G)) { PHASE_VIEW(); MOE_VIEW();
                LAS float* wrT = (LAS float*)(lds + RING_OFF);
                LAS int* lcnt = (LAS int*)(lds + RING_OFF + 32768);
                const float* wr = INP(15) + (size_t)jl * D * NEXP; const float* gf = INP(11) + L * D;
                for (int i = tid; i < D * NEXP; i += 512) { const int k = i >> 3, e = i & 7; wrT[e * 1024 + k] = wr[i] * gf[k]; }
                if (tid < 8) lcnt[tid] = 0;
                __syncthreads();
                f32x4 wreg[8][4];
#pragma unroll
                for (int e = 0; e < 8; ++e)
#pragma unroll
                    for (int j = 0; j < 4; ++j) wreg[e][j] = *(const LAS f32x4*)(wrT + e * 1024 + 256 * j + 4 * lane);
                typedef unsigned u2 __attribute__((ext_vector_type(2)));
                u2 xw[4], xwn[4];
                { const GAS u2* xr = (const GAS u2*)(XB + (size_t)(bx * 128 + wave * 16) * D) + lane;
#pragma unroll
                  for (int j = 0; j < 4; ++j) xw[j] = xr[64 * j]; }
                for (int q = 0; q < 16; ++q) { const int t = bx * 128 + wave * 16 + q;
                    if (q < 15) { const GAS u2* xr = (const GAS u2*)(XB + (size_t)(t + 1) * D) + lane;
#pragma unroll
                        for (int j = 0; j < 4; ++j) xwn[j] = xr[64 * j]; }
                    f32x4 xv[4]; float ss = 0.f;
#pragma unroll
                    for (int j = 0; j < 4; ++j) { xv[j] = pg8::bf_lo4(xw[j].x, xw[j].y); ss += (xv[j].x * xv[j].x + xv[j].y * xv[j].y) + (xv[j].z * xv[j].z + xv[j].w * xv[j].w); }
                    float pa[8];
#pragma unroll
                    for (int e = 0; e < 8; ++e) { float a = 0.f;
#pragma unroll
                        for (int j = 0; j < 4; ++j) { const f32x4 w = wreg[e][j]; a += (xv[j].x * w.x + xv[j].y * w.y) + (xv[j].z * w.z + xv[j].w * w.w); }
                        pa[e] = a; }
                    float r4[4], r2[2], r1;
                    { const bool hi = (lane & 32) != 0;
#pragma unroll
                      for (int i = 0; i < 4; ++i) { const float snd = hi ? pa[i] : pa[i + 4], kp = hi ? pa[i + 4] : pa[i]; r4[i] = kp + __shfl_xor(snd, 32); } }
                    { const bool hi = (lane & 16) != 0;
#pragma unroll
                      for (int i = 0; i < 2; ++i) { const float snd = hi ? r4[i] : r4[i + 2], kp = hi ? r4[i + 2] : r4[i]; r2[i] = kp + __shfl_xor(snd, 16); } }
                    { const bool hi = (lane & 8) != 0; const float snd = hi ? r2[0] : r2[1], kp = hi ? r2[1] : r2[0]; r1 = kp + __shfl_xor(snd, 8); }
                    r1 += __shfl_xor(r1, 4); r1 += __shfl_xor(r1, 2); r1 += __shfl_xor(r1, 1);
                    float lgt[8];
#pragma unroll
                    for (int e = 0; e < 8; ++e) lgt[e] = __int_as_float(__builtin_amdgcn_readlane(__float_as_int(r1), 8 * e));
                    ss = wave_sum(ss); const float rs = __builtin_amdgcn_rsqf(ss * (1.0f / 1024.0f) + EPS);
                    int e1 = 0; float v1 = lgt[0];
#pragma unroll
                    for (int e = 1; e < 8; ++e) if (lgt[e] > v1) { v1 = lgt[e]; e1 = e; }
                    int e2 = -1; float v2 = 0.f;
#pragma unroll
                    for (int e = 0; e < 8; ++e) if (e != e1 && (e2 < 0 || lgt[e] > v2)) { v2 = lgt[e]; e2 = e; }
                    const float ex = __builtin_amdgcn_exp2f((v2 - v1) * rs * kLog2e), g1 = 1.0f / (1.0f + ex), g2 = ex * g1;
                    if (lane == 0) { tok_e[2 * t] = e1; tok_e[2 * t + 1] = e2; tok_g[2 * t] = g1; tok_g[2 * t + 1] = g2; tok_rs[t] = rs; atomicAdd((int*)&lcnt[e1], 1); atomicAdd((int*)&lcnt[e2], 1); }
#pragma unroll
                    for (int j = 0; j < 4; ++j) xw[j] = xwn[j];
                }
                __syncthreads();
                if (tid < 8) cnts[bx * 8 + tid] = lcnt[tid];
                __syncthreads();
                GRID_BAR();
            }

            if (IN(PH_H)) { PHASE_VIEW(); MOE_VIEW();
                LAS int* lc = (LAS int*)(lds + RING_OFF);
                LAS int* base = lc + 2048;
                LAS int* lslot = base + 16;
                LAS int* le = lslot + 256;
                for (int i = tid; i < 2048; i += 512) lc[i] = cnts[i];
                if (tid < 256) le[tid] = tok_e[bx * 256 + tid];
                __syncthreads();
                {
                    int tot = 0, pre = 0;
#pragma unroll
                    for (int k = 0; k < 4; ++k) { const int wg = lane + 64 * k; const int c = lc[wg * 8 + wave]; tot += c; pre += (wg < bx) ? c : 0; }
#pragma unroll
                    for (int o = 1; o < 64; o <<= 1) { tot += __shfl_xor(tot, o); pre += __shfl_xor(pre, o); }
                    if (lane == 0) { base[wave] = pre; base[8 + wave] = tot; }
                }
                __syncthreads();
                if (tid == 0) { int ps = 0; for (int e = 0; e < 8; ++e) { const int tot = base[8 + e]; base[e] += ps; const int nb = (tot + 255) >> 8;
                        if (bx == 0) { for (int q = 0; q < nb; ++q) blk[1 + (ps >> 8) + q] = e; }
                        ps += nb << 8; }
                    if (bx == 0) blk[0] = ps >> 8; }
                __syncthreads();
                {
                    int run = base[wave];
#pragma unroll
                    for (int k = 0; k < 2; ++k) { const int i = lane + 64 * k; const int a = le[2 * i], b2 = le[2 * i + 1]; const bool f = (a == wave) || (b2 == wave);
                        const unsigned long long m = __ballot(f); const int rank = __popcll(m & ((1ull << lane) - 1ull));
                        if (f) lslot[2 * i + (a == wave ? 0 : 1)] = run + rank;
                        run += __popcll(m); }
                }
                __syncthreads();
                if (tid < 256) { const int t = bx * 128 + (tid >> 1); const int s = lslot[tid]; tok_slot[bx * 256 + tid] = s; rsx[s] = tok_rs[t]; }
                for (int p = wave; p < 256; p += 8) { const int t = bx * 128 + (p >> 1), s = lslot[p];
                    const GAS v4u* src = (const GAS v4u*)(XB + (size_t)t * D) + 2 * lane; const v4u a = src[0], b4 = src[1];
                    const f32x4 f0 = pg8::bf_lo4(a.x, a.y), f1 = pg8::bf_lo4(a.z, a.w), f2 = pg8::bf_lo4(b4.x, b4.y), f3 = pg8::bf_lo4(b4.z, b4.w); v4u o;
                    o.x = (unsigned)__builtin_amdgcn_cvt_pk_fp8_f32(f0.z, f0.w, __builtin_amdgcn_cvt_pk_fp8_f32(f0.x, f0.y, 0, false), true);
                    o.y = (unsigned)__builtin_amdgcn_cvt_pk_fp8_f32(f1.z, f1.w, __builtin_amdgcn_cvt_pk_fp8_f32(f1.x, f1.y, 0, false), true);
                    o.z = (unsigned)__builtin_amdgcn_cvt_pk_fp8_f32(f2.z, f2.w, __builtin_amdgcn_cvt_pk_fp8_f32(f2.x, f2.y, 0, false), true);
                    o.w = (unsigned)__builtin_amdgcn_cvt_pk_fp8_f32(f3.z, f3.w, __builtin_amdgcn_cvt_pk_fp8_f32(f3.x, f3.y, 0, false), true);
                    *((GAS v4u*)((unsigned char*)XG + (size_t)s * D) + lane) = o; }
                __syncthreads();
                GRID_BAR();
            }

            if (IN(PH_G1)) { PHASE_VIEW(); MOE_VIEW();
                const int nblk = blk[0];
                pg8::Gemm g{XG, (const bf16*)(ws + WS_WEGU), nblk * 256, 2 * EFF, D / 2}; pg8::MoeOrder S; S.init(nblk * 256, 2 * EFF, G, bx); S.blk_e = blk + 1; S.ntile = 2 * EFF / 256;
                pg8::EpiSwi<true> E{nullptr, rsx, EA, EFF};
                pg8::gemm_phase<pg8::EpiSwi<true>, pg8::MoeOrder, true, true, 1>(lds + RING_OFF, g, S, E);
                GRID_BAR();
            }

            if (IN(PH_G2)) { PHASE_VIEW(); MOE_VIEW();
                const int nblk = blk[0];
                pg8::Gemm g{EA, (const bf16*)(ws + WS_WED), nblk * 256, D, EFF / 2}; pg8::MoeOrder S; S.init(nblk * 256, D, G, bx, 1); S.blk_e = blk + 1; S.ntile = D / 256;
                pg8::EpiStore E{XG, D, 1.0f / 256.0f};
                pg8::gemm_phase<pg8::EpiStore, pg8::MoeOrder, true, true, 1>(lds + RING_OFF, g, S, E);
                GRID_BAR();
            }

            if (IN(PH_CMB)) { PHASE_VIEW(); MOE_VIEW();
                for (int t = gw; t < T; t += NGW) {
                    const int s1 = tok_slot[2 * t], s2 = tok_slot[2 * t + 1]; const float g1 = tok_g[2 * t], g2 = tok_g[2 * t + 1];
                    typedef unsigned u2 __attribute__((ext_vector_type(2))); GAS u2* xr = (GAS u2*)(XB + (size_t)t * D) + lane;
                    const GAS u2* y1 = (const GAS u2*)(XG + (size_t)s1 * D) + lane; const GAS u2* y2 = (const GAS u2*)(XG + (size_t)s2 * D) + lane;
                    float s = 0.f;
#pragma unroll
                    for (int j = 0; j < 4; ++j) { const u2 xw = xr[64 * j]; f32x4 v = pg8::bf_lo4(xw.x, xw.y); const u2 a = y1[64 * j], b2 = y2[64 * j];
                        v = v + (pg8::bf_lo4(a.x, a.y) * g1 + pg8::bf_lo4(b2.x, b2.y) * g2) * SC_CMB; s += (v.x * v.x + v.y * v.y) + (v.z * v.z + v.w * v.w);
                        u2 o; o.x = pk2(v.x, v.y); o.y = pk2(v.z, v.w); xr[64 * j] = o;
                        if (PLE8) ((GAS unsigned*)(ws + WS_X8F + (size_t)t * D))[64 * j + lane] = (unsigned)__builtin_amdgcn_cvt_pk_fp8_f32(v.z, v.w, __builtin_amdgcn_cvt_pk_fp8_f32(v.x, v.y, 0, false), true); }
                    s = wave_sum(s);
                    if (lane < 16) PART[(size_t)t * 16 + lane] = lane == 0 ? s : 0.f;
                }
                GRID_BAR();
            }
        }


        if (IN(PH_I)) { PHASE_VIEW(); MIX_VIEW();
            bf16* PP = (bf16*)(ws + WS_PP);
            { pg8::Gemm g{(const bf16*)(ws + WS_PB) + (size_t)L * T * PLE_DIM, (const bf16*)(ws + WS_WPP) + (size_t)L * D * PLE_DIM, T, D, PLE_DIM}; pg8::StaticOrder S; S.init(T, D, G, bx);
              pg8::EpiStore E{PP, D, 1.0f};
              pg8::gemm_phase<pg8::EpiStore, pg8::StaticOrder, true, true>(lds + RING_OFF, g, S, E); }
            { pg8::Gemm g{PLE8 ? (const bf16*)(ws + WS_X8F) : (const bf16*)XB, (const bf16*)(ws + WS_WPG) + (size_t)L * D * D, T, D, PLE8 ? D / 2 : D}; pg8::StaticOrder S; S.init(T, D, G, bx);
              pg8::EpiRes<true, (L + 1 >= INPROJ8_LAYER && L + 1 < DEPTH), PLE8> E{XB, XBN, PARTN, PART, PP, ws + WS_XBN8, SC_I};
              pg8::gemm_phase<pg8::EpiRes<true, (L + 1 >= INPROJ8_LAYER && L + 1 < DEPTH), PLE8>, pg8::StaticOrder, true, true, PLE8 ? 1 : 0>(lds + RING_OFF, g, S, E); }
            GRID_BAR();
        }
    }
    if (3 >= l_lo && 3 < l_hi) { constexpr int L = 3;
        const bool moe = (L & 1) != 0; const int jl = L >> 1;
        constexpr bool INPROJ8 = (L >= INPROJ8_LAYER);
        constexpr bool PLE8 = (L >= PLE8_LAYER);
        constexpr bool DENSE8 = (L == 2);
#define MOE_VIEW() int* tok_e = (int*)(ws + WS_MOE + MO_TOKE); float* tok_g = (float*)(ws + WS_MOE + MO_TOKG); float* tok_rs = (float*)(ws + WS_MOE + MO_TOKRS); \
            int* tok_slot = (int*)(ws + WS_MOE + MO_SLOT); float* rsx = (float*)(ws + WS_MOE + MO_RSX); int* cnts = (int*)(ws + WS_MOE + MO_CNT); int* blk = (int*)(ws + WS_MOE + MO_BLK); \
            bf16* XG = (bf16*)(ws + WS_XG); bf16* EA = (bf16*)(ws + WS_EA); \
            (void)tok_e; (void)tok_g; (void)tok_rs; (void)tok_slot; (void)rsx; (void)cnts; (void)blk; (void)XG; (void)EA
#define MIX_VIEW() bf16* Zb = (bf16*)(ws + WS_Z); bf16* Qb = (bf16*)(ws + WS_Q); bf16* Kb = (bf16*)(ws + WS_K); bf16* KZT = (bf16*)(ws + WS_KZT); bf16* VT = (bf16*)(ws + WS_VT); \
        bf16* SG = (bf16*)(ws + WS_SG); bf16* SGA = (bf16*)(ws + WS_SGA); bf16* SGB = (bf16*)(ws + WS_SGB); bf16* Cb = (bf16*)(ws + WS_C); \
        float* KVT = (float*)(ws + WS_KVT); bf16* RB = (bf16*)(ws + WS_KVT); bf16* ST = (bf16*)(ws + WS_ST); bf16* MG = (bf16*)(ws + WS_MG); (void)RB; \
        (void)Zb; (void)Qb; (void)Kb; (void)KZT; (void)VT; (void)SG; (void)SGA; (void)SGB; (void)Cb; (void)KVT; (void)ST; (void)MG


        if (IN(PH_A)) { PHASE_VIEW(); MIX_VIEW();
            static_assert(WS_K - WS_Q == 2 * pg8::EpiIn::QK_STRIDE && WS_SGA - WS_SG == 2 * pg8::EpiIn::G_STRIDE && WS_SGB - WS_SGA == 2 * pg8::EpiIn::G_STRIDE, "EpiIn strides");
            if constexpr (L == 0 && A0G8 && !INPROJ8) {
              { pg8::Gemm g{(const bf16*)XBN, (const bf16*)(ws + WS_WIN), T, 2048, D}; pg8::StaticOrder S; S.init(T, 2048, G, bx);
                pg8::EpiIn E{PARTN, (const float*)(ws + WS_COS), (const float*)(ws + WS_SIN), Zb, Qb, SG, 1.0f, 0};
                pg8::gemm_phase<pg8::EpiIn, pg8::StaticOrder, true, true, 0>(lds + RING_OFF, g, S, E); }
              { pg8::Gemm g{(const bf16*)(ws + WS_XBN8), (const bf16*)(ws + WS_WIN8G0), T, 3072, D / 2}; pg8::StaticOrder S; S.init(T, 3072, G, bx);
                pg8::EpiIn E{PARTN, (const float*)(ws + WS_COS), (const float*)(ws + WS_SIN), Zb, Qb, SG, 1.0f / 64.0f, 8};
                pg8::gemm_phase<pg8::EpiIn, pg8::StaticOrder, true, true, 1>(lds + RING_OFF, g, S, E); }
            } else
            { pg8::Gemm g{INPROJ8 ? (const bf16*)(ws + WS_XBN8) : (const bf16*)XBN, (const bf16*)(ws + WS_WIN) + (size_t)L * 5120 * D, T, 5120, INPROJ8 ? D / 2 : D}; pg8::StaticOrder S; S.init(T, 5120, G, bx);
              pg8::EpiIn E{PARTN, (const float*)(ws + WS_COS), (const float*)(ws + WS_SIN), Zb, Qb, SG, INPROJ8 ? 1.0f / 64.0f : 1.0f, 0};
              pg8::gemm_phase<pg8::EpiIn, pg8::StaticOrder, true, true, INPROJ8 ? 1 : 0>(lds + RING_OFF, g, S, E); }

            { pg8::Gemm g{(const bf16*)(ws + WS_WKVT) + (size_t)L * 1536 * D, INPROJ8 ? (const bf16*)(ws + WS_XBN8) : (const bf16*)XBN, 1536, T, INPROJ8 ? D / 2 : D}; pg8::StaticOrder S; S.init(1536, T, G, bx);
              pg8::EpiKvT E{PARTN, (const float*)(ws + WS_COST), (const float*)(ws + WS_SINT), KZT, VT, INPROJ8 ? 1.0f / 64.0f : 1.0f};
              pg8::gemm_phase<pg8::EpiKvT, pg8::StaticOrder, true, true, INPROJ8 ? 1 : 0>(lds + RING_OFF, g, S, E); }
            GRID_BAR();
        }


        if (IN(PH_B)) { PHASE_VIEW(); MIX_VIEW();

            {
                const float* cw = INP(4) + (size_t)L * CONV_W * CONV_DIM; const float* cb = INP(5) + L * CONV_DIM;
                const float* lg = INP(6) + L * CONV_DIM; const float* lb = INP(7) + L * CONV_DIM;
                LAS unsigned* zt = (LAS unsigned*)(lds + RING_OFF);
                LAS float* ot = (LAS float*)(lds + RING_OFF + 65536);
                const int cp = tid & 255, half = tid >> 8;
                float w0[CONV_W], w1[CONV_W];
#pragma unroll
                for (int w = 0; w < CONV_W; ++w) { w0[w] = cw[w * CONV_DIM + 2 * cp]; w1[w] = cw[w * CONV_DIM + 2 * cp + 1]; }
                const float b0 = cb[2 * cp], b1 = cb[2 * cp + 1];
                f32x4 lg0 = *(const f32x4*)(lg + 8 * lane), lg1 = *(const f32x4*)(lg + 8 * lane + 4), lb0 = *(const f32x4*)(lb + 8 * lane), lb1 = *(const f32x4*)(lb + 8 * lane + 4);
                for (int u = bx; u < T / 32; u += G) {
                    const int tok0 = u * 32, pos0 = tok0 & (SEQ - 1);
                    for (int idx = tid; idx < 62 * 64; idx += 512) { const int r = idx >> 6, ch = idx & 63; const int pos = pos0 - 30 + r;
                        v4u v = {0u, 0u, 0u, 0u}; if (pos >= 0) v = *(const GAS v4u*)(Zb + (size_t)(tok0 - 30 + r) * CONV_DIM + ch * 8);
                        *(LAS v4u*)(zt + r * 256 + ch * 4) = v; }
                    __syncthreads();
#pragma unroll 1
                    for (int tg = 0; tg < 2; ++tg) { const int tb = 16 * half + 8 * tg;
                        float a0[8], a1[8];
#pragma unroll
                        for (int q = 0; q < 8; ++q) { a0[q] = b0; a1[q] = b1; }
#pragma unroll
                        for (int r = 0; r < 38; ++r) { const unsigned pv = zt[(tb + r) * 256 + cp]; const float f0 = __uint_as_float(pv << 16), f1 = __uint_as_float(pv & 0xffff0000u);
#pragma unroll
                            for (int q = 0; q < 8; ++q) { const int w = r - q; if (w >= 0 && w < CONV_W) { a0[q] = fmaf(w0[w], f0, a0[q]); a1[q] = fmaf(w1[w], f1, a1[q]); } } }
#pragma unroll
                        for (int q = 0; q < 8; ++q) { typedef float f2 __attribute__((ext_vector_type(2))); *(LAS f2*)(ot + (tb + q) * 512 + 2 * cp) = (f2){a0[q], a1[q]}; } }
                    __syncthreads();
#pragma unroll 1
                    for (int q = 0; q < 4; ++q) { const int tk = 4 * wave + q; const LAS f32x4* op = (const LAS f32x4*)(ot + tk * 512 + 8 * lane); f32x4 v0 = op[0], v1 = op[1];
                        const float mean = wave_sum((v0.x + v0.y) + (v0.z + v0.w) + (v1.x + v1.y) + (v1.z + v1.w)) * (1.0f / 512.0f);
                        v0 = v0 - mean; v1 = v1 - mean;
                        const float var = wave_sum((v0.x * v0.x + v0.y * v0.y) + (v0.z * v0.z + v0.w * v0.w) + (v1.x * v1.x + v1.y * v1.y) + (v1.z * v1.z + v1.w * v1.w)) * (1.0f / 512.0f);
                        const float rstd = __builtin_amdgcn_rsqf(var + EPS);
                        v0 = v0 * rstd * lg0 + lb0; v1 = v1 * rstd * lg1 + lb1;
                        v0 = v0 * pg8::sigm4(v0); v1 = v1 * pg8::sigm4(v1);
                        *(GAS v4u*)(Cb + (size_t)(tok0 + tk) * CONV_DIM + 8 * lane) = pg8::pack8(v0, v1); }
                    __syncthreads();
                }
            }

            {
                const int fr = lane & 15, g4 = lane >> 4;
                for (int u = bx; u < NUNIT; u += G) {
                    const int n = u & 63, bh = u >> 6, h = bh & 7, b = bh >> 3; const size_t tok0 = (size_t)b * SEQ + n * RC;
                    bf16x8 Bv[4], Ak[4][4];
#pragma unroll
                    for (int ks = 0; ks < 4; ++ks) Bv[ks] = *(const GAS bf16x8*)(VT + (size_t)(h * RDV + 16 * wave + fr) * T + tok0 + 32 * ks + 8 * g4);
#pragma unroll
                    for (int dkt = 0; dkt < 4; ++dkt)
#pragma unroll
                        for (int ks = 0; ks < 4; ++ks) Ak[dkt][ks] = *(const GAS bf16x8*)(KZT + (size_t)(h * RDK + 16 * dkt + fr) * T + tok0 + 32 * ks + 8 * g4);
                    f32x4 acc4[4];
#pragma unroll
                    for (int dkt = 0; dkt < 4; ++dkt) { acc4[dkt] = (f32x4){0.f, 0.f, 0.f, 0.f};
#pragma unroll
                        for (int ks = 0; ks < 4; ++ks) acc4[dkt] = __builtin_amdgcn_mfma_f32_16x16x32_bf16(Ak[dkt][ks], Bv[ks], acc4[dkt], 0, 0, 0); }
#pragma unroll
                    for (int dkt = 0; dkt < 4; ++dkt) { typedef unsigned u2 __attribute__((ext_vector_type(2))); u2 o; o.x = pk2(acc4[dkt].x, acc4[dkt].y); o.y = pk2(acc4[dkt].z, acc4[dkt].w);
                        *(GAS u2*)((bf16*)KVT + (size_t)u * (RDV * RDK) + (16 * wave + fr) * RDK + 16 * dkt + 4 * g4) = o; }
                }
            }

            if (moe) {
                __syncthreads();
                LAS float* scr = (LAS float*)(lds + RING_OFF + wave * 16384);
                constexpr int I_GU = 16 * 112, I_DN = 56 * 16, I_EXP = I_GU + I_DN;
                for (int it = gw; it < NEXP * I_EXP; it += NGW) { const int e = it / I_EXP, r = it % I_EXP; const size_t o = ((size_t)jl * NEXP + e) * D * EFF;
                    if (r < I_GU) conv_item<true>(INP(16) + o, INP(17) + o, INP(11) + L * D, (bf16*)(ws + WS_WEGU + (size_t)e * 2 * EFF * D), EFF, D, 112, 3, r, scr, lane);
                    else conv_item<true>(INP(18) + o, nullptr, nullptr, (bf16*)(ws + WS_WED + (size_t)e * D * EFF), D, EFF, 16, 0, r - I_GU, scr, lane); }
            }
            GRID_BAR();
        }


        if (IN(PH_C)) { PHASE_VIEW(); MIX_VIEW();
            {   const int gt = bx * 512 + tid;
                if (gt < 32 * 4096) { const int bh = gt >> 12, e2 = gt & 4095, h = bh & 7; const float gc = __builtin_amdgcn_exp2f(128.0f * log2g(h));
                    float s0 = 0.f, s1 = 0.f; typedef float f2 __attribute__((ext_vector_type(2)));
                    const GAS unsigned* kv = (const GAS unsigned*)((const bf16*)KVT + (size_t)bh * NCH * (RDV * RDK)) + e2; GAS unsigned* st = (GAS unsigned*)(ST + (size_t)bh * NCH * (RDV * RDK)) + e2;
                    unsigned wv[NCH];
#pragma unroll
                    for (int n = 0; n < NCH; ++n) wv[n] = kv[(size_t)n * 4096];
#pragma unroll
                    for (int n = 0; n < NCH; ++n) { const unsigned w = wv[n]; st[(size_t)n * 4096] = pk2(s0, s1); s0 = fmaf(gc, s0, __uint_as_float(w << 16)); s1 = fmaf(gc, s1, __uint_as_float(w & 0xffff0000u)); } }
            }
            GRID_BAR();
        }


        if (IN(PH_D)) { PHASE_VIEW(); MIX_VIEW();
            const int fr = lane & 15, g4 = lane >> 4;
            unsigned offK[2], offS[2], offV[2];
#pragma unroll
            for (int i = 0; i < 2; ++i) { int R, C; pg8::stage_rc(tid * 16 + i * 8192, R, C); const int Rp = (R & ~31) + pg8::perm32(R & 31);
                offK[i] = (unsigned)(Rp * 512 + C) * 2u; offS[i] = (unsigned)(R * 64 + C) * 2u; offV[i] = (unsigned)R * (unsigned)(T * 2) + (unsigned)C * 2u; }
            const unsigned ldsw = (unsigned)wave * 1024u; const int fo = pg8::lds_byte(fr, g4 * 8);
#define RD_STAGE(bufoff, gbase, voff) do { _Pragma("unroll") for (int _i = 0; _i < 2; ++_i) \
                __builtin_amdgcn_global_load_lds((const unsigned*)((const char*)(gbase) + (voff)[_i]), (LAS unsigned*)(lds + (bufoff) + ldsw + _i * 8192), 16, 0, 0); } while (0)
#define RD_ISSUE(uu, buf) do { const int n_ = (uu) & 63, bh_ = (uu) >> 6, h_ = bh_ & 7, b_ = bh_ >> 3; const size_t t0_ = (size_t)b_ * SEQ + n_ * RC; const int so_ = (buf) * 65536; \
                RD_STAGE(so_, Kb + t0_ * 512 + h_ * RDK, offK); RD_STAGE(so_ + 16384, ST + (size_t)(uu) * (RDV * RDK), offS); \
                RD_STAGE(so_ + 32768, VT + (size_t)(h_ * RDV) * T + t0_, offV); RD_STAGE(so_ + 49152, VT + (size_t)(h_ * RDV) * T + t0_ + 64, offV); } while (0)
            int cur = 0;
            typedef unsigned u2 __attribute__((ext_vector_type(2)));
            bf16x8 Bq[2], Bqn[2]; u2 gv[8], gvn[8];
#define RD_QG(uu, BQ, GV) do { const int n_ = (uu) & 63, bh_ = (uu) >> 6, h_ = bh_ & 7, b_ = bh_ >> 3; const size_t tk_ = (size_t)b_ * SEQ + n_ * RC + 16 * wave + fr; \
                _Pragma("unroll") for (int ks = 0; ks < 2; ++ks) BQ[ks] = *(const GAS bf16x8*)(Qb + tk_ * 512 + h_ * RDK + 32 * ks + 8 * g4); \
                _Pragma("unroll") for (int dvt = 0; dvt < 8; ++dvt) GV[dvt] = *(const GAS u2*)(SG + tk_ * 1024 + h_ * RDV + 16 * dvt + 4 * g4); } while (0)
            if (bx < NUNIT) { RD_ISSUE(bx, 0); RD_QG(bx, Bq, gv); }
            for (int u = bx; u < NUNIT; u += G, cur ^= 1) {
                const int n = u & 63, bh = u >> 6, h = bh & 7, b = bh >> 3; const size_t tok0 = (size_t)b * SEQ + n * RC; const float lg = log2g(h);
                const size_t tok = tok0 + 16 * wave + fr;
                const int un = u + G;
                if (un < NUNIT) { RD_ISSUE(un, cur ^ 1); RD_QG(un, Bqn, gvn); asm volatile("s_waitcnt vmcnt(18)" ::: "memory"); } else { asm volatile("s_waitcnt vmcnt(0)" ::: "memory"); }
                __builtin_amdgcn_s_barrier(); asm volatile("" ::: "memory");
                const LAS unsigned char* sb = lds + cur * 65536 + fo;
                f32x4 oT[8], cT[8];
#pragma unroll
                for (int dvt = 0; dvt < 8; ++dvt) { oT[dvt] = (f32x4){0.f, 0.f, 0.f, 0.f}; cT[dvt] = (f32x4){0.f, 0.f, 0.f, 0.f}; }
#pragma unroll
                for (int t2 = 0; t2 < 4; ++t2) {
                    if (2 * t2 <= wave) {
                        unsigned P[2][2];
#pragma unroll
                        for (int nn = 0; nn < 2; ++nn) { f32x4 sv = {0.f, 0.f, 0.f, 0.f};
#pragma unroll
                            for (int ks = 0; ks < 2; ++ks) { const bf16x8 Ak = *(const LAS bf16x8*)(sb + (2 * t2 + nn) * 2048 + ks * 1024);
                                sv = __builtin_amdgcn_mfma_f32_16x16x32_bf16(Ak, Bq[ks], sv, 0, 0, 0); }
                            const int dd = (16 * wave + fr) - (32 * t2 + 8 * g4 + 4 * nn);
                            const float d0 = dd >= 0 ? sv.x * __builtin_amdgcn_exp2f((float)dd * lg) : 0.f, d1 = dd >= 1 ? sv.y * __builtin_amdgcn_exp2f((float)(dd - 1) * lg) : 0.f;
                            const float d2 = dd >= 2 ? sv.z * __builtin_amdgcn_exp2f((float)(dd - 2) * lg) : 0.f, d3 = dd >= 3 ? sv.w * __builtin_amdgcn_exp2f((float)(dd - 3) * lg) : 0.f;
                            P[nn][0] = pg8::cvt_pk_bf16(d0, d1); P[nn][1] = pg8::cvt_pk_bf16(d2, d3); }
                        v4u bp; bp.x = P[0][0]; bp.y = P[0][1]; bp.z = P[1][0]; bp.w = P[1][1];
                        const bf16x8 Bp = __builtin_bit_cast(bf16x8, bp);
                        const LAS unsigned char* vb = sb + 32768 + (t2 >> 1) * 16384 + (t2 & 1) * 1024;
#pragma unroll
                        for (int dvt = 0; dvt < 8; ++dvt) { const bf16x8 Av = *(const LAS bf16x8*)(vb + dvt * 2048);
                            oT[dvt] = __builtin_amdgcn_mfma_f32_16x16x32_bf16(Av, Bp, oT[dvt], 0, 0, 0); }
                    }
                }
#pragma unroll
                for (int dvt = 0; dvt < 8; ++dvt)
#pragma unroll
                    for (int ks = 0; ks < 2; ++ks) { const bf16x8 As = *(const LAS bf16x8*)(sb + 16384 + dvt * 2048 + ks * 1024);
                        cT[dvt] = __builtin_amdgcn_mfma_f32_16x16x32_bf16(As, Bq[ks], cT[dvt], 0, 0, 0); }
                const float xi = __builtin_amdgcn_exp2f((float)(16 * wave + fr + 1) * lg);
                float sm = 0.f;
#pragma unroll
                for (int dvt = 0; dvt < 8; ++dvt) { oT[dvt] = oT[dvt] + cT[dvt] * xi; sm += (oT[dvt].x + oT[dvt].y) + (oT[dvt].z + oT[dvt].w); }
                sm += __shfl_xor(sm, 16); sm += __shfl_xor(sm, 32);
                const float mean = sm * (1.0f / 128.0f); float sq = 0.f;
#pragma unroll
                for (int dvt = 0; dvt < 8; ++dvt) { oT[dvt] = oT[dvt] - mean; sq += (oT[dvt].x * oT[dvt].x + oT[dvt].y * oT[dvt].y) + (oT[dvt].z * oT[dvt].z + oT[dvt].w * oT[dvt].w); }
                sq += __shfl_xor(sq, 16); sq += __shfl_xor(sq, 32);
                const float rstd = __builtin_amdgcn_rsqf(sq * (1.0f / 128.0f) + EPS);
#pragma unroll
                for (int dvt = 0; dvt < 8; ++dvt) { const f32x4 graw = pg8::bf_lo4(gv[dvt].x, gv[dvt].y), gf = graw * pg8::sigm4(graw);
                    const f32x4 r = oT[dvt] * rstd * gf; u2 o; o.x = pg8::cvt_pk_bf16(r.x, r.y); o.y = pg8::cvt_pk_bf16(r.z, r.w); *(GAS u2*)(RB + tok * 1024 + h * RDV + 16 * dvt + 4 * g4) = o; }
                asm volatile("s_waitcnt lgkmcnt(0)" ::: "memory"); __builtin_amdgcn_s_barrier(); asm volatile("" ::: "memory");
#pragma unroll
                for (int ks = 0; ks < 2; ++ks) Bq[ks] = Bqn[ks];
#pragma unroll
                for (int dvt = 0; dvt < 8; ++dvt) gv[dvt] = gvn[dvt];
            }
#undef RD_QG
#undef RD_ISSUE
#undef RD_STAGE
            GRID_BAR();
        }


        if (IN(PH_E)) { PHASE_VIEW(); MIX_VIEW();
            { pg8::Gemm g{Cb, (const bf16*)(ws + WS_WCO) + (size_t)L * D * CONV_DIM, T, D, CONV_DIM}; pg8::StaticOrder S; S.init(T, D, G, bx);
              pg8::EpiGate<false> E{SGA, MG, 1.0f};
              pg8::gemm_phase<pg8::EpiGate<false>, pg8::StaticOrder, true, true>(lds + RING_OFF, g, S, E); }
            { pg8::Gemm g{RB, (const bf16*)(ws + WS_WRO) + (size_t)L * D * D, T, D, D}; pg8::StaticOrder S; S.init(T, D, G, bx);
              pg8::EpiGate<true> E{SGB, MG, SC_E};
              pg8::gemm_phase<pg8::EpiGate<true>, pg8::StaticOrder, true, true>(lds + RING_OFF, g, S, E); }
            GRID_BAR();
        }


        if (IN(PH_F)) { PHASE_VIEW(); MIX_VIEW();
            pg8::Gemm g{MG, (const bf16*)(ws + WS_WO) + (size_t)L * D * D, T, D, D}; pg8::StaticOrder S; S.init(T, D, G, bx);
            pg8::EpiRes<false, DENSE8> E{XBN, XB, PART, nullptr, nullptr, ws + WS_XB8, SC_F};
            pg8::gemm_phase<pg8::EpiRes<false, DENSE8>, pg8::StaticOrder, true, true>(lds + RING_OFF, g, S, E);
            GRID_BAR();
        }

        if (!moe) {

            if (IN(PH_G)) { PHASE_VIEW(); MOE_VIEW();
                pg8::Gemm g{DENSE8 ? (const bf16*)(ws + WS_XB8) : (const bf16*)XB, (const bf16*)(ws + WS_WDGU) + (size_t)jl * 2 * DFF * D, T, 2 * DFF, DENSE8 ? D / 2 : D}; pg8::StaticOrder S; S.init(T, 2 * DFF, G, bx);
                pg8::EpiSwi<false, DENSE8> E{PART, nullptr, (bf16*)(ws + WS_FA), DFF};
                pg8::gemm_phase<pg8::EpiSwi<false, DENSE8>, pg8::StaticOrder, true, true, DENSE8 ? 1 : 0>(lds + RING_OFF, g, S, E);
                GRID_BAR();
            }

            if (IN(PH_H)) { PHASE_VIEW(); MOE_VIEW();
                pg8::Gemm g{(const bf16*)(ws + WS_FA), (const bf16*)(ws + WS_WDD) + (size_t)jl * D * DFF, T, D, DENSE8 ? DFF / 2 : DFF}; pg8::StaticOrder S; S.init(T, D, G, bx, 1);
                pg8::EpiRes<false, PLE8> E{XB, XB, PART, nullptr, nullptr, ws + WS_X8F, SC_Hd * (DENSE8 ? 1.0f / 256.0f : 1.0f)};
                pg8::gemm_phase<pg8::EpiRes<false, PLE8>, pg8::StaticOrder, true, true, DENSE8 ? 1 : 0>(lds + RING_OFF, g, S, E);
                GRID_BAR();
            }
        } else {

            if (IN(PH_G)) { PHASE_VIEW(); MOE_VIEW();
                LAS float* wrT = (LAS float*)(lds + RING_OFF);
                LAS int* lcnt = (LAS int*)(lds + RING_OFF + 32768);
                const float* wr = INP(15) + (size_t)jl * D * NEXP; const float* gf = INP(11) + L * D;
                for (int i = tid; i < D * NEXP; i += 512) { const int k = i >> 3, e = i & 7; wrT[e * 1024 + k] = wr[i] * gf[k]; }
                if (tid < 8) lcnt[tid] = 0;
                __syncthreads();
                f32x4 wreg[8][4];
#pragma unroll
                for (int e = 0; e < 8; ++e)
#pragma unroll
                    for (int j = 0; j < 4; ++j) wreg[e][j] = *(const LAS f32x4*)(wrT + e * 1024 + 256 * j + 4 * lane);
                typedef unsigned u2 __attribute__((ext_vector_type(2)));
                u2 xw[4], xwn[4];
                { const GAS u2* xr = (const GAS u2*)(XB + (size_t)(bx * 128 + wave * 16) * D) + lane;
#pragma unroll
                  for (int j = 0; j < 4; ++j) xw[j] = xr[64 * j]; }
                for (int q = 0; q < 16; ++q) { const int t = bx * 128 + wave * 16 + q;
                    if (q < 15) { const GAS u2* xr = (const GAS u2*)(XB + (size_t)(t + 1) * D) + lane;
#pragma unroll
                        for (int j = 0; j < 4; ++j) xwn[j] = xr[64 * j]; }
                    f32x4 xv[4]; float ss = 0.f;
#pragma unroll
                    for (int j = 0; j < 4; ++j) { xv[j] = pg8::bf_lo4(xw[j].x, xw[j].y); ss += (xv[j].x * xv[j].x + xv[j].y * xv[j].y) + (xv[j].z * xv[j].z + xv[j].w * xv[j].w); }
                    float pa[8];
#pragma unroll
                    for (int e = 0; e < 8; ++e) { float a = 0.f;
#pragma unroll
                        for (int j = 0; j < 4; ++j) { const f32x4 w = wreg[e][j]; a += (xv[j].x * w.x + xv[j].y * w.y) + (xv[j].z * w.z + xv[j].w * w.w); }
                        pa[e] = a; }
                    float r4[4], r2[2], r1;
                    { const bool hi = (lane & 32) != 0;
#pragma unroll
                      for (int i = 0; i < 4; ++i) { const float snd = hi ? pa[i] : pa[i + 4], kp = hi ? pa[i + 4] : pa[i]; r4[i] = kp + __shfl_xor(snd, 32); } }
                    { const bool hi = (lane & 16) != 0;
#pragma unroll
                      for (int i = 0; i < 2; ++i) { const float snd = hi ? r4[i] : r4[i + 2], kp = hi ? r4[i + 2] : r4[i]; r2[i] = kp + __shfl_xor(snd, 16); } }
                    { const bool hi = (lane & 8) != 0; const float snd = hi ? r2[0] : r2[1], kp = hi ? r2[1] : r2[0]; r1 = kp + __shfl_xor(snd, 8); }
                    r1 += __shfl_xor(r1, 4); r1 += __shfl_xor(r1, 2); r1 += __shfl_xor(r1, 1);
                    float lgt[8];
#pragma unroll
                    for (int e = 0; e < 8; ++e) lgt[e] = __int_as_float(__builtin_amdgcn_readlane(__float_as_int(r1), 8 * e));
                    ss = wave_sum(ss); const float rs = __builtin_amdgcn_rsqf(ss * (1.0f / 1024.0f) + EPS);
                    int e1 = 0; float v1 = lgt[0];
#pragma unroll
                    for (int e = 1; e < 8; ++e) if (lgt[e] > v1) { v1 = lgt[e]; e1 = e; }
                    int e2 = -1; float v2 = 0.f;
#pragma unroll
                    for (int e = 0; e < 8; ++e) if (e != e1 && (e2 < 0 || lgt[e] > v2)) { v2 = lgt[e]; e2 = e; }
                    const float ex = __builtin_amdgcn_exp2f((v2 - v1) * rs * kLog2e), g1 = 1.0f / (1.0f + ex), g2 = ex * g1;
                    if (lane == 0) { tok_e[2 * t] = e1; tok_e[2 * t + 1] = e2; tok_g[2 * t] = g1; tok_g[2 * t + 1] = g2; tok_rs[t] = rs; atomicAdd((int*)&lcnt[e1], 1); atomicAdd((int*)&lcnt[e2], 1); }
#pragma unroll
                    for (int j = 0; j < 4; ++j) xw[j] = xwn[j];
                }
                __syncthreads();
                if (tid < 8) cnts[bx * 8 + tid] = lcnt[tid];
                __syncthreads();
                GRID_BAR();
            }

            if (IN(PH_H)) { PHASE_VIEW(); MOE_VIEW();
                LAS int* lc = (LAS int*)(lds + RING_OFF);
                LAS int* base = lc + 2048;
                LAS int* lslot = base + 16;
                LAS int* le = lslot + 256;
                for (int i = tid; i < 2048; i += 512) lc[i] = cnts[i];
                if (tid < 256) le[tid] = tok_e[bx * 256 + tid];
                __syncthreads();
                {
                    int tot = 0, pre = 0;
#pragma unroll
                    for (int k = 0; k < 4; ++k) { const int wg = lane + 64 * k; const int c = lc[wg * 8 + wave]; tot += c; pre += (wg < bx) ? c : 0; }
#pragma unroll
                    for (int o = 1; o < 64; o <<= 1) { tot += __shfl_xor(tot, o); pre += __shfl_xor(pre, o); }
                    if (lane == 0) { base[wave] = pre; base[8 + wave] = tot; }
                }
                __syncthreads();
                if (tid == 0) { int ps = 0; for (int e = 0; e < 8; ++e) { const int tot = base[8 + e]; base[e] += ps; const int nb = (tot + 255) >> 8;
                        if (bx == 0) { for (int q = 0; q < nb; ++q) blk[1 + (ps >> 8) + q] = e; }
                        ps += nb << 8; }
                    if (bx == 0) blk[0] = ps >> 8; }
                __syncthreads();
                {
                    int run = base[wave];
#pragma unroll
                    for (int k = 0; k < 2; ++k) { const int i = lane + 64 * k; const int a = le[2 * i], b2 = le[2 * i + 1]; const bool f = (a == wave) || (b2 == wave);
                        const unsigned long long m = __ballot(f); const int rank = __popcll(m & ((1ull << lane) - 1ull));
                        if (f) lslot[2 * i + (a == wave ? 0 : 1)] = run + rank;
                        run += __popcll(m); }
                }
                __syncthreads();
                if (tid < 256) { const int t = bx * 128 + (tid >> 1); const int s = lslot[tid]; tok_slot[bx * 256 + tid] = s; rsx[s] = tok_rs[t]; }
                for (int p = wave; p < 256; p += 8) { const int t = bx * 128 + (p >> 1), s = lslot[p];
                    const GAS v4u* src = (const GAS v4u*)(XB + (size_t)t * D) + 2 * lane; const v4u a = src[0], b4 = src[1];
                    const f32x4 f0 = pg8::bf_lo4(a.x, a.y), f1 = pg8::bf_lo4(a.z, a.w), f2 = pg8::bf_lo4(b4.x, b4.y), f3 = pg8::bf_lo4(b4.z, b4.w); v4u o;
                    o.x = (unsigned)__builtin_amdgcn_cvt_pk_fp8_f32(f0.z, f0.w, __builtin_amdgcn_cvt_pk_fp8_f32(f0.x, f0.y, 0, false), true);
                    o.y = (unsigned)__builtin_amdgcn_cvt_pk_fp8_f32(f1.z, f1.w, __builtin_amdgcn_cvt_pk_fp8_f32(f1.x, f1.y, 0, false), true);
                    o.z = (unsigned)__builtin_amdgcn_cvt_pk_fp8_f32(f2.z, f2.w, __builtin_amdgcn_cvt_pk_fp8_f32(f2.x, f2.y, 0, false), true);
                    o.w = (unsigned)__builtin_amdgcn_cvt_pk_fp8_f32(f3.z, f3.w, __builtin_amdgcn_cvt_pk_fp8_f32(f3.x, f3.y, 0, false), true);
                    *((GAS v4u*)((unsigned char*)XG + (size_t)s * D) + lane) = o; }
                __syncthreads();
                GRID_BAR();
            }

            if (IN(PH_G1)) { PHASE_VIEW(); MOE_VIEW();
                const int nblk = blk[0];
                pg8::Gemm g{XG, (const bf16*)(ws + WS_WEGU), nblk * 256, 2 * EFF, D / 2}; pg8::MoeOrder S; S.init(nblk * 256, 2 * EFF, G, bx); S.blk_e = blk + 1; S.ntile = 2 * EFF / 256;
                pg8::EpiSwi<true> E{nullptr, rsx, EA, EFF};
                pg8::gemm_phase<pg8::EpiSwi<true>, pg8::MoeOrder, true, true, 1>(lds + RING_OFF, g, S, E);
                GRID_BAR();
            }

            if (IN(PH_G2)) { PHASE_VIEW(); MOE_VIEW();
                const int nblk = blk[0];
                pg8::Gemm g{EA, (const bf16*)(ws + WS_WED), nblk * 256, D, EFF / 2}; pg8::MoeOrder S; S.init(nblk * 256, D, G, bx, 1); S.blk_e = blk + 1; S.ntile = D / 256;
                pg8::EpiStore E{XG, D, 1.0f / 256.0f};
                pg8::gemm_phase<pg8::EpiStore, pg8::MoeOrder, true, true, 1>(lds + RING_OFF, g, S, E);
                GRID_BAR();
            }

            if (IN(PH_CMB)) { PHASE_VIEW(); MOE_VIEW();
                for (int t = gw; t < T; t += NGW) {
                    const int s1 = tok_slot[2 * t], s2 = tok_slot[2 * t + 1]; const float g1 = tok_g[2 * t], g2 = tok_g[2 * t + 1];
                    typedef unsigned u2 __attribute__((ext_vector_type(2))); GAS u2* xr = (GAS u2*)(XB + (size_t)t * D) + lane;
                    const GAS u2* y1 = (const GAS u2*)(XG + (size_t)s1 * D) + lane; const GAS u2* y2 = (const GAS u2*)(XG + (size_t)s2 * D) + lane;
                    float s = 0.f;
#pragma unroll
                    for (int j = 0; j < 4; ++j) { const u2 xw = xr[64 * j]; f32x4 v = pg8::bf_lo4(xw.x, xw.y); const u2 a = y1[64 * j], b2 = y2[64 * j];
                        v = v + (pg8::bf_lo4(a.x, a.y) * g1 + pg8::bf_lo4(b2.x, b2.y) * g2) * SC_CMB; s += (v.x * v.x + v.y * v.y) + (v.z * v.z + v.w * v.w);
                        u2 o; o.x = pk2(v.x, v.y); o.y = pk2(v.z, v.w); xr[64 * j] = o;
                        if (PLE8) ((GAS unsigned*)(ws + WS_X8F + (size_t)t * D))[64 * j + lane] = (unsigned)__builtin_amdgcn_cvt_pk_fp8_f32(v.z, v.w, __builtin_amdgcn_cvt_pk_fp8_f32(v.x, v.y, 0, false), true); }
                    s = wave_sum(s);
                    if (lane < 16) PART[(size_t)t * 16 + lane] = lane == 0 ? s : 0.f;
                }
                GRID_BAR();
            }
        }


        if (IN(PH_I)) { PHASE_VIEW(); MIX_VIEW();
            bf16* PP = (bf16*)(ws + WS_PP);
            { pg8::Gemm g{(const bf16*)(ws + WS_PB) + (size_t)L * T * PLE_DIM, (const bf16*)(ws + WS_WPP) + (size_t)L * D * PLE_DIM, T, D, PLE_DIM}; pg8::StaticOrder S; S.init(T, D, G, bx);
              pg8::EpiStore E{PP, D, 1.0f};
              pg8::gemm_phase<pg8::EpiStore, pg8::StaticOrder, true, true>(lds + RING_OFF, g, S, E); }
            { pg8::Gemm g{PLE8 ? (const bf16*)(ws + WS_X8F) : (const bf16*)XB, (const bf16*)(ws + WS_WPG) + (size_t)L * D * D, T, D, PLE8 ? D / 2 : D}; pg8::StaticOrder S; S.init(T, D, G, bx);
              pg8::EpiRes<true, (L + 1 >= INPROJ8_LAYER && L + 1 < DEPTH), PLE8> E{XB, XBN, PARTN, PART, PP, ws + WS_XBN8, SC_I};
              pg8::gemm_phase<pg8::EpiRes<true, (L + 1 >= INPROJ8_LAYER && L + 1 < DEPTH), PLE8>, pg8::StaticOrder, true, true, PLE8 ? 1 : 0>(lds + RING_OFF, g, S, E); }
            GRID_BAR();
        }
    }


    if (l_hi > DEPTH) { PHASE_VIEW();
        const float* gf = INP(22);
        f32x4 gv[4];
#pragma unroll
        for (int j = 0; j < 4; ++j) gv[j] = *((const f32x4*)gf + lane + 64 * j);
        for (int m = gw; m < T; m += NGW) { typedef unsigned u2 __attribute__((ext_vector_type(2))); const GAS u2* xr = (const GAS u2*)(XBN + (size_t)m * D) + lane; GAS f32x4* xo = (GAS f32x4*)(X + (size_t)m * D) + lane; f32x4 v[4]; float s = 0.f;
#pragma unroll
            for (int j = 0; j < 4; ++j) { const u2 xw = xr[64 * j]; v[j] = pg8::bf_lo4(xw.x, xw.y); s += (v[j].x * v[j].x + v[j].y * v[j].y) + (v[j].z * v[j].z + v[j].w * v[j].w); }
            const float rs = __builtin_amdgcn_rsqf(wave_sum(s) * (1.0f / 1024.0f) + EPS);
#pragma unroll
            for (int j = 0; j < 4; ++j) xo[64 * j] = v[j] * rs * gv[j]; }
    }
#undef IN
#undef GRID_BAR
#undef INP
#undef PHASE_VIEW
#undef MIX_VIEW
#undef MOE_VIEW
}

extern "C" void kernel_launch(void* const* d_in, const int* in_sizes, int n_in, void* d_out, int out_size, void* d_ws, size_t ws_size, hipStream_t stream) {
    static int grid = 0;
    if (grid == 0) {
        if (n_in != 23 || out_size != T * D || ws_size < WS_END) { fprintf(stderr, "kernel_launch: unexpected shapes: n_in %d out %d ws %zu (need %zu)\n", n_in, out_size, ws_size, (size_t)WS_END); grid = -1; return; }
        int dev = 0, cus = 0, per_cu = 0;
        if (hipGetDevice(&dev) != hipSuccess || hipDeviceGetAttribute(&cus, hipDeviceAttributeMultiprocessorCount, dev) != hipSuccess) { grid = -1; return; }
        if (hipFuncSetAttribute((const void*)hybrid_fwd, hipFuncAttributeMaxDynamicSharedMemorySize, LDS_BYTES) != hipSuccess) { fprintf(stderr, "kernel_launch: hipFuncSetAttribute failed\n"); grid = -1; return; }
        if (hipOccupancyMaxActiveBlocksPerMultiprocessor(&per_cu, (const void*)hybrid_fwd, NWAVES * 64, LDS_BYTES) != hipSuccess || per_cu < 1) { fprintf(stderr, "kernel_launch: occupancy query reports %d\n", per_cu); }
        (void)hipGetLastError();
        grid = cus;
        if (grid != 256) { fprintf(stderr, "kernel_launch: built for 256 CUs, found %d\n", cus); grid = -1; return; }
    }
    if (grid < 0) return;
    (void)hipMemsetAsync((char*)d_ws + WS_CTL, 0, CTL_ZERO_BYTES, stream);
    Args a{};
    for (int i = 0; i < 23; ++i) a.in[i] = (const float*)d_in[i];
    a.out = (float*)d_out; a.ws = (unsigned char*)d_ws; a.pad = 0;
#if MK_FUSED
    a.l_lo = -1; a.l_hi = DEPTH + 1; a.ph_lo = 0; a.ph_hi = PH_N; a.fused = 1;
    hipLaunchKernelGGL(hybrid_fwd, dim3(grid), dim3(NWAVES * 64), LDS_BYTES, stream, a);
#else
    a.fused = 0;
    a.l_lo = -1; a.l_hi = 0; a.ph_lo = 0; a.ph_hi = 0;
    hipLaunchKernelGGL(hybrid_fwd, dim3(grid), dim3(NWAVES * 64), LDS_BYTES, stream, a);
    for (int L = 0; L < DEPTH; ++L)
        for (int ph = 0; ph < PH_N; ++ph) {
            if ((L & 1) == 0 && (ph == PH_G1 || ph == PH_G2 || ph == PH_CMB)) continue;
            a.l_lo = L; a.l_hi = L + 1; a.ph_lo = ph; a.ph_hi = ph + 1;
            hipLaunchKernelGGL(hybrid_fwd, dim3(grid), dim3(NWAVES * 64), LDS_BYTES, stream, a);
        }
    a.l_lo = DEPTH; a.l_hi = DEPTH + 1; a.ph_lo = 0; a.ph_hi = 0;
    hipLaunchKernelGGL(hybrid_fwd, dim3(grid), dim3(NWAVES * 64), LDS_BYTES, stream, a);
#endif
}
```
